# Optimizing an MI355X kernel written in HIP

```python
import jax, jax.numpy as jnp
from jax import lax
import numpy as np

D_MODEL = 1024
BATCH = 4
SEQ = 4096
DEPTH = 1
DEC_BATCH = 16
DEC_SEQ = 32
PAST_LEN = 4096

CHUNK = 64
N_HEADS = 8
HEAD_DIM = 64
D_ATTN = N_HEADS * HEAD_DIM
D_CONV = D_MODEL // 2
CONV_WIDTH = 31
D_FF = ((8 * D_MODEL // 3 + 255) // 256) * 256
Q_BLOCK = 128
RMS_EPS = 1e-6
LN_EPS = 1e-5
NEG = -1e30
D_IN = 2 * D_CONV + 3 * D_ATTN + N_HEADS + 2 * D_MODEL

kernel_name = "hybrid_conformer_fox_stream_step"


def rmsnorm(x, g):
    xf = x.astype(jnp.float32)
    y = xf * lax.rsqrt(jnp.mean(xf * xf, axis=-1, keepdims=True) + RMS_EPS)
    return (y * g.astype(jnp.float32)).astype(x.dtype)


def layernorm(x, g, b):
    xf = x.astype(jnp.float32)
    mu = jnp.mean(xf, axis=-1, keepdims=True)
    var = jnp.mean(jnp.square(xf - mu), axis=-1, keepdims=True)
    y = (xf - mu) * lax.rsqrt(var + LN_EPS)
    return (y * g.astype(jnp.float32) + b.astype(jnp.float32)).astype(x.dtype)


def depthwise_causal(xpad, w_dw, b_dw):
    out = lax.conv_general_dilated(
        xpad, w_dw[:, None, :].astype(xpad.dtype), window_strides=(1,), padding='VALID',
        dimension_numbers=('NWC', 'WIO', 'NWC'), feature_group_count=D_CONV)
    return out + b_dw.astype(out.dtype)


def fox_block(q, k, v, cq, ck, q_pos, k_pos):
    s = jnp.einsum('bqhd,bkhd->bhqk', q.astype(jnp.float32), k.astype(jnp.float32)) * (HEAD_DIM ** -0.5)
    decay = jnp.transpose(cq, (0, 2, 1))[:, :, :, None] - jnp.transpose(ck, (0, 2, 1))[:, :, None, :]
    mask = k_pos[None, :] <= q_pos[:, None]
    s = jnp.where(mask[None, None], s + decay, NEG)
    p = jax.nn.softmax(s, axis=-1)
    return jnp.einsum('bhqk,bkhd->bqhd', p, v.astype(jnp.float32)).astype(v.dtype)


def fox_prompt(q, k, v, logf):
    B, S = q.shape[0], q.shape[1]
    c = jnp.cumsum(logf, axis=1)
    pos = jnp.arange(S)
    nb = S // Q_BLOCK
    qb = jnp.transpose(q.reshape(B, nb, Q_BLOCK, N_HEADS, HEAD_DIM), (1, 0, 2, 3, 4))
    cb = jnp.transpose(c.reshape(B, nb, Q_BLOCK, N_HEADS), (1, 0, 2, 3))
    pb = pos.reshape(nb, Q_BLOCK)
    out = lax.map(lambda a: fox_block(a[0], k, v, a[1], c, a[2], pos), (qb, cb, pb))
    return jnp.transpose(out, (1, 0, 2, 3, 4)).reshape(B, S, N_HEADS, HEAD_DIM)


def fox_sample(q, k, v, logf, cache_k, cache_v, cache_logf):
    P, T = cache_k.shape[1], q.shape[1]
    kk = jnp.concatenate([cache_k.astype(k.dtype), k], axis=1)
    vv = jnp.concatenate([cache_v.astype(v.dtype), v], axis=1)
    c = jnp.cumsum(jnp.concatenate([cache_logf.astype(jnp.float32), logf], axis=1), axis=1)
    k_pos = jnp.arange(P + T)
    q_pos = P + jnp.arange(T)
    return fox_block(q, kk, vv, c[:, P:], c, q_pos, k_pos)


def layer(x, conv_hist, attend, norm_mix_g, w_in, b_f, w_dw, b_dw, ln_g, ln_b,
          w_conv_pw, w_attn_o, w_out, norm_ffn_g, w_gate, w_up, w_down):
    B, T, _ = x.shape
    u = rmsnorm(x, norm_mix_g) @ w_in
    o = 2 * D_CONV
    glu_in = u[..., :o]
    q = u[..., o:o + D_ATTN].reshape(B, T, N_HEADS, HEAD_DIM); o += D_ATTN
    k = u[..., o:o + D_ATTN].reshape(B, T, N_HEADS, HEAD_DIM); o += D_ATTN
    v = u[..., o:o + D_ATTN].reshape(B, T, N_HEADS, HEAD_DIM); o += D_ATTN
    f_logit = u[..., o:o + N_HEADS]; o += N_HEADS
    g_conv = u[..., o:o + D_MODEL]; o += D_MODEL
    g_attn = u[..., o:o + D_MODEL]
    logf = jax.nn.log_sigmoid(f_logit.astype(jnp.float32) + b_f.astype(jnp.float32))

    a, gl = jnp.split(glu_in, 2, axis=-1)
    cu = a * jax.nn.sigmoid(gl)
    cpad = jnp.concatenate([conv_hist.astype(cu.dtype), cu], axis=1)
    new_hist = cpad[:, -(CONV_WIDTH - 1):]
    cy = jax.nn.silu(layernorm(depthwise_causal(cpad, w_dw, b_dw), ln_g, ln_b)) @ w_conv_pw

    ao = attend(q, k, v, logf).reshape(B, T, D_ATTN) @ w_attn_o

    mixed = jax.nn.sigmoid(g_conv) * cy + jax.nn.sigmoid(g_attn) * ao
    h = x + mixed @ w_out

    z = rmsnorm(h, norm_ffn_g)
    h = h + (jax.nn.silu(z @ w_gate) * (z @ w_up)) @ w_down
    return h, k, v, logf.astype(x.dtype), new_hist


def setup_inputs(seed: int = 0) -> dict:
    key = jax.random.key(seed)
    ks = jax.random.split(key, 24)
    L = DEPTH

    def nrm(k, shape, scale):
        return jax.random.normal(k, shape, jnp.float32) * scale

    return {
        "x_prompt": nrm(ks[0], (BATCH, SEQ, D_MODEL), 1.0),
        "x_sample": nrm(ks[1], (DEC_BATCH, DEC_SEQ, D_MODEL), 1.0),
        "cache_k": nrm(ks[2], (L, DEC_BATCH, PAST_LEN, N_HEADS, HEAD_DIM), 1.0),
        "cache_v": nrm(ks[3], (L, DEC_BATCH, PAST_LEN, N_HEADS, HEAD_DIM), 1.0),
        "cache_logf": jax.nn.log_sigmoid(nrm(ks[4], (L, DEC_BATCH, PAST_LEN, N_HEADS), 1.0) + 3.0),
        "state_conv": nrm(ks[5], (L, DEC_BATCH, CONV_WIDTH - 1, D_CONV), 1.0),
        "norm_mix_g": 1.0 + nrm(ks[6], (L, D_MODEL), 0.02),
        "w_in": nrm(ks[7], (L, D_MODEL, D_IN), D_MODEL ** -0.5),
        "b_f": jax.random.uniform(ks[8], (L, N_HEADS), jnp.float32, 1.0, 5.0),
        "w_dw": nrm(ks[9], (L, CONV_WIDTH, D_CONV), CONV_WIDTH ** -0.5),
        "b_dw": nrm(ks[10], (L, D_CONV), 0.02),
        "ln_g": 1.0 + nrm(ks[11], (L, D_CONV), 0.02),
        "ln_b": nrm(ks[12], (L, D_CONV), 0.02),
        "w_conv_pw": nrm(ks[13], (L, D_CONV, D_MODEL), D_CONV ** -0.5),
        "w_attn_o": nrm(ks[14], (L, D_ATTN, D_MODEL), D_ATTN ** -0.5),
        "w_out": nrm(ks[15], (L, D_MODEL, D_MODEL), D_MODEL ** -0.5),
        "norm_ffn_g": 1.0 + nrm(ks[16], (L, D_MODEL), 0.02),
        "w_gate": nrm(ks[17], (L, D_MODEL, D_FF), D_MODEL ** -0.5),
        "w_up": nrm(ks[18], (L, D_MODEL, D_FF), D_MODEL ** -0.5),
        "w_down": nrm(ks[19], (L, D_FF, D_MODEL), D_FF ** -0.5),
        "final_norm_g": 1.0 + nrm(ks[20], (D_MODEL,), 0.02),
    }


def reference(x_prompt, x_sample, cache_k, cache_v, cache_logf, state_conv,
              norm_mix_g, w_in, b_f, w_dw, b_dw, ln_g, ln_b, w_conv_pw, w_attn_o, w_out,
              norm_ffn_g, w_gate, w_up, w_down, final_norm_g):
    hp, hs = x_prompt, x_sample
    kp_l, vp_l, fp_l, cp_l = [], [], [], []
    ks_l, vs_l, fs_l, cs_l = [], [], [], []
    for l in range(DEPTH):
        wts = (norm_mix_g[l], w_in[l], b_f[l], w_dw[l], b_dw[l], ln_g[l], ln_b[l],
               w_conv_pw[l], w_attn_o[l], w_out[l], norm_ffn_g[l], w_gate[l], w_up[l], w_down[l])
        zero_hist = jnp.zeros((hp.shape[0], CONV_WIDTH - 1, D_CONV), hp.dtype)
        hp, kp, vp, fp, cp = layer(hp, zero_hist, fox_prompt, *wts)
        ck, cv, cf = cache_k[l], cache_v[l], cache_logf[l]
        attend_s = lambda q, k, v, lf: fox_sample(q, k, v, lf, ck, cv, cf)
        hs, ksn, vsn, fsn, csn = layer(hs, state_conv[l], attend_s, *wts)
        kp_l.append(kp); vp_l.append(vp); fp_l.append(fp); cp_l.append(cp)
        ks_l.append(ksn); vs_l.append(vsn); fs_l.append(fsn); cs_l.append(csn)
    y_prompt = rmsnorm(hp, final_norm_g)
    y_sample = rmsnorm(hs, final_norm_g)
    return (y_prompt, y_sample,
            jnp.stack(kp_l), jnp.stack(vp_l), jnp.stack(fp_l), jnp.stack(cp_l),
            jnp.stack(ks_l), jnp.stack(vs_l), jnp.stack(fs_l), jnp.stack(cs_l))
```

```cpp
#include <hip/hip_runtime.h>
#include <hip/hip_cooperative_groups.h>
#include <cstdio>
#include <cstdint>
#include <cmath>
namespace cg = cooperative_groups;
constexpr int DM = 1024, MP = 16384, MS = 512, MT = MP + MS, SEQ = 4096, NH = 8, HD = 64, DA = 512, DC = 512, CW = 31, DFF = 2816, DIN = 4616, PAST = 4096, DB = 16, DS = 32;
constexpr int NIN = 4608, NGU = 2 * DFF;
constexpr size_t OFF_Y = 0, OFF_KP = (size_t)MT * DM, OFF_VP = OFF_KP + (size_t)MP * DA, OFF_LFP = OFF_VP + (size_t)MP * DA, OFF_CVP = OFF_LFP + (size_t)MP * NH,
                 OFF_KS = OFF_CVP + (size_t)4 * 30 * DC, OFF_VS = OFF_KS + (size_t)MS * DA, OFF_LFS = OFF_VS + (size_t)MS * DA, OFF_CVS = OFF_LFS + (size_t)MS * NH, OUT_TOTAL = OFF_CVS + (size_t)DB * 30 * DC;
static_assert(OUT_TOTAL == 35045376, "output size");
constexpr float LOG2E = 1.4426950408889634f;
constexpr float QSCALE = 0.125f * LOG2E;
#define N_LAUNCHES 1
namespace pg8 {
#define PG8_LAS __attribute__((address_space(3)))
typedef unsigned short bf16_t;
typedef short bf16x8 __attribute__((ext_vector_type(8)));
typedef float f32x4 __attribute__((ext_vector_type(4)));
typedef unsigned u32x4 __attribute__((ext_vector_type(4)));
constexpr int BM = 256, BK = 64, HALF = 128, HTB = HALF * BK * 2  , STAGE_BYTES = 8 * HTB, NXCD = 8, WGM = 8;

__host__ __device__ __forceinline__ int lds_byte(int r, int c) { const int st = (r >> 4) * 2 + (c >> 5), rr = r & 15, cc = c & 31, ob = rr * 64 + cc * 2; return st * 1024 + (ob ^ (((ob >> 9) & 1) << 5)); }
__host__ __device__ __forceinline__ void stage_rc(int b, int& R, int& C) { const int st = b / 1024, sb = b % 1024, swz = sb ^ (((sb >> 9) & 1) << 5); R = (st >> 1) * 16 + swz / 64; C = (st & 1) * 32 + (swz % 64) / 2; }
__host__ __device__ __forceinline__ int perm32(int rho) { const int n = rho >> 4, i = rho & 15; return 8 * (i >> 2) + 4 * n + (i & 3); }

struct Unit { int pm, pn; };
struct Gemm { const bf16_t* A; const bf16_t* Bt; int M, N, K; };

struct StaticOrder {
    int nM, nN, nwg, G, c;
    __host__ __device__ void init(int M, int N, int G_, int c_) { nM = M / BM; nN = N / BM; nwg = nM * nN; G = G_; c = c_; }
    __host__ __device__ bool next(int i, Unit& u) const {
        const long L = (long)i * G + c; if (L >= nwg) return false;
        int wgid = (int)L; { const int q = nwg / NXCD, r = nwg % NXCD, xcd = wgid % NXCD, off = wgid / NXCD; wgid = (xcd < r ? xcd * (q + 1) : r * (q + 1) + (xcd - r) * q) + off; }
        const int nig = WGM * nN, gid = wgid / nig, fm = gid * WGM, gsz = (nM - fm) < WGM ? (nM - fm) : WGM;
        u.pm = fm + ((wgid % nig) % gsz); u.pn = (wgid % nig) / gsz; return true;
    }
    __device__ __forceinline__ void a_ready(const Unit&) const {}
    __device__ __forceinline__ void done(const Unit&) const {}
};

__device__ __forceinline__ unsigned cvt_pk_bf16(float lo, float hi) { unsigned r; asm volatile("v_cvt_pk_bf16_f32 %0, %1, %2" : "=v"(r) : "v"(lo), "v"(hi)); return r; }
typedef float f32x2 __attribute__((ext_vector_type(2)));
template <class Epi, class Sched, bool ALIGN_EPI = false, bool SP2 = false>
__device__ __forceinline__ void gemm_phase(PG8_LAS unsigned char* lds, const Gemm g, const Sched& S, const Epi& E) {
    const int tid = threadIdx.x, wid = __builtin_amdgcn_readfirstlane(tid >> 6), lane = tid & 63, wr = wid >> 2, wc = wid & 3, fr = lane & 15, fq = lane >> 4;
    const int K = g.K, nt = K / BK;
    unsigned voffA[2], voffB[2];
#pragma unroll
    for (int i = 0; i < 2; ++i) { int R, C; stage_rc(tid * 16 + i * 8192, R, C); const int Rb = Epi::PERM ? ((R & ~31) + perm32(R & 31)) : R;
        voffA[i] = (unsigned)(R * K + C) * 2u; voffB[i] = (unsigned)(Rb * K + C) * 2u; }
    const size_t kstep = (size_t)(BK * 2);
    const size_t hstep = (size_t)HALF * K * 2;
    const size_t tstep = 2 * hstep;
    const unsigned ldsw = (unsigned)wid * 1024u;
    const int aoff = lds_byte(wr * 64 + fr, fq * 8), boff = lds_byte(wc * 32 + fr, fq * 8);
#define PG8_SA(b, h) (((b) * 2 + (h)) * HTB)
#define PG8_SB(b, h) ((4 + (b) * 2 + (h)) * HTB)
#define PG8_STAGE(bufoff, gbase, voff) do { _Pragma("unroll") for (int _i = 0; _i < 2; ++_i) \
        __builtin_amdgcn_global_load_lds((const unsigned*)((const char*)(gbase) + (voff)[_i]), (PG8_LAS unsigned*)(lds + (bufoff) + ldsw + _i * 8192), 16, 0, 0); } while (0)
#define PG8_LDA(dst, b, h) do { _Pragma("unroll") for (int m = 0; m < 4; ++m) _Pragma("unroll") for (int k = 0; k < 2; ++k) dst[m][k] = *(const PG8_LAS bf16x8*)(lds + PG8_SA(b, h) + aoff + m * 2048 + k * 1024); } while (0)
#define PG8_LDB(dst, b, h) do { _Pragma("unroll") for (int n = 0; n < 2; ++n) _Pragma("unroll") for (int k = 0; k < 2; ++k) dst[n][k] = *(const PG8_LAS bf16x8*)(lds + PG8_SB(b, h) + boff + n * 2048 + k * 1024); } while (0)
#define PG8_MMA(ai, bj, At, Bt) do { __builtin_amdgcn_s_setprio(1); _Pragma("unroll") for (int m = 0; m < 4; ++m) _Pragma("unroll") for (int n = 0; n < 2; ++n) _Pragma("unroll") for (int k = 0; k < 2; ++k) \
        acc[ai][bj][m][n] = __builtin_amdgcn_mfma_f32_16x16x32_bf16(Bt[n][k], At[m][k], acc[ai][bj][m][n], 0, 0, 0); __builtin_amdgcn_s_setprio(0); } while (0)
#define PG8_WAIT_V(n) asm volatile("s_waitcnt vmcnt(" #n ")" ::: "memory")
#define PG8_WAIT_L(n) asm volatile("s_waitcnt lgkmcnt(" #n ")" ::: "memory")
#define PG8_BAR __builtin_amdgcn_s_barrier()
#define PG8_SCHED __builtin_amdgcn_sched_barrier(0)
    Unit cur, nxt; int ui = 0;
    if (!S.next(0, cur)) return;
    f32x4 acc[2][2][4][2];
#pragma unroll
    for (int a = 0; a < 2; ++a)
#pragma unroll
        for (int b = 0; b < 2; ++b)
#pragma unroll
            for (int m = 0; m < 4; ++m)
#pragma unroll
                for (int n = 0; n < 2; ++n) acc[a][b][m][n] = (f32x4){0.f, 0.f, 0.f, 0.f};
    bf16x8 At[4][2], B0[2][2], B1[2][2];
    const char* cA = (const char*)g.A + (size_t)cur.pm * tstep; const char* cB = (const char*)g.Bt + (size_t)cur.pn * tstep;
    S.a_ready(cur);
    if constexpr (SP2) {
        PG8_STAGE(PG8_SB(0, 0), cB, voffB); PG8_STAGE(PG8_SB(0, 1), cB + hstep, voffB); PG8_STAGE(PG8_SA(0, 0), cA, voffA); PG8_STAGE(PG8_SA(0, 1), cA + hstep, voffA);
        if (wr == 1) PG8_BAR;
        PG8_WAIT_V(2); PG8_BAR;
        PG8_STAGE(PG8_SB(1, 0), cB + kstep, voffB); PG8_STAGE(PG8_SA(1, 0), cA + kstep, voffA); PG8_STAGE(PG8_SB(1, 1), cB + hstep + kstep, voffB);
        PG8_WAIT_V(6); PG8_BAR;
    } else {
        PG8_STAGE(PG8_SB(0, 0), cB, voffB); PG8_STAGE(PG8_SA(0, 0), cA, voffA); PG8_STAGE(PG8_SB(0, 1), cB + hstep, voffB); PG8_STAGE(PG8_SA(0, 1), cA + hstep, voffA);
        if (wr == 1) PG8_BAR;
        PG8_WAIT_V(4); PG8_BAR;
        PG8_STAGE(PG8_SB(1, 0), cB + kstep, voffB); PG8_STAGE(PG8_SA(1, 0), cA + kstep, voffA); PG8_STAGE(PG8_SB(1, 1), cB + hstep + kstep, voffB);
        PG8_WAIT_V(6); PG8_BAR;
    }
    for (;;) {
        const bool has_next = S.next(ui + 1, nxt);
        const char* nA = has_next ? (const char*)g.A + (size_t)nxt.pm * tstep : cA; const char* nB = has_next ? (const char*)g.Bt + (size_t)nxt.pn * tstep : cB;
        for (int t = 0; t < nt; t += 2) {
            const bool last = (t == nt - 2);
            const char* a1 = cA + (size_t)(t + 1) * kstep;
            const char* a2 = last ? nA : cA + (size_t)(t + 2) * kstep; const char* b2 = last ? nB : cB + (size_t)(t + 2) * kstep;
            const char* a3 = a2 + kstep; const char* b3 = b2 + kstep;
            if (last && has_next) S.a_ready(nxt);
            if constexpr (SP2) {
            PG8_LDB(B0, 0, 0); PG8_LDB(B1, 0, 1); PG8_SCHED; PG8_LDA(At, 0, 0); PG8_STAGE(PG8_SA(1, 1), a1 + hstep, voffA);
            PG8_WAIT_V(8); PG8_WAIT_L(0); PG8_BAR; PG8_MMA(0, 0, At, B0); PG8_MMA(0, 1, At, B1); PG8_BAR; PG8_SCHED;
            PG8_LDA(At, 0, 1); PG8_STAGE(PG8_SB(0, 0), b2, voffB); PG8_STAGE(PG8_SB(0, 1), b2 + hstep, voffB); PG8_STAGE(PG8_SA(0, 0), a2, voffA);
            PG8_WAIT_V(8); PG8_WAIT_L(0); PG8_BAR; PG8_MMA(1, 0, At, B0); PG8_MMA(1, 1, At, B1); PG8_BAR; PG8_SCHED;
            PG8_LDB(B0, 1, 0); PG8_LDB(B1, 1, 1); PG8_SCHED; PG8_LDA(At, 1, 0); PG8_STAGE(PG8_SA(0, 1), a2 + hstep, voffA);
            PG8_WAIT_V(8); PG8_WAIT_L(0); PG8_BAR; PG8_MMA(0, 0, At, B0); PG8_MMA(0, 1, At, B1); PG8_BAR; PG8_SCHED;
            PG8_LDA(At, 1, 1); PG8_STAGE(PG8_SB(1, 0), b3, voffB); PG8_STAGE(PG8_SB(1, 1), b3 + hstep, voffB); PG8_STAGE(PG8_SA(1, 0), a3, voffA);
            PG8_WAIT_V(8); PG8_WAIT_L(0); PG8_BAR; PG8_MMA(1, 0, At, B0); PG8_MMA(1, 1, At, B1); PG8_BAR; PG8_SCHED;
            } else {
            PG8_LDB(B0, 0, 0); PG8_SCHED; PG8_LDA(At, 0, 0); PG8_STAGE(PG8_SA(1, 1), a1 + hstep, voffA);
            PG8_WAIT_L(8); PG8_BAR; PG8_WAIT_L(0); PG8_MMA(0, 0, At, B0); PG8_BAR; PG8_SCHED;
            PG8_LDB(B1, 0, 1); PG8_STAGE(PG8_SB(0, 0), b2, voffB);
            PG8_BAR; PG8_WAIT_L(0); PG8_MMA(0, 1, At, B1); PG8_BAR;
            PG8_LDA(At, 0, 1); PG8_STAGE(PG8_SA(0, 0), a2, voffA);
            PG8_BAR; PG8_WAIT_L(0); PG8_MMA(1, 0, At, B0); PG8_BAR; PG8_SCHED;
            PG8_STAGE(PG8_SB(0, 1), b2 + hstep, voffB);
            PG8_WAIT_V(6); PG8_BAR; PG8_MMA(1, 1, At, B1); PG8_BAR;
            PG8_LDB(B0, 1, 0); PG8_SCHED; PG8_LDA(At, 1, 0); PG8_STAGE(PG8_SA(0, 1), a2 + hstep, voffA);
            PG8_WAIT_L(8); PG8_BAR; PG8_WAIT_L(0); PG8_MMA(0, 0, At, B0); PG8_BAR; PG8_SCHED;
            PG8_LDB(B1, 1, 1); PG8_STAGE(PG8_SB(1, 0), b3, voffB);
            PG8_BAR; PG8_WAIT_L(0); PG8_MMA(0, 1, At, B1); PG8_BAR;
            PG8_LDA(At, 1, 1); PG8_STAGE(PG8_SA(1, 0), a3, voffA);
            PG8_BAR; PG8_WAIT_L(0); PG8_MMA(1, 0, At, B0); PG8_BAR; PG8_SCHED;
            PG8_STAGE(PG8_SB(1, 1), b3 + hstep, voffB);
            PG8_WAIT_V(6); PG8_BAR; PG8_MMA(1, 1, At, B1); PG8_BAR;
            }
        }
        if constexpr (ALIGN_EPI) { if (wr == 0) PG8_BAR; }
        if constexpr (!Epi::AFTER_DRAIN) { E(acc, cur, wr, wc, fr, fq); S.done(cur); }
        if (!has_next) break;
#pragma unroll
        for (int a = 0; a < 2; ++a)
#pragma unroll
            for (int b = 0; b < 2; ++b)
#pragma unroll
                for (int m = 0; m < 4; ++m)
#pragma unroll
                    for (int n = 0; n < 2; ++n) acc[a][b][m][n] = (f32x4){0.f, 0.f, 0.f, 0.f};
        cur = nxt; cA = nA; cB = nB; ++ui;
        if constexpr (ALIGN_EPI) { if (wr == 1) PG8_BAR; }
    }
    PG8_WAIT_V(0);
    if constexpr (!ALIGN_EPI) { if (wr == 0) PG8_BAR; }
    PG8_BAR;
    if constexpr (Epi::AFTER_DRAIN) { E.fused(acc, cur, wr, wc, fr, fq, lds, wid, lane); S.done(cur); }
#undef PG8_SA
#undef PG8_SB
#undef PG8_STAGE
#undef PG8_LDA
#undef PG8_LDB
#undef PG8_MMA
#undef PG8_WAIT_V
#undef PG8_WAIT_L
#undef PG8_BAR
#undef PG8_SCHED
}
__device__ __forceinline__ float bf2f(unsigned short b) { return __uint_as_float((unsigned)b << 16); }
__device__ __forceinline__ float sigm(float x) { return __builtin_amdgcn_rcpf(1.0f + __expf(-x)); }
__device__ __forceinline__ u32x4 pack8(const f32x4 a, const f32x4 b) { u32x4 w; w.x = cvt_pk_bf16(a[0], a[1]); w.y = cvt_pk_bf16(a[2], a[3]); w.z = cvt_pk_bf16(b[0], b[1]); w.w = cvt_pk_bf16(b[2], b[3]); return w; }
__device__ __forceinline__ void unpack8(const u32x4 w, f32x4& a, f32x4& b) {
    a[0] = __uint_as_float(w.x << 16); a[1] = __uint_as_float(w.x & 0xffff0000u); a[2] = __uint_as_float(w.y << 16); a[3] = __uint_as_float(w.y & 0xffff0000u);
    b[0] = __uint_as_float(w.z << 16); b[1] = __uint_as_float(w.z & 0xffff0000u); b[2] = __uint_as_float(w.w << 16); b[3] = __uint_as_float(w.w & 0xffff0000u); }
__device__ __forceinline__ f32x4 sigm4(f32x4 v) { f32x4 r; r[0] = sigm(v[0]); r[1] = sigm(v[1]); r[2] = sigm(v[2]); r[3] = sigm(v[3]); return r; }

struct EpiIn {
    static constexpr bool PERM = true, AFTER_DRAIN = false;
    const float* rstd; bf16_t *CU, *Q, *K, *V, *GC, *GA; float* out;
    __device__ __forceinline__ void operator()(const f32x4 (&acc)[2][2][4][2], const Unit& u, int wr, int wc, int fr, int fq) const {
        const int pn = u.pn, row0 = u.pm * BM + wr * 64 + fr, cl = wc * 32 + 8 * fq;
#pragma unroll
        for (int ai = 0; ai < 2; ++ai)
#pragma unroll
            for (int m = 0; m < 4; ++m) {
                const int row = row0 + ai * HALF + m * 16; const float rs = rstd[row];
                if (pn < 4) {
                    const f32x4 a0 = acc[ai][0][m][0] * rs, a1 = acc[ai][0][m][1] * rs, g0 = acc[ai][1][m][0] * rs, g1 = acc[ai][1][m][1] * rs;
                    const f32x4 c0 = a0 * sigm4(g0), c1 = a1 * sigm4(g1); const int ch = 128 * pn + cl;
                    *(u32x4*)(CU + (size_t)row * DC + ch) = pack8(c0, c1);
                    float* hd = nullptr;
                    if (row < MP) { const int t = row & (SEQ - 1); if (t >= SEQ - 30) hd = out + OFF_CVP + ((size_t)(row >> 12) * 30 + (t - (SEQ - 30))) * DC + ch; }
                    else { const int sr = row - MP, t = sr & 31; if (t >= 2) hd = out + OFF_CVS + ((size_t)(sr >> 5) * 30 + (t - 2)) * DC + ch; }
                    if (hd) { *(f32x4*)hd = c0; *(f32x4*)(hd + 4) = c1; }
                } else if (pn < 10) {
                    const int which = (pn - 4) >> 1;
#pragma unroll
                    for (int bj = 0; bj < 2; ++bj) {
                        const int col = ((pn - 4) & 1) * 256 + bj * HALF + cl; const f32x4 v0 = acc[ai][bj][m][0] * rs, v1 = acc[ai][bj][m][1] * rs;
                        if (which == 0) { *(u32x4*)(Q + (size_t)row * DA + col) = pack8(v0 * QSCALE, v1 * QSCALE); }
                        else { bf16_t* B = which == 1 ? K : V; *(u32x4*)(B + (size_t)row * DA + col) = pack8(v0, v1);
                            float* d = (row < MP) ? out + (which == 1 ? OFF_KP : OFF_VP) + (size_t)row * DA + col : out + (which == 1 ? OFF_KS : OFF_VS) + (size_t)(row - MP) * DA + col;
                            *(f32x4*)d = v0; *(f32x4*)(d + 4) = v1; }
                    }
                } else {
                    bf16_t* B = pn < 14 ? GC : GA;
#pragma unroll
                    for (int bj = 0; bj < 2; ++bj) {
                        const int col = ((pn - 10) & 3) * 256 + bj * HALF + cl; const f32x4 v0 = acc[ai][bj][m][0] * rs, v1 = acc[ai][bj][m][1] * rs;
                        *(u32x4*)(B + (size_t)row * DM + col) = pack8(sigm4(v0), sigm4(v1)); }
                }
            }
    }
};
template <bool ADD> struct EpiMix {
    static constexpr bool PERM = true, AFTER_DRAIN = false;
    const bf16_t* G; bf16_t* MIX;
    __device__ __forceinline__ void operator()(const f32x4 (&acc)[2][2][4][2], const Unit& u, int wr, int wc, int fr, int fq) const {
        const int row0 = u.pm * BM + wr * 64 + fr, col0 = u.pn * BM + wc * 32 + 8 * fq;
#pragma unroll
        for (int ai = 0; ai < 2; ++ai)
#pragma unroll
            for (int m = 0; m < 4; ++m) {
                const size_t ro = (size_t)(row0 + ai * HALF + m * 16) * DM + col0;
#pragma unroll
                for (int bj = 0; bj < 2; ++bj) {
                    f32x4 g0, g1; unpack8(*(const u32x4*)(G + ro + bj * HALF), g0, g1);
                    f32x4 v0 = acc[ai][bj][m][0] * g0, v1 = acc[ai][bj][m][1] * g1;
                    if (ADD) { f32x4 o0, o1; unpack8(*(const u32x4*)(MIX + ro + bj * HALF), o0, o1); v0 += o0; v1 += o1; }
                    *(u32x4*)(MIX + ro + bj * HALF) = pack8(v0, v1); }
            }
    }
};
struct EpiOut {
    static constexpr bool PERM = true, AFTER_DRAIN = false;
    const float *xp, *xs; float* H; bf16_t* HB; float* SS;
    __device__ __forceinline__ void operator()(const f32x4 (&acc)[2][2][4][2], const Unit& u, int wr, int wc, int fr, int fq) const {
        const int row0 = u.pm * BM + wr * 64 + fr, col0 = u.pn * BM + wc * 32 + 8 * fq;
#pragma unroll
        for (int ai = 0; ai < 2; ++ai)
#pragma unroll
            for (int m = 0; m < 4; ++m) {
                const int row = row0 + ai * HALF + m * 16; const size_t ro = (size_t)row * DM + col0;
                const float* xr = (row < MP) ? xp + ro : xs + (ro - (size_t)MP * DM);
                float ss = 0.f;
#pragma unroll
                for (int bj = 0; bj < 2; ++bj) {
                    const f32x4 h0 = acc[ai][bj][m][0] + *(const f32x4*)(xr + bj * HALF), h1 = acc[ai][bj][m][1] + *(const f32x4*)(xr + bj * HALF + 4);
                    *(f32x4*)(H + ro + bj * HALF) = h0; *(f32x4*)(H + ro + bj * HALF + 4) = h1; *(u32x4*)(HB + ro + bj * HALF) = pack8(h0, h1);
                    ss += (h0[0] * h0[0] + h0[1] * h0[1]) + (h0[2] * h0[2] + h0[3] * h0[3]) + (h1[0] * h1[0] + h1[1] * h1[1]) + (h1[2] * h1[2] + h1[3] * h1[3]); }
                ss += __shfl_xor(ss, 16); ss += __shfl_xor(ss, 32);
                if (fq == 0) SS[(size_t)row * 16 + u.pn * 4 + wc] = ss;
            }
    }
};
struct EpiGU {
    static constexpr bool PERM = true, AFTER_DRAIN = false;
    const float* SS; bf16_t* ACT;
    __device__ __forceinline__ void operator()(const f32x4 (&acc)[2][2][4][2], const Unit& u, int wr, int wc, int fr, int fq) const {
        const int row0 = u.pm * BM + wr * 64 + fr, ch = u.pn * HALF + wc * 32 + 8 * fq;
#pragma unroll
        for (int ai = 0; ai < 2; ++ai)
#pragma unroll
            for (int m = 0; m < 4; ++m) {
                const int row = row0 + ai * HALF + m * 16; const f32x4* sp = (const f32x4*)(SS + (size_t)row * 16);
                const f32x4 s0 = sp[0], s1 = sp[1], s2 = sp[2], s3 = sp[3];
                const float tot = ((s0[0] + s0[1]) + (s0[2] + s0[3])) + ((s1[0] + s1[1]) + (s1[2] + s1[3])) + ((s2[0] + s2[1]) + (s2[2] + s2[3])) + ((s3[0] + s3[1]) + (s3[2] + s3[3]));
                const float rs = 1.0f / sqrtf(tot * (1.0f / DM) + 1e-6f);
                const f32x4 g0 = acc[ai][0][m][0] * rs, g1 = acc[ai][0][m][1] * rs, u0 = acc[ai][1][m][0] * rs, u1 = acc[ai][1][m][1] * rs;
                *(u32x4*)(ACT + (size_t)row * DFF + ch) = pack8(g0 * sigm4(g0) * u0, g1 * sigm4(g1) * u1);
            }
    }
};
struct EpiDown {
    static constexpr bool PERM = true, AFTER_DRAIN = false;
    const float* H; float* Y; float* SS;
    __device__ __forceinline__ void operator()(const f32x4 (&acc)[2][2][4][2], const Unit& u, int wr, int wc, int fr, int fq) const {
        const int row0 = u.pm * BM + wr * 64 + fr, col0 = u.pn * BM + wc * 32 + 8 * fq;
#pragma unroll
        for (int ai = 0; ai < 2; ++ai)
#pragma unroll
            for (int m = 0; m < 4; ++m) {
                const int row = row0 + ai * HALF + m * 16; const size_t ro = (size_t)row * DM + col0;
                float ss = 0.f;
#pragma unroll
                for (int bj = 0; bj < 2; ++bj) {
                    const f32x4 h0 = acc[ai][bj][m][0] + *(const f32x4*)(H + ro + bj * HALF), h1 = acc[ai][bj][m][1] + *(const f32x4*)(H + ro + bj * HALF + 4);
                    *(f32x4*)(Y + ro + bj * HALF) = h0; *(f32x4*)(Y + ro + bj * HALF + 4) = h1;
                    ss += (h0[0] * h0[0] + h0[1] * h0[1]) + (h0[2] * h0[2] + h0[3] * h0[3]) + (h1[0] * h1[0] + h1[1] * h1[1]) + (h1[2] * h1[2] + h1[3] * h1[3]); }
                ss += __shfl_xor(ss, 16); ss += __shfl_xor(ss, 32);
                if (fq == 0) SS[(size_t)row * 16 + u.pn * 4 + wc] = ss;
            }
    }
};
}
#define LAS __attribute__((address_space(3)))
typedef unsigned short bf16;
typedef LAS unsigned char* ldsp;
typedef __attribute__((ext_vector_type(8))) short bf16x8;
typedef __attribute__((ext_vector_type(4))) short s16x4;
typedef __attribute__((ext_vector_type(16))) float f32x16;
typedef __attribute__((ext_vector_type(4))) float f32x4;
typedef __attribute__((ext_vector_type(4))) unsigned u32x4;
typedef __attribute__((ext_vector_type(2))) unsigned u32x2;
constexpr int NWAVES = 8, NTHREADS = 512;
constexpr int LDS_BYTES = 147456;
constexpr int LDS_QW = 137216;

__device__ __forceinline__ float wave_sum(float v) {
#pragma unroll
    for (int o = 1; o < 64; o <<= 1) v += __shfl_xor(v, o);
    return v;
}
__device__ __forceinline__ float bf2f(unsigned short b) { return __uint_as_float((unsigned)b << 16); }
__device__ __forceinline__ unsigned cvtpk(float lo, float hi) { return pg8::cvt_pk_bf16(lo, hi); }
#define BLOCK_BAR() asm volatile("s_waitcnt vmcnt(0) lgkmcnt(0)\n\ts_barrier" ::: "memory")

constexpr size_t MiB = 1u << 20;
constexpr size_t WS_CTL = 0, WS_WIN = 1 * MiB, WS_WPW = 10 * MiB, WS_WAO = 11 * MiB, WS_WOUT = 12 * MiB, WS_WGU = 14 * MiB, WS_WDN = 25 * MiB, WS_RSTD = 31 * MiB,
                 WS_SS = 32 * MiB, WS_SS2 = 34 * MiB, WS_CBP = 36 * MiB, WS_CBS = 37 * MiB, WS_XB = 40 * MiB, WS_CU = 73 * MiB, WS_Q = 90 * MiB, WS_K = 107 * MiB, WS_V = 124 * MiB,
                 WS_GC = 141 * MiB, WS_GA = 174 * MiB, WS_CS = 207 * MiB, WS_AO = 224 * MiB, WS_MIX = 241 * MiB, WS_H = 274 * MiB, WS_HB = 340 * MiB, WS_ACT = 373 * MiB, WS_END = 464 * MiB;
constexpr int CBS_PITCH = 4160;

struct Args { const float* in[21]; float* out; unsigned char* ws; int ph_lo, ph_hi; };

__device__ __forceinline__ void transpose_item(const float* W, int N, int K, int src_col0, int k0, bf16* WT, int dst_row0, const float* gk, LAS float* scr, int lane) {
#pragma unroll 8
    for (int i = 0; i < 32; ++i) { const int kk = 2 * i + (lane >> 5); const float g = gk ? gk[k0 + kk] : 1.0f; scr[kk * 33 + (lane & 31)] = W[(size_t)(k0 + kk) * N + src_col0 + (lane & 31)] * g; }
    asm volatile("s_waitcnt lgkmcnt(0)" ::: "memory");
    const int c = lane & 7;
#pragma unroll
    for (int j = 0; j < 4; ++j) { const int n = (lane >> 3) + 8 * j; const LAS float* s = scr + (8 * c) * 33 + n;
        u32x4 o; o.x = cvtpk(s[0 * 33], s[1 * 33]); o.y = cvtpk(s[2 * 33], s[3 * 33]); o.z = cvtpk(s[4 * 33], s[5 * 33]); o.w = cvtpk(s[6 * 33], s[7 * 33]);
        *(u32x4*)(WT + (size_t)(dst_row0 + n) * K + k0 + 8 * c) = o; }
    asm volatile("s_waitcnt lgkmcnt(0)" ::: "memory");
}

__device__ __forceinline__ void p0_prologue(const Args& a, ldsp lds, int wave, int lane) {
    unsigned char* ws = a.ws;
    const int gw = blockIdx.x * NWAVES + wave, NGW = gridDim.x * NWAVES;
    if (blockIdx.x == 0 && threadIdx.x == 0) __hip_atomic_store((unsigned*)(ws + WS_CTL), 0u, __ATOMIC_RELAXED, __HIP_MEMORY_SCOPE_AGENT);
    LAS float* gwf = (LAS float*)lds;
    { const float* win = a.in[7]; const float* g = a.in[6];
      for (int e = threadIdx.x; e < 8 * DM; e += NTHREADS) { const int k = e >> 3, h = e & 7; gwf[h * DM + k] = win[(size_t)k * DIN + 2560 + h] * g[k]; } }
    LAS float* scr = (LAS float*)(lds + 32768 + wave * 8448);
    constexpr int I_IN = (DM / 64) * (NIN / 32), I_PW = (DC / 64) * (DM / 32), I_AO = (DA / 64) * (DM / 32), I_OUT = (DM / 64) * (DM / 32), I_GU = (DM / 64) * (NGU / 32), I_DN = (DFF / 64) * (DM / 32);
    constexpr int NITEMS = I_IN + I_PW + I_AO + I_OUT + I_GU + I_DN;
    for (int it = gw; it < NITEMS; it += NGW) {
        int r = it;
        if (r < I_IN) { const int nblk = NIN / 32, kb = r / nblk, nb = r % nblk, n = 32 * nb; int src;
            if (n < 1024) { const int pn = n >> 8, rr = n & 255; src = rr < 128 ? 128 * pn + rr : 512 + 128 * pn + (rr - 128); } else if (n < 2560) src = n; else src = n + 8;
            transpose_item(a.in[7], DIN, DM, src, 64 * kb, (bf16*)(ws + WS_WIN), n, a.in[6], scr, lane); continue; } r -= I_IN;
        if (r < I_PW) { const int nblk = DM / 32, kb = r / nblk, nb = r % nblk; transpose_item(a.in[13], DM, DC, 32 * nb, 64 * kb, (bf16*)(ws + WS_WPW), 32 * nb, nullptr, scr, lane); continue; } r -= I_PW;
        if (r < I_AO) { const int nblk = DM / 32, kb = r / nblk, nb = r % nblk; transpose_item(a.in[14], DM, DA, 32 * nb, 64 * kb, (bf16*)(ws + WS_WAO), 32 * nb, nullptr, scr, lane); continue; } r -= I_AO;
        if (r < I_OUT) { const int nblk = DM / 32, kb = r / nblk, nb = r % nblk; transpose_item(a.in[15], DM, DM, 32 * nb, 64 * kb, (bf16*)(ws + WS_WOUT), 32 * nb, nullptr, scr, lane); continue; } r -= I_OUT;
        if (r < I_GU) { const int nblk = NGU / 32, kb = r / nblk, nb = r % nblk, n = 32 * nb, pn = n >> 8, rr = n & 255;
            const float* src = rr < 128 ? a.in[17] : a.in[18]; const int sc = rr < 128 ? 128 * pn + rr : 128 * pn + (rr - 128);
            transpose_item(src, DFF, DM, sc, 64 * kb, (bf16*)(ws + WS_WGU), n, a.in[16], scr, lane); continue; } r -= I_GU;
        { const int nblk = DM / 32, kb = r / nblk, nb = r % nblk; transpose_item(a.in[19], DM, DFF, 32 * nb, 64 * kb, (bf16*)(ws + WS_WDN), 32 * nb, nullptr, scr, lane); }
    }
    __syncthreads();
    float* rstd = (float*)(ws + WS_RSTD); bf16* XB = (bf16*)(ws + WS_XB); const float* bfv = a.in[8];
    for (int m = gw; m < MT; m += NGW) {
        const float* xrow = (m < MP) ? a.in[0] + (size_t)m * DM : a.in[1] + (size_t)(m - MP) * DM;
        const f32x4* xr = (const f32x4*)xrow + lane;
        f32x4 v[4]; float s = 0.f;
#pragma unroll
        for (int j = 0; j < 4; ++j) { v[j] = xr[64 * j]; s += (v[j].x * v[j].x + v[j].y * v[j].y) + (v[j].z * v[j].z + v[j].w * v[j].w); }
        const float rs = 1.0f / sqrtf(wave_sum(s) * (1.0f / DM) + 1e-6f);
        unsigned long long* o8 = (unsigned long long*)(XB + (size_t)m * DM) + lane;
#pragma unroll
        for (int j = 0; j < 4; ++j) o8[64 * j] = (unsigned long long)cvtpk(v[j].x, v[j].y) | ((unsigned long long)cvtpk(v[j].z, v[j].w) << 32);
        float f[8];
#pragma unroll
        for (int h = 0; h < 8; ++h) { float acc = 0.f;
#pragma unroll
            for (int j = 0; j < 4; ++j) { const f32x4 w = *(const LAS f32x4*)(gwf + h * DM + 4 * lane + 256 * j); acc += (v[j].x * w.x + v[j].y * w.y) + (v[j].z * w.z + v[j].w * w.w); }
            f[h] = wave_sum(acc); }
        float fl = f[0];
#pragma unroll
        for (int h = 1; h < 8; ++h) fl = (lane == h) ? f[h] : fl;
        if (lane == 0) rstd[m] = rs;
        if (lane < 8) { const float z = fl * rs + bfv[lane]; const float lf = fminf(z, 0.f) - log1pf(expf(-fabsf(z)));
            float* dst = (m < MP) ? a.out + OFF_LFP + (size_t)m * NH + lane : a.out + OFF_LFS + (size_t)(m - MP) * NH + lane; *dst = lf; }
    }
}

__device__ __forceinline__ void cumsum_phase(const Args& a, int wave, int lane) {
    const int gw = blockIdx.x * NWAVES + wave;
    if (gw >= 160) return;
    unsigned char* ws = a.ws;
    const float* src; float* dst; const float* extra = nullptr;
    if (gw < 32) { const int b = gw >> 3, h = gw & 7; src = a.out + OFF_LFP + (size_t)b * SEQ * NH + h; dst = (float*)(ws + WS_CBP) + (size_t)gw * SEQ; }
    else { const int s = gw - 32, b = s >> 3, h = s & 7; src = a.in[4] + (size_t)b * PAST * NH + h; dst = (float*)(ws + WS_CBS) + (size_t)s * CBS_PITCH; extra = a.out + OFF_LFS + (size_t)b * DS * NH + h; }
    const float* p = src + (size_t)lane * 64 * NH;
    float tot = 0.f;
    for (int i = 0; i < 64; ++i) tot += p[i * NH];
    float incl = tot;
#pragma unroll
    for (int o = 1; o < 64; o <<= 1) { const float t = __shfl_up(incl, o); if (lane >= o) incl += t; }
    float run = incl - tot;
    for (int i = 0; i < 64; ++i) { run += p[i * NH]; dst[lane * 64 + i] = -run * LOG2E; }
    if (extra) {
        const float total = __shfl(incl, 63);
        float v = (lane < 32) ? extra[lane * NH] : 0.f; float ic = v;
#pragma unroll
        for (int o = 1; o < 64; o <<= 1) { const float t = __shfl_up(ic, o); if (lane >= o) ic += t; }
        dst[PAST + lane] = (lane < 32) ? -(total + ic) * LOG2E : 0.f;
    }
}

namespace att {
__device__ __forceinline__ int crow(int r, int hi) { return (r & 3) + 8 * (r >> 2) + 4 * hi; }
#define SBAR() __builtin_amdgcn_sched_barrier(0)
__device__ __forceinline__ void qkt(f32x16& p0, f32x16& p1, const LAS unsigned char* Kslot, const bf16x8* qr, int r32, int hi) {
    const LAS unsigned char* kb = Kslot + hi * 1024 + r32 * 16;
    f32x16 z = {};
#pragma unroll
    for (int d0 = 0; d0 < 4; ++d0) {
        const bf16x8 b0 = *(const LAS bf16x8*)(kb + d0 * 2048), b1 = *(const LAS bf16x8*)(kb + d0 * 2048 + 512);
        if (d0 == 0) { p0 = __builtin_amdgcn_mfma_f32_32x32x16_bf16(b0, qr[0], z, 0, 0, 0); p1 = __builtin_amdgcn_mfma_f32_32x32x16_bf16(b1, qr[0], z, 0, 0, 0); }
        else { p0 = __builtin_amdgcn_mfma_f32_32x32x16_bf16(b0, qr[d0], p0, 0, 0, 0); p1 = __builtin_amdgcn_mfma_f32_32x32x16_bf16(b1, qr[d0], p1, 0, 0, 0); } }
}
__device__ __forceinline__ void pv(f32x16* o, int vb, bf16x8 pa0, bf16x8 pa1, bf16x8 pa2, bf16x8 pa3) {
#pragma unroll
    for (int d0 = 0; d0 < 2; ++d0) { s16x4 lo[4], hi[4];
#pragma unroll
        for (int ks = 0; ks < 4; ++ks) {
            asm volatile("ds_read_b64_tr_b16 %0,%1 offset:%c2" : "=&v"(lo[ks]) : "v"(vb), "i"(d0 * 4096 + ks * 1024) : "memory");
            asm volatile("ds_read_b64_tr_b16 %0,%1 offset:%c2" : "=&v"(hi[ks]) : "v"(vb), "i"(d0 * 4096 + ks * 1024 + 512) : "memory"); }
        asm volatile("s_waitcnt lgkmcnt(0)" ::: "memory"); SBAR();
#define PK(k) (bf16x8){lo[k][0], lo[k][1], lo[k][2], lo[k][3], hi[k][0], hi[k][1], hi[k][2], hi[k][3]}
        o[d0] = __builtin_amdgcn_mfma_f32_32x32x16_bf16(pa0, PK(0), o[d0], 0, 0, 0);
        o[d0] = __builtin_amdgcn_mfma_f32_32x32x16_bf16(pa1, PK(1), o[d0], 0, 0, 0);
        o[d0] = __builtin_amdgcn_mfma_f32_32x32x16_bf16(pa2, PK(2), o[d0], 0, 0, 0);
        o[d0] = __builtin_amdgcn_mfma_f32_32x32x16_bf16(pa3, PK(3), o[d0], 0, 0, 0);
#undef PK
    }
}
__device__ __forceinline__ float rowmax(const f32x16& p0, const f32x16& p1) {
    float m = fmaxf(p0[0], p1[0]);
#pragma unroll
    for (int r = 1; r < 16; ++r) m = fmaxf(m, fmaxf(p0[r], p1[r]));
    auto rr = __builtin_amdgcn_permlane32_swap(__float_as_uint(m), __float_as_uint(m), false, false);
    return fmaxf(__uint_as_float(rr[0]), __uint_as_float(rr[1]));
}
__device__ __forceinline__ void tile_a(const LAS unsigned char* Kslot, const LAS float* bs, const bf16x8* qr, bool mask, int koff, int qrel, int r32, int hi,
                                          float& m_run, float& l_run, f32x16* o, LAS float* wsf, u32x4& pw0, u32x4& pw1, u32x4& pw2, u32x4& pw3) {
    f32x16 p0, p1; qkt(p0, p1, Kslot, qr, r32, hi);
#pragma unroll
    for (int i = 0; i < 4; ++i) { const f32x4 b0 = *(const LAS f32x4*)(bs + 8 * i + 4 * hi), b1 = *(const LAS f32x4*)(bs + 32 + 8 * i + 4 * hi);
#pragma unroll
        for (int j = 0; j < 4; ++j) { p0[4 * i + j] += b0[j]; p1[4 * i + j] += b1[j]; } }
    if (mask) {
#pragma unroll
        for (int r = 0; r < 16; ++r) { const int kv = koff + crow(r, hi); if (kv > qrel) p0[r] = -INFINITY; if (kv + 32 > qrel) p1[r] = -INFINITY; } }
    const float rm = rowmax(p0, p1);
    const float mn = fmaxf(m_run, rm), f = __builtin_amdgcn_exp2f(m_run - mn); m_run = mn;
    float s = 0.f;
#pragma unroll
    for (int r = 0; r < 16; ++r) { p0[r] = __builtin_amdgcn_exp2f(p0[r] - mn); p1[r] = __builtin_amdgcn_exp2f(p1[r] - mn); s += p0[r] + p1[r]; }
    l_run = l_run * f + s;
    if (hi == 0) wsf[r32] = f;
    asm volatile("s_waitcnt lgkmcnt(0)" ::: "memory");
#pragma unroll
    for (int i = 0; i < 4; ++i) { const f32x4 fv = *(const LAS f32x4*)(wsf + 8 * i + 4 * hi);
#pragma unroll
        for (int j = 0; j < 4; ++j) { o[0][4 * i + j] *= fv[j]; o[1][4 * i + j] *= fv[j]; } }
#pragma unroll
    for (int j = 0; j < 4; ++j) { pw0[j] = cvtpk(p0[2 * j], p0[2 * j + 1]); pw1[j] = cvtpk(p0[8 + 2 * j], p0[9 + 2 * j]); pw2[j] = cvtpk(p1[2 * j], p1[2 * j + 1]); pw3[j] = cvtpk(p1[8 + 2 * j], p1[9 + 2 * j]); }
}
__device__ __forceinline__ void tile_core(const LAS unsigned char* Kslot, int vb, const LAS float* bs, const bf16x8* qr, bool mask, int koff, int qrel, int r32, int hi,
                                          float& m_run, float& l_run, f32x16* o, LAS float* wsf) {
    u32x4 pw0, pw1, pw2, pw3;
    tile_a(Kslot, bs, qr, mask, koff, qrel, r32, hi, m_run, l_run, o, wsf, pw0, pw1, pw2, pw3);
    pv(o, vb, __builtin_bit_cast(bf16x8, pw0), __builtin_bit_cast(bf16x8, pw1), __builtin_bit_cast(bf16x8, pw2), __builtin_bit_cast(bf16x8, pw3));
}
__device__ __forceinline__ int vbase(int lane, int hi) { return ((lane >> 4) & 1) * 32 + (lane & 3) * 8 + (4 * hi + ((lane & 15) >> 2)) * 64; }

constexpr int PL_K = 0, PL_V = 16384, PL_B = 32768, PL_WS = 33280, PL_OST = 36864;
__device__ __forceinline__ void prompt_unit(int b, int h, int qb, const bf16* Q, const bf16* K, const bf16* V, const float* CB, bf16* O, ldsp lds) {
    int tid_ = threadIdx.x; asm volatile("" : "+v"(tid_));
    const int tid = tid_, lane = tid & 63, r32 = lane & 31, hi = lane >> 5; const int wid = __builtin_amdgcn_readfirstlane(tid >> 6);
    const size_t rowbase = (size_t)b * SEQ; const int q0 = qb * 256;
    const bf16* Qw = Q + (rowbase + q0 + wid * 32) * DA + h * HD;
    const bf16* Kh = K + rowbase * DA + h * HD; const bf16* Vh = V + rowbase * DA + h * HD;
    const float* cb = CB + (size_t)(b * NH + h) * SEQ;
    const bf16* ksrc = Kh + (size_t)lane * DA + wid * 8;
    const bf16* vsrc = Vh + (size_t)(16 * (wid & 3) + (lane >> 2)) * DA + (wid >> 2) * 32 + (lane & 3) * 8;
    const int NT = (q0 + 256) / 64;
#define DMA_TILE(t, slot) do { \
        __builtin_amdgcn_global_load_lds((const unsigned*)(ksrc + (size_t)(t) * 64 * DA), (LAS unsigned*)(lds + PL_K + (slot) * 8192 + wid * 1024), 16, 0, 0); \
        __builtin_amdgcn_global_load_lds((const unsigned*)(vsrc + (size_t)(t) * 64 * DA), (LAS unsigned*)(lds + PL_V + (slot) * 8192 + wid * 1024), 16, 0, 0); \
        if (wid == 0) __builtin_amdgcn_global_load_lds((const unsigned*)(cb + (t) * 64 + lane), (LAS unsigned*)(lds + PL_B + (slot) * 256), 4, 0, 0); } while (0)
    DMA_TILE(0, 0);
    bf16x8 qr[4];
#pragma unroll
    for (int d0 = 0; d0 < 4; ++d0) qr[d0] = *(const bf16x8*)(Qw + (size_t)r32 * DA + d0 * 16 + hi * 8);
    float m_run = -1e30f, l_run = 0.f; f32x16 o[2]; o[0] = f32x16{}; o[1] = f32x16{};
    LAS float* wsf = (LAS float*)(lds + PL_WS + wid * 256);
    const int lds0 = (int)(unsigned)(uintptr_t)lds;
    const int vb0 = lds0 + PL_V + vbase(lane, hi);
    const int qrel = wid * 32 + r32;
    for (int t = 0; t < NT; ++t) {
        BLOCK_BAR();
        const int slot = t & 1;
        if (t + 1 < NT) DMA_TILE(t + 1, slot ^ 1);
        const int jb = t - (NT - 4);
        if (jb < 0 || 64 * jb <= wid * 32 + 31)
            tile_core(lds + PL_K + slot * 8192, vb0 + slot * 8192, (const LAS float*)(lds + PL_B + slot * 256), qr, jb >= 0, 64 * jb, qrel, r32, hi, m_run, l_run, o, wsf);
    }
#undef DMA_TILE
    { auto rr = __builtin_amdgcn_permlane32_swap(__float_as_uint(l_run), __float_as_uint(l_run), false, false); l_run = __uint_as_float(rr[0]) + __uint_as_float(rr[1]); }
    if (hi == 0) wsf[32 + r32] = l_run;
    asm volatile("s_waitcnt lgkmcnt(0)" ::: "memory");
    float rli[16];
#pragma unroll
    for (int r = 0; r < 16; ++r) rli[r] = 1.0f / wsf[32 + crow(r, hi)];
    bf16* Ow = O + (rowbase + q0 + wid * 32) * DA + h * HD;
    { LAS bf16* stg = (LAS bf16*)(lds + PL_OST + wid * 4096);
#pragma unroll
      for (int r = 0; r < 16; ++r) { const int orow = crow(r, hi);
#pragma unroll
          for (int d0 = 0; d0 < 2; ++d0) { const float v = o[d0][r] * rli[r]; stg[orow * 64 + d0 * 32 + r32] = (bf16)(cvtpk(v, v) & 0xffffu); } }
      asm volatile("s_waitcnt lgkmcnt(0)" ::: "memory");
#pragma unroll
      for (int i = 0; i < 4; ++i) { const int row = i * 8 + (lane >> 3), ch = lane & 7; const u32x4 v = *(const LAS u32x4*)(stg + row * 64 + ch * 8); *(u32x4*)(Ow + (size_t)row * DA + ch * 8) = v; } }
    BLOCK_BAR();
}

constexpr int SL_B = 131072, SL_WS = 133120, SL_M = 135168, SL_L = 136192;
__device__ __forceinline__ void sample_unit(int b, int h, const Args& a, ldsp lds) {
    int tid_ = threadIdx.x; asm volatile("" : "+v"(tid_));
    const int tid = tid_, lane = tid & 63, r32 = lane & 31, hi = lane >> 5; const int wid = __builtin_amdgcn_readfirstlane(tid >> 6);
    unsigned char* ws = a.ws;
    const bf16* Q = (const bf16*)(ws + WS_Q); const bf16* Kn = (const bf16*)(ws + WS_K); const bf16* Vn = (const bf16*)(ws + WS_V); bf16* O = (bf16*)(ws + WS_AO);
    const float* cbs = (const float*)(ws + WS_CBS) + (size_t)(b * NH + h) * CBS_PITCH;
    const size_t srow = (size_t)MP + (size_t)b * DS;
    const float* ck = a.in[2] + ((size_t)b * PAST * NH + h) * HD; const float* cv = a.in[3] + ((size_t)b * PAST * NH + h) * HD;
    ldsp Kw = lds + wid * 16384; ldsp Vw = Kw + 8192;
    LAS float* bsw = (LAS float*)(lds + SL_B + wid * 256); LAS float* wsf = (LAS float*)(lds + SL_WS + wid * 256);
    bf16x8 qr[4];
#pragma unroll
    for (int d0 = 0; d0 < 4; ++d0) qr[d0] = *(const bf16x8*)(Q + (srow + r32) * DA + h * HD + d0 * 16 + hi * 8);
    float m_run = -1e30f, l_run = 0.f; f32x16 o[2]; o[0] = f32x16{}; o[1] = f32x16{};
    const int vb0 = (int)(unsigned)(uintptr_t)Vw + vbase(lane, hi);
    const int f4 = lane & 15, kq = lane >> 4; const int voff = (kq * DA + 4 * f4) * 4;
    const __amdgpu_buffer_rsrc_t rk = __builtin_amdgcn_make_buffer_rsrc((void*)ck, 0, PAST * 2048, 0x00027000), rv = __builtin_amdgcn_make_buffer_rsrc((void*)cv, 0, PAST * 2048, 0x00027000);
    const int koffK = (f4 >> 1) * 1024 + (f4 & 1) * 8;
    const int koffV = (f4 >> 3) * 4096 + ((f4 & 7) >> 1) * 16 + (f4 & 1) * 8;
    f32x4 kreg[8];
#pragma unroll
    for (int i = 0; i < 8; ++i) kreg[i] = __builtin_bit_cast(f32x4, __builtin_amdgcn_raw_buffer_load_b128(rk, voff, (512 * wid + 4 * i) * 2048, 0));
    for (int tt = 0; tt < 8; ++tt) {
        const int key0 = 512 * wid + 64 * tt;
        { f32x4 kreg2[8];
#pragma unroll
          for (int i = 0; i < 8; ++i) kreg2[i] = __builtin_bit_cast(f32x4, __builtin_amdgcn_raw_buffer_load_b128(rk, voff, (key0 + 32 + 4 * i) * 2048, 0));
#pragma unroll
          for (int i = 0; i < 8; ++i) { const int key = 4 * i + kq; u32x2 w; w.x = cvtpk(kreg[i].x, kreg[i].y); w.y = cvtpk(kreg[i].z, kreg[i].w); *(LAS u32x2*)(Kw + koffK + key * 16) = w; }
#pragma unroll
          for (int i = 0; i < 8; ++i) { const int key = 32 + 4 * i + kq; u32x2 w; w.x = cvtpk(kreg2[i].x, kreg2[i].y); w.y = cvtpk(kreg2[i].z, kreg2[i].w); *(LAS u32x2*)(Kw + koffK + key * 16) = w; } }
        asm volatile("" ::: "memory");
        f32x4 vreg[16];
#pragma unroll
        for (int i = 0; i < 16; ++i) vreg[i] = __builtin_bit_cast(f32x4, __builtin_amdgcn_raw_buffer_load_b128(rv, voff, (key0 + 4 * i) * 2048, 0));
        bsw[lane] = cbs[key0 + lane];
        asm volatile("s_waitcnt lgkmcnt(0)" ::: "memory");
        u32x4 pw0, pw1, pw2, pw3;
        tile_a(Kw, bsw, qr, false, 0, 0, r32, hi, m_run, l_run, o, wsf, pw0, pw1, pw2, pw3);
        asm volatile("" ::: "memory");
#pragma unroll
        for (int i = 0; i < 16; ++i) { const int key = 4 * i + kq; u32x2 w; w.x = cvtpk(vreg[i].x, vreg[i].y); w.y = cvtpk(vreg[i].z, vreg[i].w); *(LAS u32x2*)(Vw + koffV + (key >> 4) * 1024 + (key & 15) * 64) = w; }
        asm volatile("" ::: "memory");
        if (tt < 7) {
#pragma unroll
            for (int i = 0; i < 8; ++i) kreg[i] = __builtin_bit_cast(f32x4, __builtin_amdgcn_raw_buffer_load_b128(rk, voff, (key0 + 64 + 4 * i) * 2048, 0)); }
        asm volatile("s_waitcnt lgkmcnt(0)" ::: "memory");
        pv(o, vb0, __builtin_bit_cast(bf16x8, pw0), __builtin_bit_cast(bf16x8, pw1), __builtin_bit_cast(bf16x8, pw2), __builtin_bit_cast(bf16x8, pw3));
    }
    if (wid == 7) {
        const int key = lane >> 1, half = lane & 1;
        const u32x4* kp = (const u32x4*)(Kn + (srow + key) * DA + h * HD + half * 32); const u32x4* vp = (const u32x4*)(Vn + (srow + key) * DA + h * HD + half * 32);
#pragma unroll
        for (int c = 0; c < 4; ++c) { *(LAS u32x4*)(Kw + (4 * half + c) * 1024 + key * 16) = kp[c]; *(LAS u32x4*)(Kw + (4 * half + c) * 1024 + (key + 32) * 16) = (u32x4){0u, 0u, 0u, 0u}; }
#pragma unroll
        for (int c = 0; c < 4; ++c) { *(LAS u32x4*)(Vw + (half * 4 + (key >> 4)) * 1024 + ((key & 15) * 4 + c) * 16) = vp[c]; *(LAS u32x4*)(Vw + (half * 4 + 2 + (key >> 4)) * 1024 + ((key & 15) * 4 + c) * 16) = (u32x4){0u, 0u, 0u, 0u}; }
        bsw[lane] = cbs[PAST + lane];
        asm volatile("s_waitcnt lgkmcnt(0)" ::: "memory");
        tile_core(Kw, vb0, bsw, qr, true, 0, r32, r32, hi, m_run, l_run, o, wsf);
    }
    { auto rr = __builtin_amdgcn_permlane32_swap(__float_as_uint(l_run), __float_as_uint(l_run), false, false); l_run = __uint_as_float(rr[0]) + __uint_as_float(rr[1]); }
    LAS float* Mw = (LAS float*)(lds + SL_M); LAS float* Lw = (LAS float*)(lds + SL_L);
    if (hi == 0) { Mw[wid * 32 + r32] = m_run; Lw[wid * 32 + r32] = l_run; }
    BLOCK_BAR();
    float M = -1e30f;
#pragma unroll
    for (int w = 0; w < 8; ++w) M = fmaxf(M, Mw[w * 32 + r32]);
    float L = 0.f;
#pragma unroll
    for (int w = 0; w < 8; ++w) L += Lw[w * 32 + r32] * __builtin_amdgcn_exp2f(Mw[w * 32 + r32] - M);
    const float g = __builtin_amdgcn_exp2f(m_run - M) / L;
    if (hi == 0) wsf[r32] = g;
    asm volatile("s_waitcnt lgkmcnt(0)" ::: "memory");
    LAS float* OW = (LAS float*)Kw;
#pragma unroll
    for (int r = 0; r < 16; ++r) { const int q = crow(r, hi); const float gg = wsf[q];
#pragma unroll
        for (int d0 = 0; d0 < 2; ++d0) OW[q * 64 + d0 * 32 + r32] = o[d0][r] * gg; }
    BLOCK_BAR();
    { const int q = tid >> 4, d = (tid & 15) * 4; f32x4 acc = {0.f, 0.f, 0.f, 0.f};
#pragma unroll
      for (int w = 0; w < 8; ++w) acc += *(const LAS f32x4*)(lds + w * 16384 + (q * 64 + d) * 4);
      u32x2 wv; wv.x = cvtpk(acc.x, acc.y); wv.y = cvtpk(acc.z, acc.w); *(u32x2*)(O + (srow + q) * DA + h * HD + d) = wv; }
    BLOCK_BAR();
}
#undef SBAR
}

__device__ __forceinline__ void conv_unit(int u, const Args& a, ldsp lds) {
    int tid_ = threadIdx.x; asm volatile("" : "+v"(tid_));
    const int tid = tid_, lane = tid & 63; const int wid = __builtin_amdgcn_readfirstlane(tid >> 6);
    unsigned char* ws = a.ws; const bf16* CU = (const bf16*)(ws + WS_CU); bf16* CS = (bf16*)(ws + WS_CS);
    const int row0 = 32 * u, ch = tid;
    const float* wdw = a.in[9]; const float* bdw = a.in[10]; const float* lng = a.in[11]; const float* lnb = a.in[12];
    asm volatile("" : "+s"(wdw), "+s"(bdw), "+s"(lng), "+s"(lnb));
    float w[CW];
#pragma unroll
    for (int j = 0; j < CW; ++j) w[j] = wdw[j * DC + ch];
    const float bias = bdw[ch];
    float in[62];
    if (row0 < MP) { const bool first = (row0 & (SEQ - 1)) == 0;
#pragma unroll
        for (int i = 0; i < 62; ++i) { float v = 0.f; if (!(first && i < 30)) v = bf2f(CU[(size_t)(row0 - 30 + i) * DC + ch]); in[i] = v; } }
    else { const int b = (row0 - MP) >> 5; const float* st = a.in[5] + (size_t)b * 30 * DC + ch;
#pragma unroll
        for (int i = 0; i < 30; ++i) in[i] = st[(size_t)i * DC];
#pragma unroll
        for (int i = 30; i < 62; ++i) in[i] = bf2f(CU[(size_t)(row0 - 30 + i) * DC + ch]); }
    LAS float* Y = (LAS float*)lds;
#pragma unroll
    for (int r = 0; r < 32; ++r) { float acc = bias;
#pragma unroll
        for (int j = 0; j < CW; ++j) acc += w[j] * in[r + j];
        Y[r * DC + ch] = acc; }
    BLOCK_BAR();
    const float* lg = lng + 8 * lane; const float* lb = lnb + 8 * lane;
    const f32x4 g0 = *(const f32x4*)lg, g1 = *(const f32x4*)(lg + 4), b0 = *(const f32x4*)lb, b1 = *(const f32x4*)(lb + 4);
#pragma unroll
    for (int rr = 0; rr < 4; ++rr) { const int r = wid * 4 + rr;
        f32x4 v0 = *(const LAS f32x4*)(Y + r * DC + 8 * lane), v1 = *(const LAS f32x4*)(Y + r * DC + 8 * lane + 4);
        const float mean = wave_sum((v0.x + v0.y) + (v0.z + v0.w) + (v1.x + v1.y) + (v1.z + v1.w)) * (1.0f / DC);
        v0 = v0 - mean; v1 = v1 - mean;
        const float var = wave_sum((v0.x * v0.x + v0.y * v0.y) + (v0.z * v0.z + v0.w * v0.w) + (v1.x * v1.x + v1.y * v1.y) + (v1.z * v1.z + v1.w * v1.w)) * (1.0f / DC);
        const float rs = 1.0f / sqrtf(var + 1e-5f);
        f32x4 y0 = v0 * rs * g0 + b0, y1 = v1 * rs * g1 + b1;
        y0 = y0 * pg8::sigm4(y0); y1 = y1 * pg8::sigm4(y1);
        *(u32x4*)(CS + (size_t)(row0 + r) * DC + 8 * lane) = pg8::pack8(y0, y1); }
    BLOCK_BAR();
}

constexpr int NU_SAMPLE = DB * NH, NU_PROMPT = 4 * NH * 16, NU_CONV = MT / 32, NU_TOTAL = NU_SAMPLE + NU_PROMPT + NU_CONV;
__device__ __forceinline__ void queue_phase(const Args& a, ldsp lds) {
    unsigned char* ws = a.ws; unsigned* ctr = (unsigned*)(ws + WS_CTL);
    volatile LAS unsigned* qw = (volatile LAS unsigned*)(lds + LDS_QW);
    for (;;) {
        if (threadIdx.x == 0) qw[0] = __hip_atomic_fetch_add(ctr, 1u, __ATOMIC_RELAXED, __HIP_MEMORY_SCOPE_AGENT);
        __syncthreads();
        const int id = (int)qw[0];
        __syncthreads();
        if (id >= NU_TOTAL) break;
        if (id < NU_SAMPLE) att::sample_unit(id >> 3, id & 7, a, lds);
        else if (id < NU_SAMPLE + NU_PROMPT) { const int j = id - NU_SAMPLE, qb = 15 - (j >> 5), bh = j & 31;
            att::prompt_unit(bh >> 3, bh & 7, qb, (const bf16*)(ws + WS_Q), (const bf16*)(ws + WS_K), (const bf16*)(ws + WS_V), (const float*)(ws + WS_CBP), (bf16*)(ws + WS_AO), lds); }
        else conv_unit(id - NU_SAMPLE - NU_PROMPT, a, lds);
    }
}

__device__ __forceinline__ void final_norm(const Args& a, int wave, int lane) {
    const int gw = blockIdx.x * NWAVES + wave, NGW = gridDim.x * NWAVES;
    const float* SS2 = (const float*)(a.ws + WS_SS2); const float* g = a.in[20];
    f32x4 gv[4];
#pragma unroll
    for (int j = 0; j < 4; ++j) gv[j] = ((const f32x4*)g)[lane + 64 * j];
    for (int m = gw; m < MT; m += NGW) {
        const float part = (lane < 16) ? SS2[(size_t)m * 16 + lane] : 0.f;
        const float rs = 1.0f / sqrtf(wave_sum(part) * (1.0f / DM) + 1e-6f);
        f32x4* yr = (f32x4*)(a.out + (size_t)m * DM) + lane;
#pragma unroll
        for (int j = 0; j < 4; ++j) { const f32x4 v = yr[64 * j]; yr[64 * j] = v * rs * gv[j]; }
    }
}

constexpr int NPHASE = 8;
__global__ void __launch_bounds__(NTHREADS, 2) fwd_kernel(Args a) {
    extern __shared__ __attribute__((aligned(16))) unsigned char lds_raw[];
    ldsp lds = (ldsp)lds_raw;
    const int tid = threadIdx.x, lane = tid & 63; const int wave = __builtin_amdgcn_readfirstlane(tid >> 6);
    unsigned char* ws = a.ws;
    const int lo = a.ph_lo, hi = a.ph_hi; const int G = gridDim.x, c = blockIdx.x;
#ifdef PHASE_ONLY
#define IN(k) ((k) == PHASE_ONLY && lo <= (k) && (k) < hi)
#else
#define IN(k) (lo <= (k) && (k) < hi)
#endif
#define SEAM(k) do { if (IN(k) && IN((k) + 1)) { cg::this_grid().sync(); } } while (0)
    if (IN(0)) { p0_prologue(a, lds, wave, lane); __syncthreads(); }
    SEAM(0);
    if (IN(1)) {
        cumsum_phase(a, wave, lane);
        pg8::Gemm g{(const bf16*)(ws + WS_XB), (const bf16*)(ws + WS_WIN), MT, NIN, DM}; pg8::StaticOrder S; S.init(MT, NIN, G, c);
        pg8::EpiIn E{(const float*)(ws + WS_RSTD), (bf16*)(ws + WS_CU), (bf16*)(ws + WS_Q), (bf16*)(ws + WS_K), (bf16*)(ws + WS_V), (bf16*)(ws + WS_GC), (bf16*)(ws + WS_GA), a.out};
        pg8::gemm_phase<pg8::EpiIn, pg8::StaticOrder, true, true>(lds, g, S, E);
    }
    SEAM(1);
    if (IN(2)) queue_phase(a, lds);
    SEAM(2);
    if (IN(3)) {
        { pg8::Gemm g{(const bf16*)(ws + WS_CS), (const bf16*)(ws + WS_WPW), MT, DM, DC}; pg8::StaticOrder S; S.init(MT, DM, G, c);
          pg8::EpiMix<false> E{(const bf16*)(ws + WS_GC), (bf16*)(ws + WS_MIX)};
          pg8::gemm_phase<pg8::EpiMix<false>, pg8::StaticOrder, true, true>(lds, g, S, E); }
        asm volatile("s_waitcnt vmcnt(0)" ::: "memory"); __syncthreads();
        { pg8::Gemm g{(const bf16*)(ws + WS_AO), (const bf16*)(ws + WS_WAO), MT, DM, DA}; pg8::StaticOrder S; S.init(MT, DM, G, c);
          pg8::EpiMix<true> E{(const bf16*)(ws + WS_GA), (bf16*)(ws + WS_MIX)};
          pg8::gemm_phase<pg8::EpiMix<true>, pg8::StaticOrder, true, true>(lds, g, S, E); }
    }
    SEAM(3);
    if (IN(4)) {
        pg8::Gemm g{(const bf16*)(ws + WS_MIX), (const bf16*)(ws + WS_WOUT), MT, DM, DM}; pg8::StaticOrder S; S.init(MT, DM, G, c);
        pg8::EpiOut E{a.in[0], a.in[1], (float*)(ws + WS_H), (bf16*)(ws + WS_HB), (float*)(ws + WS_SS)};
        pg8::gemm_phase<pg8::EpiOut, pg8::StaticOrder, true, true>(lds, g, S, E);
    }
    SEAM(4);
    if (IN(5)) {
        pg8::Gemm g{(const bf16*)(ws + WS_HB), (const bf16*)(ws + WS_WGU), MT, NGU, DM}; pg8::StaticOrder S; S.init(MT, NGU, G, c);
        pg8::EpiGU E{(const float*)(ws + WS_SS), (bf16*)(ws + WS_ACT)};
        pg8::gemm_phase<pg8::EpiGU, pg8::StaticOrder, true, true>(lds, g, S, E);
    }
    SEAM(5);
    if (IN(6)) {
        pg8::Gemm g{(const bf16*)(ws + WS_ACT), (const bf16*)(ws + WS_WDN), MT, DM, DFF}; pg8::StaticOrder S; S.init(MT, DM, G, c);
        pg8::EpiDown E{(const float*)(ws + WS_H), a.out, (float*)(ws + WS_SS2)};
        pg8::gemm_phase<pg8::EpiDown, pg8::StaticOrder, true, true>(lds, g, S, E);
    }
    SEAM(6);
    if (IN(7)) final_norm(a, wave, lane);
#undef IN
#undef SEAM
}

#ifndef N_LAUNCHES
#define N_LAUNCHES 1
#endif
extern "C" void kernel_launch(void* const* d_in, const int* in_sizes, int n_in, void* d_out, int out_size, void* d_ws, size_t ws_size, hipStream_t stream) {
    static int grid = 0;
    if (grid == 0) {
        if (n_in != 21 || (size_t)out_size != OUT_TOTAL || ws_size < WS_END) { fprintf(stderr, "kernel_launch: unexpected shapes (n_in %d out %d ws %zu)\n", n_in, out_size, ws_size); grid = -1; return; }
        int dev = 0, cus = 0, per_cu = 0;
        hipGetDevice(&dev); hipDeviceGetAttribute(&cus, hipDeviceAttributeMultiprocessorCount, dev);
        hipFuncSetAttribute((const void*)fwd_kernel, hipFuncAttributeMaxDynamicSharedMemorySize, LDS_BYTES);
        hipOccupancyMaxActiveBlocksPerMultiprocessor(&per_cu, (const void*)fwd_kernel, NTHREADS, LDS_BYTES);
        (void)hipGetLastError();
        if (per_cu < 1) fprintf(stderr, "kernel_launch: occupancy query says %d blocks per CU\n", per_cu);
        grid = cus > 0 ? cus : 256;
    }
    if (grid < 0) return;
    Args a{};
    for (int i = 0; i < 21; ++i) a.in[i] = (const float*)d_in[i];
    a.out = (float*)d_out; a.ws = (unsigned char*)d_ws;
#if N_LAUNCHES == 1
    a.ph_lo = 0; a.ph_hi = NPHASE;
    void* args[] = {&a};
    hipError_t e = hipLaunchCooperativeKernel((const void*)fwd_kernel, dim3(grid), dim3(NTHREADS), args, LDS_BYTES, stream);
    if (e != hipSuccess) fprintf(stderr, "cooperative launch failed: %s (grid %d)\n", hipGetErrorString(e), grid);
#else
    for (int p = 0; p < NPHASE; ++p) { a.ph_lo = p; a.ph_hi = p + 1; hipLaunchKernelGGL(fwd_kernel, dim3(grid), dim3(NTHREADS), LDS_BYTES, stream, a); }
#endif
}
```

```cpp
#include <hip/hip_runtime.h>
#include <hip/hip_cooperative_groups.h>
#include <cstdio>
#include <cstdint>
#include <cmath>
namespace cg = cooperative_groups;
constexpr int DM = 1024, MP = 16384, MS = 512, MT = MP + MS, SEQ = 4096, NH = 8, HD = 64, DA = 512, DC = 512, CW = 31, DFF = 2816, DIN = 4616, PAST = 4096, DB = 16, DS = 32;
constexpr int NIN = 4608, NGU = 2 * DFF;
constexpr size_t OFF_Y = 0, OFF_KP = (size_t)MT * DM, OFF_VP = OFF_KP + (size_t)MP * DA, OFF_LFP = OFF_VP + (size_t)MP * DA, OFF_CVP = OFF_LFP + (size_t)MP * NH,
                 OFF_KS = OFF_CVP + (size_t)4 * 30 * DC, OFF_VS = OFF_KS + (size_t)MS * DA, OFF_LFS = OFF_VS + (size_t)MS * DA, OFF_CVS = OFF_LFS + (size_t)MS * NH, OUT_TOTAL = OFF_CVS + (size_t)DB * 30 * DC;
static_assert(OUT_TOTAL == 35045376, "output size");
constexpr float LOG2E = 1.4426950408889634f;
constexpr float QSCALE = 0.125f * LOG2E;
#define N_LAUNCHES 1
namespace pg8 {
#define PG8_LAS __attribute__((address_space(3)))
typedef unsigned short bf16_t;
typedef short bf16x8 __attribute__((ext_vector_type(8)));
typedef float f32x4 __attribute__((ext_vector_type(4)));
typedef unsigned u32x4 __attribute__((ext_vector_type(4)));
constexpr int BM = 256, BK = 64, HALF = 128, HTB = HALF * BK * 2  , STAGE_BYTES = 8 * HTB, NXCD = 8, WGM = 8;

__host__ __device__ __forceinline__ int lds_byte(int r, int c) { const int st = (r >> 4) * 2 + (c >> 5), rr = r & 15, cc = c & 31, ob = rr * 64 + cc * 2; return st * 1024 + (ob ^ (((ob >> 9) & 1) << 5)); }
__host__ __device__ __forceinline__ void stage_rc(int b, int& R, int& C) { const int st = b / 1024, sb = b % 1024, swz = sb ^ (((sb >> 9) & 1) << 5); R = (st >> 1) * 16 + swz / 64; C = (st & 1) * 32 + (swz % 64) / 2; }
__host__ __device__ __forceinline__ int perm32(int rho) { const int n = rho >> 4, i = rho & 15; return 8 * (i >> 2) + 4 * n + (i & 3); }

struct Unit { int pm, pn; };
struct Gemm { const bf16_t* A; const bf16_t* Bt; int M, N, K; };

struct StaticOrder {
    int nM, nN, nwg, G, c;
    __host__ __device__ void init(int M, int N, int G_, int c_) { nM = M / BM; nN = N / BM; nwg = nM * nN; G = G_; c = c_; }
    __host__ __device__ bool next(int i, Unit& u) const {
        const long L = (long)i * G + c; if (L >= nwg) return false;
        int wgid = (int)L; { const int q = nwg / NXCD, r = nwg % NXCD, xcd = wgid % NXCD, off = wgid / NXCD; wgid = (xcd < r ? xcd * (q + 1) : r * (q + 1) + (xcd - r) * q) + off; }
        const int nig = WGM * nN, gid = wgid / nig, fm = gid * WGM, gsz = (nM - fm) < WGM ? (nM - fm) : WGM;
        u.pm = fm + ((wgid % nig) % gsz); u.pn = (wgid % nig) / gsz; return true;
    }
    __device__ __forceinline__ void a_ready(const Unit&) const {}
    __device__ __forceinline__ void done(const Unit&) const {}
};

__device__ __forceinline__ unsigned cvt_pk_bf16(float lo, float hi) { unsigned r; asm volatile("v_cvt_pk_bf16_f32 %0, %1, %2" : "=v"(r) : "v"(lo), "v"(hi)); return r; }
typedef float f32x2 __attribute__((ext_vector_type(2)));
template <class Epi, class Sched, bool ALIGN_EPI = false, bool SP2 = false>
__device__ __forceinline__ void gemm_phase(PG8_LAS unsigned char* lds, const Gemm g, const Sched& S, const Epi& E) {
    const int tid = threadIdx.x, wid = __builtin_amdgcn_readfirstlane(tid >> 6), lane = tid & 63, wr = wid >> 2, wc = wid & 3, fr = lane & 15, fq = lane >> 4;
    const int K = g.K, nt = K / BK;
    unsigned voffA[2], voffB[2];
#pragma unroll
    for (int i = 0; i < 2; ++i) { int R, C; stage_rc(tid * 16 + i * 8192, R, C); const int Rb = Epi::PERM ? ((R & ~31) + perm32(R & 31)) : R;
        voffA[i] = (unsigned)(R * K + C) * 2u; voffB[i] = (unsigned)(Rb * K + C) * 2u; }
    const size_t kstep = (size_t)(BK * 2);
    const size_t hstep = (size_t)HALF * K * 2;
    const size_t tstep = 2 * hstep;
    const unsigned ldsw = (unsigned)wid * 1024u;
    const int aoff = lds_byte(wr * 64 + fr, fq * 8), boff = lds_byte(wc * 32 + fr, fq * 8);
#define PG8_SA(b, h) (((b) * 2 + (h)) * HTB)
#define PG8_SB(b, h) ((4 + (b) * 2 + (h)) * HTB)
#define PG8_STAGE(bufoff, gbase, voff) do { _Pragma("unroll") for (int _i = 0; _i < 2; ++_i) \
        __builtin_amdgcn_global_load_lds((const unsigned*)((const char*)(gbase) + (voff)[_i]), (PG8_LAS unsigned*)(lds + (bufoff) + ldsw + _i * 8192), 16, 0, 0); } while (0)
#define PG8_LDA(dst, b, h) do { _Pragma("unroll") for (int m = 0; m < 4; ++m) _Pragma("unroll") for (int k = 0; k < 2; ++k) dst[m][k] = *(const PG8_LAS bf16x8*)(lds + PG8_SA(b, h) + aoff + m * 2048 + k * 1024); } while (0)
#define PG8_LDB(dst, b, h) do { _Pragma("unroll") for (int n = 0; n < 2; ++n) _Pragma("unroll") for (int k = 0; k < 2; ++k) dst[n][k] = *(const PG8_LAS bf16x8*)(lds + PG8_SB(b, h) + boff + n * 2048 + k * 1024); } while (0)
#define PG8_MMA(ai, bj, At, Bt) do { __builtin_amdgcn_s_setprio(1); _Pragma("unroll") for (int m = 0; m < 4; ++m) _Pragma("unroll") for (int n = 0; n < 2; ++n) _Pragma("unroll") for (int k = 0; k < 2; ++k) \
        acc[ai][bj][m][n] = __builtin_amdgcn_mfma_f32_16x16x32_bf16(Bt[n][k], At[m][k], acc[ai][bj][m][n], 0, 0, 0); __builtin_amdgcn_s_setprio(0); } while (0)
#define PG8_WAIT_V(n) asm volatile("s_waitcnt vmcnt(" #n ")" ::: "memory")
#define PG8_WAIT_L(n) asm volatile("s_waitcnt lgkmcnt(" #n ")" ::: "memory")
#define PG8_BAR __builtin_amdgcn_s_barrier()
#define PG8_SCHED __builtin_amdgcn_sched_barrier(0)
    Unit cur, nxt; int ui = 0;
    if (!S.next(0, cur)) return;
    f32x4 acc[2][2][4][2];
#pragma unroll
    for (int a = 0; a < 2; ++a)
#pragma unroll
        for (int b = 0; b < 2; ++b)
#pragma unroll
            for (int m = 0; m < 4; ++m)
#pragma unroll
                for (int n = 0; n < 2; ++n) acc[a][b][m][n] = (f32x4){0.f, 0.f, 0.f, 0.f};
    bf16x8 At[4][2], B0[2][2], B1[2][2];
    const char* cA = (const char*)g.A + (size_t)cur.pm * tstep; const char* cB = (const char*)g.Bt + (size_t)cur.pn * tstep;
    S.a_ready(cur);
    if constexpr (SP2) {
        PG8_STAGE(PG8_SB(0, 0), cB, voffB); PG8_STAGE(PG8_SB(0, 1), cB + hstep, voffB); PG8_STAGE(PG8_SA(0, 0), cA, voffA); PG8_STAGE(PG8_SA(0, 1), cA + hstep, voffA);
        if (wr == 1) PG8_BAR;
        PG8_WAIT_V(2); PG8_BAR;
        PG8_STAGE(PG8_SB(1, 0), cB + kstep, voffB); PG8_STAGE(PG8_SA(1, 0), cA + kstep, voffA); PG8_STAGE(PG8_SB(1, 1), cB + hstep + kstep, voffB);
        PG8_WAIT_V(6); PG8_BAR;
    } else {
        PG8_STAGE(PG8_SB(0, 0), cB, voffB); PG8_STAGE(PG8_SA(0, 0), cA, voffA); PG8_STAGE(PG8_SB(0, 1), cB + hstep, voffB); PG8_STAGE(PG8_SA(0, 1), cA + hstep, voffA);
        if (wr == 1) PG8_BAR;
        PG8_WAIT_V(4); PG8_BAR;
        PG8_STAGE(PG8_SB(1, 0), cB + kstep, voffB); PG8_STAGE(PG8_SA(1, 0), cA + kstep, voffA); PG8_STAGE(PG8_SB(1, 1), cB + hstep + kstep, voffB);
        PG8_WAIT_V(6); PG8_BAR;
    }
    for (;;) {
        const bool has_next = S.next(ui + 1, nxt);
        const char* nA = has_next ? (const char*)g.A + (size_t)nxt.pm * tstep : cA; const char* nB = has_next ? (const char*)g.Bt + (size_t)nxt.pn * tstep : cB;
        for (int t = 0; t < nt; t += 2) {
            const bool last = (t == nt - 2);
            const char* a1 = cA + (size_t)(t + 1) * kstep;
            const char* a2 = last ? nA : cA + (size_t)(t + 2) * kstep; const char* b2 = last ? nB : cB + (size_t)(t + 2) * kstep;
            const char* a3 = a2 + kstep; const char* b3 = b2 + kstep;
            if (last && has_next) S.a_ready(nxt);
            if constexpr (SP2) {
            PG8_LDB(B0, 0, 0); PG8_LDB(B1, 0, 1); PG8_SCHED; PG8_LDA(At, 0, 0); PG8_STAGE(PG8_SA(1, 1), a1 + hstep, voffA);
            PG8_WAIT_V(8); PG8_WAIT_L(0); PG8_BAR; PG8_MMA(0, 0, At, B0); PG8_MMA(0, 1, At, B1); PG8_BAR; PG8_SCHED;
            PG8_LDA(At, 0, 1); PG8_STAGE(PG8_SB(0, 0), b2, voffB); PG8_STAGE(PG8_SB(0, 1), b2 + hstep, voffB); PG8_STAGE(PG8_SA(0, 0), a2, voffA);
            PG8_WAIT_V(8); PG8_WAIT_L(0); PG8_BAR; PG8_MMA(1, 0, At, B0); PG8_MMA(1, 1, At, B1); PG8_BAR; PG8_SCHED;
            PG8_LDB(B0, 1, 0); PG8_LDB(B1, 1, 1); PG8_SCHED; PG8_LDA(At, 1, 0); PG8_STAGE(PG8_SA(0, 1), a2 + hstep, voffA);
            PG8_WAIT_V(8); PG8_WAIT_L(0); PG8_BAR; PG8_MMA(0, 0, At, B0); PG8_MMA(0, 1, At, B1); PG8_BAR; PG8_SCHED;
            PG8_LDA(At, 1, 1); PG8_STAGE(PG8_SB(1, 0), b3, voffB); PG8_STAGE(PG8_SB(1, 1), b3 + hstep, voffB); PG8_STAGE(PG8_SA(1, 0), a3, voffA);
            PG8_WAIT_V(8); PG8_WAIT_L(0); PG8_BAR; PG8_MMA(1, 0, At, B0); PG8_MMA(1, 1, At, B1); PG8_BAR; PG8_SCHED;
            } else {
            PG8_LDB(B0, 0, 0); PG8_SCHED; PG8_LDA(At, 0, 0); PG8_STAGE(PG8_SA(1, 1), a1 + hstep, voffA);
            PG8_WAIT_L(8); PG8_BAR; PG8_WAIT_L(0); PG8_MMA(0, 0, At, B0); PG8_BAR; PG8_SCHED;
            PG8_LDB(B1, 0, 1); PG8_STAGE(PG8_SB(0, 0), b2, voffB);
            PG8_BAR; PG8_WAIT_L(0); PG8_MMA(0, 1, At, B1); PG8_BAR;
            PG8_LDA(At, 0, 1); PG8_STAGE(PG8_SA(0, 0), a2, voffA);
            PG8_BAR; PG8_WAIT_L(0); PG8_MMA(1, 0, At, B0); PG8_BAR; PG8_SCHED;
            PG8_STAGE(PG8_SB(0, 1), b2 + hstep, voffB);
            PG8_WAIT_V(6); PG8_BAR; PG8_MMA(1, 1, At, B1); PG8_BAR;
            PG8_LDB(B0, 1, 0); PG8_SCHED; PG8_LDA(At, 1, 0); PG8_STAGE(PG8_SA(0, 1), a2 + hstep, voffA);
            PG8_WAIT_L(8); PG8_BAR; PG8_WAIT_L(0); PG8_MMA(0, 0, At, B0); PG8_BAR; PG8_SCHED;
            PG8_LDB(B1, 1, 1); PG8_STAGE(PG8_SB(1, 0), b3, voffB);
            PG8_BAR; PG8_WAIT_L(0); PG8_MMA(0, 1, At, B1); PG8_BAR;
            PG8_LDA(At, 1, 1); PG8_STAGE(PG8_SA(1, 0), a3, voffA);
            PG8_BAR; PG8_WAIT_L(0); PG8_MMA(1, 0, At, B0); PG8_BAR; PG8_SCHED;
            PG8_STAGE(PG8_SB(1, 1), b3 + hstep, voffB);
            PG8_WAIT_V(6); PG8_BAR; PG8_MMA(1, 1, At, B1); PG8_BAR;
            }
        }
        if constexpr (ALIGN_EPI) { if (wr == 0) PG8_BAR; }
        if constexpr (!Epi::AFTER_DRAIN) { E(acc, cur, wr, wc, fr, fq); S.done(cur); }
        if (!has_next) break;
#pragma unroll
        for (int a = 0; a < 2; ++a)
#pragma unroll
            for (int b = 0; b < 2; ++b)
#pragma unroll
                for (int m = 0; m < 4; ++m)
#pragma unroll
                    for (int n = 0; n < 2; ++n) acc[a][b][m][n] = (f32x4){0.f, 0.f, 0.f, 0.f};
        cur = nxt; cA = nA; cB = nB; ++ui;
        if constexpr (ALIGN_EPI) { if (wr == 1) PG8_BAR; }
    }
    PG8_WAIT_V(0);
    if constexpr (!ALIGN_EPI) { if (wr == 0) PG8_BAR; }
    PG8_BAR;
    if constexpr (Epi::AFTER_DRAIN) { E.fused(acc, cur, wr, wc, fr, fq, lds, wid, lane); S.done(cur); }
#undef PG8_SA
#undef PG8_SB
#undef PG8_STAGE
#undef PG8_LDA
#undef PG8_LDB
#undef PG8_MMA
#undef PG8_WAIT_V
#undef PG8_WAIT_L
#undef PG8_BAR
#undef PG8_SCHED
}
__device__ __forceinline__ float bf2f(unsigned short b) { return __uint_as_float((unsigned)b << 16); }
__device__ __forceinline__ float sigm(float x) { return __builtin_amdgcn_rcpf(1.0f + __expf(-x)); }
__device__ __forceinline__ u32x4 pack8(const f32x4 a, const f32x4 b) { u32x4 w; w.x = cvt_pk_bf16(a[0], a[1]); w.y = cvt_pk_bf16(a[2], a[3]); w.z = cvt_pk_bf16(b[0], b[1]); w.w = cvt_pk_bf16(b[2], b[3]); return w; }
__device__ __forceinline__ void unpack8(const u32x4 w, f32x4& a, f32x4& b) {
    a[0] = __uint_as_float(w.x << 16); a[1] = __uint_as_float(w.x & 0xffff0000u); a[2] = __uint_as_float(w.y << 16); a[3] = __uint_as_float(w.y & 0xffff0000u);
    b[0] = __uint_as_float(w.z << 16); b[1] = __uint_as_float(w.z & 0xffff0000u); b[2] = __uint_as_float(w.w << 16); b[3] = __uint_as_float(w.w & 0xffff0000u); }
__device__ __forceinline__ f32x4 sigm4(f32x4 v) { f32x4 r; r[0] = sigm(v[0]); r[1] = sigm(v[1]); r[2] = sigm(v[2]); r[3] = sigm(v[3]); return r; }

struct EpiIn {
    static constexpr bool PERM = true, AFTER_DRAIN = false;
    const float* rstd; bf16_t *CU, *Q, *K, *V, *GC, *GA; float* out;
    __device__ __forceinline__ void operator()(const f32x4 (&acc)[2][2][4][2], const Unit& u, int wr, int wc, int fr, int fq) const {
        const int pn = u.pn, row0 = u.pm * BM + wr * 64 + fr, cl = wc * 32 + 8 * fq;
#pragma unroll
        for (int ai = 0; ai < 2; ++ai)
#pragma unroll
            for (int m = 0; m < 4; ++m) {
                const int row = row0 + ai * HALF + m * 16; const float rs = rstd[row];
                if (pn < 4) {
                    const f32x4 a0 = acc[ai][0][m][0] * rs, a1 = acc[ai][0][m][1] * rs, g0 = acc[ai][1][m][0] * rs, g1 = acc[ai][1][m][1] * rs;
                    const f32x4 c0 = a0 * sigm4(g0), c1 = a1 * sigm4(g1); const int ch = 128 * pn + cl;
                    *(u32x4*)(CU + (size_t)row * DC + ch) = pack8(c0, c1);
                    float* hd = nullptr;
                    if (row < MP) { const int t = row & (SEQ - 1); if (t >= SEQ - 30) hd = out + OFF_CVP + ((size_t)(row >> 12) * 30 + (t - (SEQ - 30))) * DC + ch; }
                    else { const int sr = row - MP, t = sr & 31; if (t >= 2) hd = out + OFF_CVS + ((size_t)(sr >> 5) * 30 + (t - 2)) * DC + ch; }
                    if (hd) { *(f32x4*)hd = c0; *(f32x4*)(hd + 4) = c1; }
                } else if (pn < 10) {
                    const int which = (pn - 4) >> 1;
#pragma unroll
                    for (int bj = 0; bj < 2; ++bj) {
                        const int col = ((pn - 4) & 1) * 256 + bj * HALF + cl; const f32x4 v0 = acc[ai][bj][m][0] * rs, v1 = acc[ai][bj][m][1] * rs;
                        if (which == 0) { *(u32x4*)(Q + (size_t)row * DA + col) = pack8(v0 * QSCALE, v1 * QSCALE); }
                        else { bf16_t* B = which == 1 ? K : V; *(u32x4*)(B + (size_t)row * DA + col) = pack8(v0, v1);
                            float* d = (row < MP) ? out + (which == 1 ? OFF_KP : OFF_VP) + (size_t)row * DA + col : out + (which == 1 ? OFF_KS : OFF_VS) + (size_t)(row - MP) * DA + col;
                            *(f32x4*)d = v0; *(f32x4*)(d + 4) = v1; }
                    }
                } else {
                    bf16_t* B = pn < 14 ? GC : GA;
#pragma unroll
                    for (int bj = 0; bj < 2; ++bj) {
                        const int col = ((pn - 10) & 3) * 256 + bj * HALF + cl; const f32x4 v0 = acc[ai][bj][m][0] * rs, v1 = acc[ai][bj][m][1] * rs;
                        *(u32x4*)(B + (size_t)row * DM + col) = pack8(sigm4(v0), sigm4(v1)); }
                }
            }
    }
};
template <bool ADD> struct EpiMix {
    static constexpr bool PERM = true, AFTER_DRAIN = false;
    const bf16_t* G; bf16_t* MIX;
    __device__ __forceinline__ void operator()(const f32x4 (&acc)[2][2][4][2], const Unit& u, int wr, int wc, int fr, int fq) const {
        const int row0 = u.pm * BM + wr * 64 + fr, col0 = u.pn * BM + wc * 32 + 8 * fq;
#pragma unroll
        for (int ai = 0; ai < 2; ++ai)
#pragma unroll
            for (int m = 0; m < 4; ++m) {
                const size_t ro = (size_t)(row0 + ai * HALF + m * 16) * DM + col0;
#pragma unroll
                for (int bj = 0; bj < 2; ++bj) {
                    f32x4 g0, g1; unpack8(*(const u32x4*)(G + ro + bj * HALF), g0, g1);
                    f32x4 v0 = acc[ai][bj][m][0] * g0, v1 = acc[ai][bj][m][1] * g1;
                    if (ADD) { f32x4 o0, o1; unpack8(*(const u32x4*)(MIX + ro + bj * HALF), o0, o1); v0 += o0; v1 += o1; }
                    *(u32x4*)(MIX + ro + bj * HALF) = pack8(v0, v1); }
            }
    }
};
struct EpiOut {
    static constexpr bool PERM = true, AFTER_DRAIN = false;
    const float *xp, *xs; float* H; bf16_t* HB; float* SS;
    __device__ __forceinline__ void operator()(const f32x4 (&acc)[2][2][4][2], const Unit& u, int wr, int wc, int fr, int fq) const {
        const int row0 = u.pm * BM + wr * 64 + fr, col0 = u.pn * BM + wc * 32 + 8 * fq;
#pragma unroll
        for (int ai = 0; ai < 2; ++ai)
#pragma unroll
            for (int m = 0; m < 4; ++m) {
                const int row = row0 + ai * HALF + m * 16; const size_t ro = (size_t)row * DM + col0;
                const float* xr = (row < MP) ? xp + ro : xs + (ro - (size_t)MP * DM);
                float ss = 0.f;
#pragma unroll
                for (int bj = 0; bj < 2; ++bj) {
                    const f32x4 h0 = acc[ai][bj][m][0] + *(const f32x4*)(xr + bj * HALF), h1 = acc[ai][bj][m][1] + *(const f32x4*)(xr + bj * HALF + 4);
                    *(f32x4*)(H + ro + bj * HALF) = h0; *(f32x4*)(H + ro + bj * HALF + 4) = h1; *(u32x4*)(HB + ro + bj * HALF) = pack8(h0, h1);
                    ss += (h0[0] * h0[0] + h0[1] * h0[1]) + (h0[2] * h0[2] + h0[3] * h0[3]) + (h1[0] * h1[0] + h1[1] * h1[1]) + (h1[2] * h1[2] + h1[3] * h1[3]); }
                ss += __shfl_xor(ss, 16); ss += __shfl_xor(ss, 32);
                if (fq == 0) SS[(size_t)row * 16 + u.pn * 4 + wc] = ss;
            }
    }
};
struct EpiGU {
    static constexpr bool PERM = true, AFTER_DRAIN = false;
    const float* SS; bf16_t* ACT;
    __device__ __forceinline__ void operator()(const f32x4 (&acc)[2][2][4][2], const Unit& u, int wr, int wc, int fr, int fq) const {
        const int row0 = u.pm * BM + wr * 64 + fr, ch = u.pn * HALF + wc * 32 + 8 * fq;
#pragma unroll
        for (int ai = 0; ai < 2; ++ai)
#pragma unroll
            for (int m = 0; m < 4; ++m) {
                const int row = row0 + ai * HALF + m * 16; const f32x4* sp = (const f32x4*)(SS + (size_t)row * 16);
                const f32x4 s0 = sp[0], s1 = sp[1], s2 = sp[2], s3 = sp[3];
                const float tot = ((s0[0] + s0[1]) + (s0[2] + s0[3])) + ((s1[0] + s1[1]) + (s1[2] + s1[3])) + ((s2[0] + s2[1]) + (s2[2] + s2[3])) + ((s3[0] + s3[1]) + (s3[2] + s3[3]));
                const float rs = 1.0f / sqrtf(tot * (1.0f / DM) + 1e-6f);
                const f32x4 g0 = acc[ai][0][m][0] * rs, g1 = acc[ai][0][m][1] * rs, u0 = acc[ai][1][m][0] * rs, u1 = acc[ai][1][m][1] * rs;
                *(u32x4*)(ACT + (size_t)row * DFF + ch) = pack8(g0 * sigm4(g0) * u0, g1 * sigm4(g1) * u1);
            }
    }
};
struct EpiDown {
    static constexpr bool PERM = true, AFTER_DRAIN = false;
    const float* H; float* Y; float* SS;
    __device__ __forceinline__ void operator()(const f32x4 (&acc)[2][2][4][2], const Unit& u, int wr, int wc, int fr, int fq) const {
        const int row0 = u.pm * BM + wr * 64 + fr, col0 = u.pn * BM + wc * 32 + 8 * fq;
#pragma unroll
        for (int ai = 0; ai < 2; ++ai)
#pragma unroll
            for (int m = 0; m < 4; ++m) {
                const int row = row0 + ai * HALF + m * 16; const size_t ro = (size_t)row * DM + col0;
                float ss = 0.f;
#pragma unroll
                for (int bj = 0; bj < 2; ++bj) {
                    const f32x4 h0 = acc[ai][bj][m][0] + *(const f32x4*)(H + ro + bj * HALF), h1 = acc[ai][bj][m][1] + *(const f32x4*)(H + ro + bj * HALF + 4);
                    *(f32x4*)(Y + ro + bj * HALF) = h0; *(f32x4*)(Y + ro + bj * HALF + 4) = h1;
                    ss += (h0[0] * h0[0] + h0[1] * h0[1]) + (h0[2] * h0[2] + h0[3] * h0[3]) + (h1[0] * h1[0] + h1[1] * h1[1]) + (h1[2] * h1[2] + h1[3] * h1[3]); }
                ss += __shfl_xor(ss, 16); ss += __shfl_xor(ss, 32);
                if (fq == 0) SS[(size_t)row * 16 + u.pn * 4 + wc] = ss;
            }
    }
};
}
#define LAS __attribute__((address_space(3)))
typedef unsigned short bf16;
typedef LAS unsigned char* ldsp;
typedef __attribute__((ext_vector_type(8))) short bf16x8;
typedef __attribute__((ext_vector_type(4))) short s16x4;
typedef __attribute__((ext_vector_type(16))) float f32x16;
typedef __attribute__((ext_vector_type(4))) float f32x4;
typedef __attribute__((ext_vector_type(4))) unsigned u32x4;
typedef __attribute__((ext_vector_type(2))) unsigned u32x2;
constexpr int NWAVES = 8, NTHREADS = 512;
constexpr int LDS_BYTES = 147456;
constexpr int LDS_QW = 137216;
constexpr int LDS_XB = 137232;
constexpr size_t CTL_BAR_BYTE = 16384, CTL_ZERO_BYTES = 65536;

__device__ __forceinline__ float wave_sum(float v) {
#pragma unroll
    for (int o = 1; o < 64; o <<= 1) v += __shfl_xor(v, o);
    return v;
}
__device__ __forceinline__ float bf2f(unsigned short b) { return __uint_as_float((unsigned)b << 16); }
__device__ __forceinline__ unsigned cvtpk(float lo, float hi) { return pg8::cvt_pk_bf16(lo, hi); }
#define BLOCK_BAR() asm volatile("s_waitcnt vmcnt(0) lgkmcnt(0)\n\ts_barrier" ::: "memory")
#define XB_TMO      128
#define XB_XCNT(j)  (256  + 64 * (j))
#define XB_XSUB(j)  (1280 + 64 * (j))
#define XB_XGEN(j)  (2304 + 64 * (j))
#define XB_TOP      3328
#define XB_TOPGEN   3392
#define XCD_BAR_WORDS 3456
#define XB_SPIN_CAP (1u << 18)

__device__ __forceinline__ unsigned xb_ld(unsigned* p)              { return __hip_atomic_load(p, __ATOMIC_RELAXED, __HIP_MEMORY_SCOPE_AGENT); }
__device__ __forceinline__ unsigned xb_add(unsigned* p, unsigned v) { return __hip_atomic_fetch_add(p, v, __ATOMIC_RELAXED, __HIP_MEMORY_SCOPE_AGENT); }
__device__ __forceinline__ unsigned xb_xcc_id() { return (unsigned)__builtin_amdgcn_s_getreg((3 << 11) | 20) & 0xFu; }
#define XB_SPIN(cond, bar) do { unsigned _sp = 0; while (cond) { __builtin_amdgcn_s_sleep(1); \
    if ((++_sp & 255u) == 0u) { if (xb_ld(&(bar)[XB_TMO])) break; if (_sp > XB_SPIN_CAP) { atomicAdd(&(bar)[XB_TMO], 1u); break; } } } } while (0)

struct XcdBarrier {
    unsigned* bar; unsigned x;
    volatile LAS unsigned* st;
};

__device__ __forceinline__ XcdBarrier xcd_barrier_post(unsigned* bar, volatile LAS unsigned* st) {
    XcdBarrier b; b.bar = bar; b.x = xb_xcc_id(); b.st = st;
    if (threadIdx.x == 0) (void)xb_add(&bar[XB_XCNT(b.x)], 1u);
    return b;
}
__device__ __forceinline__ void xcd_barrier_complete(unsigned* bar, unsigned x, unsigned& nloc, unsigned& nx) {
    const unsigned G = gridDim.x * gridDim.y * gridDim.z;
    unsigned sum, cnt, mine, sp = 0u;
    for (;;) {
        sum = 0u; cnt = 0u; mine = 0u;
#pragma unroll
        for (unsigned j = 0; j < 16; ++j) { const unsigned c = xb_ld(&bar[XB_XCNT(j)]); sum += c; cnt += (c > 0u) ? 1u : 0u; mine = (j == x) ? c : mine; }
        if (sum == G) break;
        __builtin_amdgcn_s_sleep(1);
        if ((++sp & 255u) == 0u) { if (xb_ld(&bar[XB_TMO])) break; if (sp > XB_SPIN_CAP) { atomicAdd(&bar[XB_TMO], 1u); break; } }
    }
    nloc = mine > 0u ? mine : 1u; nx = cnt > 0u ? cnt : 1u;
}

__device__ __forceinline__ void xcd_barrier(const XcdBarrier& b) {
    asm volatile("s_waitcnt vmcnt(0)" ::: "memory");
    __syncthreads();
    if (threadIdx.x == 0) {
        unsigned* bar = b.bar;
        __builtin_amdgcn_s_waitcnt(0);
        unsigned nloc = b.st[0], nx = b.st[1];
        if (nloc == 0u) { xcd_barrier_complete(bar, b.x, nloc, nx); b.st[0] = nloc; b.st[1] = nx; }
        const unsigned old = xb_add(&bar[XB_XSUB(b.x)], 1u);
        const unsigned gen = old / nloc;
        if (old + 1u == (gen + 1u) * nloc) {
            __builtin_amdgcn_fence(__ATOMIC_RELEASE, "agent");
            asm volatile("s_waitcnt vmcnt(0)" ::: "memory");
            const unsigned og = xb_add(&bar[XB_TOP], 1u);
            const unsigned tg = og / nx;
            if (og + 1u == (tg + 1u) * nx) xb_add(&bar[XB_TOPGEN], 1u);
            else XB_SPIN(xb_ld(&bar[XB_TOPGEN]) == tg, bar);
            __builtin_amdgcn_fence(__ATOMIC_ACQUIRE, "agent");
            xb_add(&bar[XB_XGEN(b.x)], 1u);
            asm volatile("s_waitcnt vmcnt(0)" ::: "memory");
        } else {
            XB_SPIN(xb_ld(&bar[XB_XGEN(b.x)]) == gen, bar);
            __builtin_amdgcn_fence(__ATOMIC_ACQUIRE, "agent");
            asm volatile("s_waitcnt vmcnt(0)" ::: "memory");
        }
    }
    __syncthreads();
}


constexpr size_t MiB = 1u << 20;
constexpr size_t WS_CTL = 0, WS_WIN = 1 * MiB, WS_WPW = 10 * MiB, WS_WAO = 11 * MiB, WS_WOUT = 12 * MiB, WS_WGU = 14 * MiB, WS_WDN = 25 * MiB, WS_RSTD = 31 * MiB,
                 WS_SS = 32 * MiB, WS_SS2 = 34 * MiB, WS_CBP = 36 * MiB, WS_CBS = 37 * MiB, WS_XB = 40 * MiB, WS_CU = 73 * MiB, WS_Q = 90 * MiB, WS_K = 107 * MiB, WS_V = 124 * MiB,
                 WS_GC = 141 * MiB, WS_GA = 174 * MiB, WS_CS = 207 * MiB, WS_AO = 224 * MiB, WS_MIX = 241 * MiB, WS_H = 274 * MiB, WS_HB = 340 * MiB, WS_ACT = 373 * MiB, WS_END = 464 * MiB;
constexpr int CBS_PITCH = 4160;

struct Args { const float* in[21]; float* out; unsigned char* ws; int ph_lo, ph_hi; };

__device__ __forceinline__ void transpose_item(const float* W, int N, int K, int src_col0, int k0, bf16* WT, int dst_row0, const float* gk, LAS float* scr, int lane) {
#pragma unroll 8
    for (int i = 0; i < 32; ++i) { const int kk = 2 * i + (lane >> 5); const float g = gk ? gk[k0 + kk] : 1.0f; scr[kk * 33 + (lane & 31)] = W[(size_t)(k0 + kk) * N + src_col0 + (lane & 31)] * g; }
    asm volatile("s_waitcnt lgkmcnt(0)" ::: "memory");
    const int c = lane & 7;
#pragma unroll
    for (int j = 0; j < 4; ++j) { const int n = (lane >> 3) + 8 * j; const LAS float* s = scr + (8 * c) * 33 + n;
        u32x4 o; o.x = cvtpk(s[0 * 33], s[1 * 33]); o.y = cvtpk(s[2 * 33], s[3 * 33]); o.z = cvtpk(s[4 * 33], s[5 * 33]); o.w = cvtpk(s[6 * 33], s[7 * 33]);
        *(u32x4*)(WT + (size_t)(dst_row0 + n) * K + k0 + 8 * c) = o; }
    asm volatile("s_waitcnt lgkmcnt(0)" ::: "memory");
}

__device__ __forceinline__ void p0_prologue(const Args& a, ldsp lds, int wave, int lane) {
    unsigned char* ws = a.ws;
    const int gw = blockIdx.x * NWAVES + wave, NGW = gridDim.x * NWAVES;
    if (blockIdx.x == 0 && threadIdx.x == 0) __hip_atomic_store((unsigned*)(ws + WS_CTL), 0u, __ATOMIC_RELAXED, __HIP_MEMORY_SCOPE_AGENT);
    LAS float* gwf = (LAS float*)lds;
    { const float* win = a.in[7]; const float* g = a.in[6];
      for (int e = threadIdx.x; e < 8 * DM; e += NTHREADS) { const int k = e >> 3, h = e & 7; gwf[h * DM + k] = win[(size_t)k * DIN + 2560 + h] * g[k]; } }
    LAS float* scr = (LAS float*)(lds + 32768 + wave * 8448);
    constexpr int I_IN = (DM / 64) * (NIN / 32), I_PW = (DC / 64) * (DM / 32), I_AO = (DA / 64) * (DM / 32), I_OUT = (DM / 64) * (DM / 32), I_GU = (DM / 64) * (NGU / 32), I_DN = (DFF / 64) * (DM / 32);
    constexpr int NITEMS = I_IN + I_PW + I_AO + I_OUT + I_GU + I_DN;
    for (int it = gw; it < NITEMS; it += NGW) {
        int r = it;
        if (r < I_IN) { const int nblk = NIN / 32, kb = r / nblk, nb = r % nblk, n = 32 * nb; int src;
            if (n < 1024) { const int pn = n >> 8, rr = n & 255; src = rr < 128 ? 128 * pn + rr : 512 + 128 * pn + (rr - 128); } else if (n < 2560) src = n; else src = n + 8;
            transpose_item(a.in[7], DIN, DM, src, 64 * kb, (bf16*)(ws + WS_WIN), n, a.in[6], scr, lane); continue; } r -= I_IN;
        if (r < I_PW) { const int nblk = DM / 32, kb = r / nblk, nb = r % nblk; transpose_item(a.in[13], DM, DC, 32 * nb, 64 * kb, (bf16*)(ws + WS_WPW), 32 * nb, nullptr, scr, lane); continue; } r -= I_PW;
        if (r < I_AO) { const int nblk = DM / 32, kb = r / nblk, nb = r % nblk; transpose_item(a.in[14], DM, DA, 32 * nb, 64 * kb, (bf16*)(ws + WS_WAO), 32 * nb, nullptr, scr, lane); continue; } r -= I_AO;
        if (r < I_OUT) { const int nblk = DM / 32, kb = r / nblk, nb = r % nblk; transpose_item(a.in[15], DM, DM, 32 * nb, 64 * kb, (bf16*)(ws + WS_WOUT), 32 * nb, nullptr, scr, lane); continue; } r -= I_OUT;
        if (r < I_GU) { const int nblk = NGU / 32, kb = r / nblk, nb = r % nblk, n = 32 * nb, pn = n >> 8, rr = n & 255;
            const float* src = rr < 128 ? a.in[17] : a.in[18]; const int sc = rr < 128 ? 128 * pn + rr : 128 * pn + (rr - 128);
            transpose_item(src, DFF, DM, sc, 64 * kb, (bf16*)(ws + WS_WGU), n, a.in[16], scr, lane); continue; } r -= I_GU;
        { const int nblk = DM / 32, kb = r / nblk, nb = r % nblk; transpose_item(a.in[19], DM, DFF, 32 * nb, 64 * kb, (bf16*)(ws + WS_WDN), 32 * nb, nullptr, scr, lane); }
    }
    __syncthreads();
    float* rstd = (float*)(ws + WS_RSTD); bf16* XB = (bf16*)(ws + WS_XB); const float* bfv = a.in[8];
    for (int m = gw; m < MT; m += NGW) {
        const float* xrow = (m < MP) ? a.in[0] + (size_t)m * DM : a.in[1] + (size_t)(m - MP) * DM;
        const f32x4* xr = (const f32x4*)xrow + lane;
        f32x4 v[4]; float s = 0.f;
#pragma unroll
        for (int j = 0; j < 4; ++j) { v[j] = xr[64 * j]; s += (v[j].x * v[j].x + v[j].y * v[j].y) + (v[j].z * v[j].z + v[j].w * v[j].w); }
        const float rs = 1.0f / sqrtf(wave_sum(s) * (1.0f / DM) + 1e-6f);
        unsigned long long* o8 = (unsigned long long*)(XB + (size_t)m * DM) + lane;
#pragma unroll
        for (int j = 0; j < 4; ++j) o8[64 * j] = (unsigned long long)cvtpk(v[j].x, v[j].y) | ((unsigned long long)cvtpk(v[j].z, v[j].w) << 32);
        float f[8];
#pragma unroll
        for (int h = 0; h < 8; ++h) { float acc = 0.f;
#pragma unroll
            for (int j = 0; j < 4; ++j) { const f32x4 w = *(const LAS f32x4*)(gwf + h * DM + 4 * lane + 256 * j); acc += (v[j].x * w.x + v[j].y * w.y) + (v[j].z * w.z + v[j].w * w.w); }
            f[h] = wave_sum(acc); }
        float fl = f[0];
#pragma unroll
        for (int h = 1; h < 8; ++h) fl = (lane == h) ? f[h] : fl;
        if (lane == 0) rstd[m] = rs;
        if (lane < 8) { const float z = fl * rs + bfv[lane]; const float lf = fminf(z, 0.f) - log1pf(expf(-fabsf(z)));
            float* dst = (m < MP) ? a.out + OFF_LFP + (size_t)m * NH + lane : a.out + OFF_LFS + (size_t)(m - MP) * NH + lane; *dst = lf; }
    }
}

__device__ __forceinline__ void cumsum_phase(const Args& a, int wave, int lane) {
    const int gw = blockIdx.x * NWAVES + wave;
    if (gw >= 160) return;
    unsigned char* ws = a.ws;
    const float* src; float* dst; const float* extra = nullptr;
    if (gw < 32) { const int b = gw >> 3, h = gw & 7; src = a.out + OFF_LFP + (size_t)b * SEQ * NH + h; dst = (float*)(ws + WS_CBP) + (size_t)gw * SEQ; }
    else { const int s = gw - 32, b = s >> 3, h = s & 7; src = a.in[4] + (size_t)b * PAST * NH + h; dst = (float*)(ws + WS_CBS) + (size_t)s * CBS_PITCH; extra = a.out + OFF_LFS + (size_t)b * DS * NH + h; }
    const float* p = src + (size_t)lane * 64 * NH;
    float tot = 0.f;
    for (int i = 0; i < 64; ++i) tot += p[i * NH];
    float incl = tot;
#pragma unroll
    for (int o = 1; o < 64; o <<= 1) { const float t = __shfl_up(incl, o); if (lane >= o) incl += t; }
    float run = incl - tot;
    for (int i = 0; i < 64; ++i) { run += p[i * NH]; dst[lane * 64 + i] = -run * LOG2E; }
    if (extra) {
        const float total = __shfl(incl, 63);
        float v = (lane < 32) ? extra[lane * NH] : 0.f; float ic = v;
#pragma unroll
        for (int o = 1; o < 64; o <<= 1) { const float t = __shfl_up(ic, o); if (lane >= o) ic += t; }
        dst[PAST + lane] = (lane < 32) ? -(total + ic) * LOG2E : 0.f;
    }
}

namespace att {
__device__ __forceinline__ int crow(int r, int hi) { return (r & 3) + 8 * (r >> 2) + 4 * hi; }
#define SBAR() __builtin_amdgcn_sched_barrier(0)
__device__ __forceinline__ void qkt(f32x16& p0, f32x16& p1, const LAS unsigned char* Kslot, const bf16x8* qr, int r32, int hi) {
    const LAS unsigned char* kb = Kslot + hi * 1024 + r32 * 16;
    f32x16 z = {};
#pragma unroll
    for (int d0 = 0; d0 < 4; ++d0) {
        const bf16x8 b0 = *(const LAS bf16x8*)(kb + d0 * 2048), b1 = *(const LAS bf16x8*)(kb + d0 * 2048 + 512);
        if (d0 == 0) { p0 = __builtin_amdgcn_mfma_f32_32x32x16_bf16(b0, qr[0], z, 0, 0, 0); p1 = __builtin_amdgcn_mfma_f32_32x32x16_bf16(b1, qr[0], z, 0, 0, 0); }
        else { p0 = __builtin_amdgcn_mfma_f32_32x32x16_bf16(b0, qr[d0], p0, 0, 0, 0); p1 = __builtin_amdgcn_mfma_f32_32x32x16_bf16(b1, qr[d0], p1, 0, 0, 0); } }
}
__device__ __forceinline__ void pv(f32x16* o, int vb, bf16x8 pa0, bf16x8 pa1, bf16x8 pa2, bf16x8 pa3) {
#pragma unroll
    for (int d0 = 0; d0 < 2; ++d0) { s16x4 lo[4], hi[4];
#pragma unroll
        for (int ks = 0; ks < 4; ++ks) {
            asm volatile("ds_read_b64_tr_b16 %0,%1 offset:%c2" : "=&v"(lo[ks]) : "v"(vb), "i"(d0 * 4096 + ks * 1024) : "memory");
            asm volatile("ds_read_b64_tr_b16 %0,%1 offset:%c2" : "=&v"(hi[ks]) : "v"(vb), "i"(d0 * 4096 + ks * 1024 + 512) : "memory"); }
        asm volatile("s_waitcnt lgkmcnt(0)" ::: "memory"); SBAR();
#define PK(k) (bf16x8){lo[k][0], lo[k][1], lo[k][2], lo[k][3], hi[k][0], hi[k][1], hi[k][2], hi[k][3]}
        o[d0] = __builtin_amdgcn_mfma_f32_32x32x16_bf16(pa0, PK(0), o[d0], 0, 0, 0);
        o[d0] = __builtin_amdgcn_mfma_f32_32x32x16_bf16(pa1, PK(1), o[d0], 0, 0, 0);
        o[d0] = __builtin_amdgcn_mfma_f32_32x32x16_bf16(pa2, PK(2), o[d0], 0, 0, 0);
        o[d0] = __builtin_amdgcn_mfma_f32_32x32x16_bf16(pa3, PK(3), o[d0], 0, 0, 0);
#undef PK
    }
}
__device__ __forceinline__ float rowmax(const f32x16& p0, const f32x16& p1) {
    float m = fmaxf(p0[0], p1[0]);
#pragma unroll
    for (int r = 1; r < 16; ++r) m = fmaxf(m, fmaxf(p0[r], p1[r]));
    auto rr = __builtin_amdgcn_permlane32_swap(__float_as_uint(m), __float_as_uint(m), false, false);
    return fmaxf(__uint_as_float(rr[0]), __uint_as_float(rr[1]));
}
__device__ __forceinline__ void tile_a(const LAS unsigned char* Kslot, const LAS float* bs, const bf16x8* qr, bool mask, int koff, int qrel, int r32, int hi,
                                          float& m_run, float& l_run, f32x16* o, LAS float* wsf, u32x4& pw0, u32x4& pw1, u32x4& pw2, u32x4& pw3) {
    f32x16 p0, p1; qkt(p0, p1, Kslot, qr, r32, hi);
#pragma unroll
    for (int i = 0; i < 4; ++i) { const f32x4 b0 = *(const LAS f32x4*)(bs + 8 * i + 4 * hi), b1 = *(const LAS f32x4*)(bs + 32 + 8 * i + 4 * hi);
#pragma unroll
        for (int j = 0; j < 4; ++j) { p0[4 * i + j] += b0[j]; p1[4 * i + j] += b1[j]; } }
    if (mask) {
#pragma unroll
        for (int r = 0; r < 16; ++r) { const int kv = koff + crow(r, hi); if (kv > qrel) p0[r] = -INFINITY; if (kv + 32 > qrel) p1[r] = -INFINITY; } }
    const float rm = rowmax(p0, p1);
    const float mn = fmaxf(m_run, rm), f = __builtin_amdgcn_exp2f(m_run - mn); m_run = mn;
    float s = 0.f;
#pragma unroll
    for (int r = 0; r < 16; ++r) { p0[r] = __builtin_amdgcn_exp2f(p0[r] - mn); p1[r] = __builtin_amdgcn_exp2f(p1[r] - mn); s += p0[r] + p1[r]; }
    l_run = l_run * f + s;
    if (hi == 0) wsf[r32] = f;
    asm volatile("s_waitcnt lgkmcnt(0)" ::: "memory");
#pragma unroll
    for (int i = 0; i < 4; ++i) { const f32x4 fv = *(const LAS f32x4*)(wsf + 8 * i + 4 * hi);
#pragma unroll
        for (int j = 0; j < 4; ++j) { o[0][4 * i + j] *= fv[j]; o[1][4 * i + j] *= fv[j]; } }
#pragma unroll
    for (int j = 0; j < 4; ++j) { pw0[j] = cvtpk(p0[2 * j], p0[2 * j + 1]); pw1[j] = cvtpk(p0[8 + 2 * j], p0[9 + 2 * j]); pw2[j] = cvtpk(p1[2 * j], p1[2 * j + 1]); pw3[j] = cvtpk(p1[8 + 2 * j], p1[9 + 2 * j]); }
}
__device__ __forceinline__ void tile_core(const LAS unsigned char* Kslot, int vb, const LAS float* bs, const bf16x8* qr, bool mask, int koff, int qrel, int r32, int hi,
                                          float& m_run, float& l_run, f32x16* o, LAS float* wsf) {
    u32x4 pw0, pw1, pw2, pw3;
    tile_a(Kslot, bs, qr, mask, koff, qrel, r32, hi, m_run, l_run, o, wsf, pw0, pw1, pw2, pw3);
    pv(o, vb, __builtin_bit_cast(bf16x8, pw0), __builtin_bit_cast(bf16x8, pw1), __builtin_bit_cast(bf16x8, pw2), __builtin_bit_cast(bf16x8, pw3));
}
__device__ __forceinline__ int vbase(int lane, int hi) { return ((lane >> 4) & 1) * 32 + (lane & 3) * 8 + (4 * hi + ((lane & 15) >> 2)) * 64; }

constexpr int PL_K = 0, PL_V = 16384, PL_B = 32768, PL_WS = 33280, PL_OST = 36864;
__device__ __forceinline__ void prompt_unit(int b, int h, int qb, const bf16* Q, const bf16* K, const bf16* V, const float* CB, bf16* O, ldsp lds) {
    int tid_ = threadIdx.x; asm volatile("" : "+v"(tid_));
    const int tid = tid_, lane = tid & 63, r32 = lane & 31, hi = lane >> 5; const int wid = __builtin_amdgcn_readfirstlane(tid >> 6);
    const size_t rowbase = (size_t)b * SEQ; const int q0 = qb * 256;
    const bf16* Qw = Q + (rowbase + q0 + wid * 32) * DA + h * HD;
    const bf16* Kh = K + rowbase * DA + h * HD; const bf16* Vh = V + rowbase * DA + h * HD;
    const float* cb = CB + (size_t)(b * NH + h) * SEQ;
    const bf16* ksrc = Kh + (size_t)lane * DA + wid * 8;
    const bf16* vsrc = Vh + (size_t)(16 * (wid & 3) + (lane >> 2)) * DA + (wid >> 2) * 32 + (lane & 3) * 8;
    const int NT = (q0 + 256) / 64;
#define DMA_TILE(t, slot) do { \
        __builtin_amdgcn_global_load_lds((const unsigned*)(ksrc + (size_t)(t) * 64 * DA), (LAS unsigned*)(lds + PL_K + (slot) * 8192 + wid * 1024), 16, 0, 0); \
        __builtin_amdgcn_global_load_lds((const unsigned*)(vsrc + (size_t)(t) * 64 * DA), (LAS unsigned*)(lds + PL_V + (slot) * 8192 + wid * 1024), 16, 0, 0); \
        if (wid == 0) __builtin_amdgcn_global_load_lds((const unsigned*)(cb + (t) * 64 + lane), (LAS unsigned*)(lds + PL_B + (slot) * 256), 4, 0, 0); } while (0)
    DMA_TILE(0, 0);
    bf16x8 qr[4];
#pragma unroll
    for (int d0 = 0; d0 < 4; ++d0) qr[d0] = *(const bf16x8*)(Qw + (size_t)r32 * DA + d0 * 16 + hi * 8);
    float m_run = -1e30f, l_run = 0.f; f32x16 o[2]; o[0] = f32x16{}; o[1] = f32x16{};
    LAS float* wsf = (LAS float*)(lds + PL_WS + wid * 256);
    const int lds0 = (int)(unsigned)(uintptr_t)lds;
    const int vb0 = lds0 + PL_V + vbase(lane, hi);
    const int qrel = wid * 32 + r32;
    for (int t = 0; t < NT; ++t) {
        BLOCK_BAR();
        const int slot = t & 1;
        if (t + 1 < NT) DMA_TILE(t + 1, slot ^ 1);
        const int jb = t - (NT - 4);
        if (jb < 0 || 64 * jb <= wid * 32 + 31)
            tile_core(lds + PL_K + slot * 8192, vb0 + slot * 8192, (const LAS float*)(lds + PL_B + slot * 256), qr, jb >= 0, 64 * jb, qrel, r32, hi, m_run, l_run, o, wsf);
    }
#undef DMA_TILE
    { auto rr = __builtin_amdgcn_permlane32_swap(__float_as_uint(l_run), __float_as_uint(l_run), false, false); l_run = __uint_as_float(rr[0]) + __uint_as_float(rr[1]); }
    if (hi == 0) wsf[32 + r32] = l_run;
    asm volatile("s_waitcnt lgkmcnt(0)" ::: "memory");
    float rli[16];
#pragma unroll
    for (int r = 0; r < 16; ++r) rli[r] = 1.0f / wsf[32 + crow(r, hi)];
    bf16* Ow = O + (rowbase + q0 + wid * 32) * DA + h * HD;
    { LAS bf16* stg = (LAS bf16*)(lds + PL_OST + wid * 4096);
#pragma unroll
      for (int r = 0; r < 16; ++r) { const int orow = crow(r, hi);
#pragma unroll
          for (int d0 = 0; d0 < 2; ++d0) { const float v = o[d0][r] * rli[r]; stg[orow * 64 + d0 * 32 + r32] = (bf16)(cvtpk(v, v) & 0xffffu); } }
      asm volatile("s_waitcnt lgkmcnt(0)" ::: "memory");
#pragma unroll
      for (int i = 0; i < 4; ++i) { const int row = i * 8 + (lane >> 3), ch = lane & 7; const u32x4 v = *(const LAS u32x4*)(stg + row * 64 + ch * 8); *(u32x4*)(Ow + (size_t)row * DA + ch * 8) = v; } }
    BLOCK_BAR();
}

constexpr int SL_B = 131072, SL_WS = 133120, SL_M = 135168, SL_L = 136192;
__device__ __forceinline__ void sample_unit(int b, int h, const Args& a, ldsp lds) {
    int tid_ = threadIdx.x; asm volatile("" : "+v"(tid_));
    const int tid = tid_, lane = tid & 63, r32 = lane & 31, hi = lane >> 5; const int wid = __builtin_amdgcn_readfirstlane(tid >> 6);
    unsigned char* ws = a.ws;
    const bf16* Q = (const bf16*)(ws + WS_Q); const bf16* Kn = (const bf16*)(ws + WS_K); const bf16* Vn = (const bf16*)(ws + WS_V); bf16* O = (bf16*)(ws + WS_AO);
    const float* cbs = (const float*)(ws + WS_CBS) + (size_t)(b * NH + h) * CBS_PITCH;
    const size_t srow = (size_t)MP + (size_t)b * DS;
    const float* ck = a.in[2] + ((size_t)b * PAST * NH + h) * HD; const float* cv = a.in[3] + ((size_t)b * PAST * NH + h) * HD;
    ldsp Kw = lds + wid * 16384; ldsp Vw = Kw + 8192;
    LAS float* bsw = (LAS float*)(lds + SL_B + wid * 256); LAS float* wsf = (LAS float*)(lds + SL_WS + wid * 256);
    bf16x8 qr[4];
#pragma unroll
    for (int d0 = 0; d0 < 4; ++d0) qr[d0] = *(const bf16x8*)(Q + (srow + r32) * DA + h * HD + d0 * 16 + hi * 8);
    float m_run = -1e30f, l_run = 0.f; f32x16 o[2]; o[0] = f32x16{}; o[1] = f32x16{};
    const int vb0 = (int)(unsigned)(uintptr_t)Vw + vbase(lane, hi);
    const int f4 = lane & 15, kq = lane >> 4; const int voff = (kq * DA + 4 * f4) * 4;
    const __amdgpu_buffer_rsrc_t rk = __builtin_amdgcn_make_buffer_rsrc((void*)ck, 0, PAST * 2048, 0x00027000), rv = __builtin_amdgcn_make_buffer_rsrc((void*)cv, 0, PAST * 2048, 0x00027000);
    const int koffK = (f4 >> 1) * 1024 + (f4 & 1) * 8;
    const int koffV = (f4 >> 3) * 4096 + ((f4 & 7) >> 1) * 16 + (f4 & 1) * 8;
    f32x4 kreg[8];
#pragma unroll
    for (int i = 0; i < 8; ++i) kreg[i] = __builtin_bit_cast(f32x4, __builtin_amdgcn_raw_buffer_load_b128(rk, voff, (512 * wid + 4 * i) * 2048, 0));
    for (int tt = 0; tt < 8; ++tt) {
        const int key0 = 512 * wid + 64 * tt;
        { f32x4 kreg2[8];
#pragma unroll
          for (int i = 0; i < 8; ++i) kreg2[i] = __builtin_bit_cast(f32x4, __builtin_amdgcn_raw_buffer_load_b128(rk, voff, (key0 + 32 + 4 * i) * 2048, 0));
#pragma unroll
          for (int i = 0; i < 8; ++i) { const int key = 4 * i + kq; u32x2 w; w.x = cvtpk(kreg[i].x, kreg[i].y); w.y = cvtpk(kreg[i].z, kreg[i].w); *(LAS u32x2*)(Kw + koffK + key * 16) = w; }
#pragma unroll
          for (int i = 0; i < 8; ++i) { const int key = 32 + 4 * i + kq; u32x2 w; w.x = cvtpk(kreg2[i].x, kreg2[i].y); w.y = cvtpk(kreg2[i].z, kreg2[i].w); *(LAS u32x2*)(Kw + koffK + key * 16) = w; } }
        asm volatile("" ::: "memory");
        f32x4 vreg[16];
#pragma unroll
        for (int i = 0; i < 16; ++i) vreg[i] = __builtin_bit_cast(f32x4, __builtin_amdgcn_raw_buffer_load_b128(rv, voff, (key0 + 4 * i) * 2048, 0));
        bsw[lane] = cbs[key0 + lane];
        asm volatile("s_waitcnt lgkmcnt(0)" ::: "memory");
        u32x4 pw0, pw1, pw2, pw3;
        tile_a(Kw, bsw, qr, false, 0, 0, r32, hi, m_run, l_run, o, wsf, pw0, pw1, pw2, pw3);
        asm volatile("" ::: "memory");
#pragma unroll
        for (int i = 0; i < 16; ++i) { const int key = 4 * i + kq; u32x2 w; w.x = cvtpk(vreg[i].x, vreg[i].y); w.y = cvtpk(vreg[i].z, vreg[i].w); *(LAS u32x2*)(Vw + koffV + (key >> 4) * 1024 + (key & 15) * 64) = w; }
        asm volatile("" ::: "memory");
        if (tt < 7) {
#pragma unroll
            for (int i = 0; i < 8; ++i) kreg[i] = __builtin_bit_cast(f32x4, __builtin_amdgcn_raw_buffer_load_b128(rk, voff, (key0 + 64 + 4 * i) * 2048, 0)); }
        asm volatile("s_waitcnt lgkmcnt(0)" ::: "memory");
        pv(o, vb0, __builtin_bit_cast(bf16x8, pw0), __builtin_bit_cast(bf16x8, pw1), __builtin_bit_cast(bf16x8, pw2), __builtin_bit_cast(bf16x8, pw3));
    }
    if (wid == 7) {
        const int key = lane >> 1, half = lane & 1;
        const u32x4* kp = (const u32x4*)(Kn + (srow + key) * DA + h * HD + half * 32); const u32x4* vp = (const u32x4*)(Vn + (srow + key) * DA + h * HD + half * 32);
#pragma unroll
        for (int c = 0; c < 4; ++c) { *(LAS u32x4*)(Kw + (4 * half + c) * 1024 + key * 16) = kp[c]; *(LAS u32x4*)(Kw + (4 * half + c) * 1024 + (key + 32) * 16) = (u32x4){0u, 0u, 0u, 0u}; }
#pragma unroll
        for (int c = 0; c < 4; ++c) { *(LAS u32x4*)(Vw + (half * 4 + (key >> 4)) * 1024 + ((key & 15) * 4 + c) * 16) = vp[c]; *(LAS u32x4*)(Vw + (half * 4 + 2 + (key >> 4)) * 1024 + ((key & 15) * 4 + c) * 16) = (u32x4){0u, 0u, 0u, 0u}; }
        bsw[lane] = cbs[PAST + lane];
        asm volatile("s_waitcnt lgkmcnt(0)" ::: "memory");
        tile_core(Kw, vb0, bsw, qr, true, 0, r32, r32, hi, m_run, l_run, o, wsf);
    }
    { auto rr = __builtin_amdgcn_permlane32_swap(__float_as_uint(l_run), __float_as_uint(l_run), false, false); l_run = __uint_as_float(rr[0]) + __uint_as_float(rr[1]); }
    LAS float* Mw = (LAS float*)(lds + SL_M); LAS float* Lw = (LAS float*)(lds + SL_L);
    if (hi == 0) { Mw[wid * 32 + r32] = m_run; Lw[wid * 32 + r32] = l_run; }
    BLOCK_BAR();
    float M = -1e30f;
#pragma unroll
    for (int w = 0; w < 8; ++w) M = fmaxf(M, Mw[w * 32 + r32]);
    float L = 0.f;
#pragma unroll
    for (int w = 0; w < 8; ++w) L += Lw[w * 32 + r32] * __builtin_amdgcn_exp2f(Mw[w * 32 + r32] - M);
    const float g = __builtin_amdgcn_exp2f(m_run - M) / L;
    if (hi == 0) wsf[r32] = g;
    asm volatile("s_waitcnt lgkmcnt(0)" ::: "memory");
    LAS float* OW = (LAS float*)Kw;
#pragma unroll
    for (int r = 0; r < 16; ++r) { const int q = crow(r, hi); const float gg = wsf[q];
#pragma unroll
        for (int d0 = 0; d0 < 2; ++d0) OW[q * 64 + d0 * 32 + r32] = o[d0][r] * gg; }
    BLOCK_BAR();
    { const int q = tid >> 4, d = (tid & 15) * 4; f32x4 acc = {0.f, 0.f, 0.f, 0.f};
#pragma unroll
      for (int w = 0; w < 8; ++w) acc += *(const LAS f32x4*)(lds + w * 16384 + (q * 64 + d) * 4);
      u32x2 wv; wv.x = cvtpk(acc.x, acc.y); wv.y = cvtpk(acc.z, acc.w); *(u32x2*)(O + (srow + q) * DA + h * HD + d) = wv; }
    BLOCK_BAR();
}
#undef SBAR
}

__device__ __forceinline__ void conv_unit(int u, const Args& a, ldsp lds) {
    int tid_ = threadIdx.x; asm volatile("" : "+v"(tid_));
    const int tid = tid_, lane = tid & 63; const int wid = __builtin_amdgcn_readfirstlane(tid >> 6);
    unsigned char* ws = a.ws; const bf16* CU = (const bf16*)(ws + WS_CU); bf16* CS = (bf16*)(ws + WS_CS);
    const int row0 = 32 * u, ch = tid;
    const float* wdw = a.in[9]; const float* bdw = a.in[10]; const float* lng = a.in[11]; const float* lnb = a.in[12];
    asm volatile("" : "+s"(wdw), "+s"(bdw), "+s"(lng), "+s"(lnb));
    float w[CW];
#pragma unroll
    for (int j = 0; j < CW; ++j) w[j] = wdw[j * DC + ch];
    const float bias = bdw[ch];
    float in[62];
    if (row0 < MP) { const bool first = (row0 & (SEQ - 1)) == 0;
#pragma unroll
        for (int i = 0; i < 62; ++i) { float v = 0.f; if (!(first && i < 30)) v = bf2f(CU[(size_t)(row0 - 30 + i) * DC + ch]); in[i] = v; } }
    else { const int b = (row0 - MP) >> 5; const float* st = a.in[5] + (size_t)b * 30 * DC + ch;
#pragma unroll
        for (int i = 0; i < 30; ++i) in[i] = st[(size_t)i * DC];
#pragma unroll
        for (int i = 30; i < 62; ++i) in[i] = bf2f(CU[(size_t)(row0 - 30 + i) * DC + ch]); }
    LAS float* Y = (LAS float*)lds;
#pragma unroll
    for (int r = 0; r < 32; ++r) { float acc = bias;
#pragma unroll
        for (int j = 0; j < CW; ++j) acc += w[j] * in[r + j];
        Y[r * DC + ch] = acc; }
    BLOCK_BAR();
    const float* lg = lng + 8 * lane; const float* lb = lnb + 8 * lane;
    const f32x4 g0 = *(const f32x4*)lg, g1 = *(const f32x4*)(lg + 4), b0 = *(const f32x4*)lb, b1 = *(const f32x4*)(lb + 4);
#pragma unroll
    for (int rr = 0; rr < 4; ++rr) { const int r = wid * 4 + rr;
        f32x4 v0 = *(const LAS f32x4*)(Y + r * DC + 8 * lane), v1 = *(const LAS f32x4*)(Y + r * DC + 8 * lane + 4);
        const float mean = wave_sum((v0.x + v0.y) + (v0.z + v0.w) + (v1.x + v1.y) + (v1.z + v1.w)) * (1.0f / DC);
        v0 = v0 - mean; v1 = v1 - mean;
        const float var = wave_sum((v0.x * v0.x + v0.y * v0.y) + (v0.z * v0.z + v0.w * v0.w) + (v1.x * v1.x + v1.y * v1.y) + (v1.z * v1.z + v1.w * v1.w)) * (1.0f / DC);
        const float rs = 1.0f / sqrtf(var + 1e-5f);
        f32x4 y0 = v0 * rs * g0 + b0, y1 = v1 * rs * g1 + b1;
        y0 = y0 * pg8::sigm4(y0); y1 = y1 * pg8::sigm4(y1);
        *(u32x4*)(CS + (size_t)(row0 + r) * DC + 8 * lane) = pg8::pack8(y0, y1); }
    BLOCK_BAR();
}

constexpr int NU_SAMPLE = DB * NH, NU_PROMPT = 4 * NH * 16, NU_CONV = MT / 32, NU_TOTAL = NU_SAMPLE + NU_PROMPT + NU_CONV;
__device__ __forceinline__ void queue_phase(const Args& a, ldsp lds) {
    unsigned char* ws = a.ws; unsigned* ctr = (unsigned*)(ws + WS_CTL);
    volatile LAS unsigned* qw = (volatile LAS unsigned*)(lds + LDS_QW);
    for (;;) {
        if (threadIdx.x == 0) qw[0] = __hip_atomic_fetch_add(ctr, 1u, __ATOMIC_RELAXED, __HIP_MEMORY_SCOPE_AGENT);
        __syncthreads();
        const int id = (int)qw[0];
        __syncthreads();
        if (id >= NU_TOTAL) break;
        if (id < NU_SAMPLE) att::sample_unit(id >> 3, id & 7, a, lds);
        else if (id < NU_SAMPLE + NU_PROMPT) { const int j = id - NU_SAMPLE, qb = 15 - (j >> 5), bh = j & 31;
            att::prompt_unit(bh >> 3, bh & 7, qb, (const bf16*)(ws + WS_Q), (const bf16*)(ws + WS_K), (const bf16*)(ws + WS_V), (const float*)(ws + WS_CBP), (bf16*)(ws + WS_AO), lds); }
        else conv_unit(id - NU_SAMPLE - NU_PROMPT, a, lds);
    }
}

__device__ __forceinline__ void final_norm(const Args& a, int wave, int lane) {
    const int gw = blockIdx.x * NWAVES + wave, NGW = gridDim.x * NWAVES;
    const float* SS2 = (const float*)(a.ws + WS_SS2); const float* g = a.in[20];
    f32x4 gv[4];
#pragma unroll
    for (int j = 0; j < 4; ++j) gv[j] = ((const f32x4*)g)[lane + 64 * j];
    for (int m = gw; m < MT; m += NGW) {
        const float part = (lane < 16) ? SS2[(size_t)m * 16 + lane] : 0.f;
        const float rs = 1.0f / sqrtf(wave_sum(part) * (1.0f / DM) + 1e-6f);
        f32x4* yr = (f32x4*)(a.out + (size_t)m * DM) + lane;
#pragma unroll
        for (int j = 0; j < 4; ++j) { const f32x4 v = yr[64 * j]; yr[64 * j] = v * rs * gv[j]; }
    }
}

constexpr int NPHASE = 8;
__global__ void __launch_bounds__(NTHREADS, 2) fwd_kernel(Args a) {
    extern __shared__ __attribute__((aligned(16))) unsigned char lds_raw[];
    ldsp lds = (ldsp)lds_raw;
    const int tid = threadIdx.x, lane = tid & 63; const int wave = __builtin_amdgcn_readfirstlane(tid >> 6);
    unsigned char* ws = a.ws;
    const int lo = a.ph_lo, hi = a.ph_hi; const int G = gridDim.x, c = blockIdx.x;
#ifdef PHASE_ONLY
#define IN(k) ((k) == PHASE_ONLY && lo <= (k) && (k) < hi)
#else
#define IN(k) (lo <= (k) && (k) < hi)
#endif
    if (tid < 4) ((LAS unsigned*)(lds + LDS_XB))[tid] = 0u;
    __syncthreads();
    XcdBarrier bar; bar.bar = (unsigned*)(ws + WS_CTL + CTL_BAR_BYTE); bar.x = 0; bar.st = nullptr;
    if (hi - lo > 1) bar = xcd_barrier_post((unsigned*)(ws + WS_CTL + CTL_BAR_BYTE), (volatile LAS unsigned*)(lds + LDS_XB));
    if (lo < 0) cg::this_grid().sync();
#define SEAM(k) do { if (IN(k) && IN((k) + 1)) { xcd_barrier(bar); } } while (0)
#ifndef REP0
#define REP0 1
#endif
    if (IN(0)) for (int rep_ = 0; rep_ < REP0; ++rep_) { p0_prologue(a, lds, wave, lane); __syncthreads(); }
    SEAM(0);
#ifndef REP1
#define REP1 1
#endif
    if (IN(1)) for (int rep_ = 0; rep_ < REP1; ++rep_) {
        if (rep_) xcd_barrier(bar);
        cumsum_phase(a, wave, lane);
        pg8::Gemm g{(const bf16*)(ws + WS_XB), (const bf16*)(ws + WS_WIN), MT, NIN, DM}; pg8::StaticOrder S; S.init(MT, NIN, G, c);
        pg8::EpiIn E{(const float*)(ws + WS_RSTD), (bf16*)(ws + WS_CU), (bf16*)(ws + WS_Q), (bf16*)(ws + WS_K), (bf16*)(ws + WS_V), (bf16*)(ws + WS_GC), (bf16*)(ws + WS_GA), a.out};
        pg8::gemm_phase<pg8::EpiIn, pg8::StaticOrder, true, true>(lds, g, S, E);
    }
    SEAM(1);
    if (IN(2)) queue_phase(a, lds);
#ifdef PROBE_Q2
    xcd_barrier(bar); if (blockIdx.x == 0 && threadIdx.x == 0) __hip_atomic_store((unsigned*)(ws + WS_CTL), 0u, __ATOMIC_RELAXED, __HIP_MEMORY_SCOPE_AGENT); xcd_barrier(bar);
    if (IN(2)) queue_phase(a, lds);
#endif
    SEAM(2);
#ifndef REP3
#define REP3 1
#endif
    if (IN(3)) for (int rep_ = 0; rep_ < REP3; ++rep_) {
        if (rep_) xcd_barrier(bar);
        { pg8::Gemm g{(const bf16*)(ws + WS_CS), (const bf16*)(ws + WS_WPW), MT, DM, DC}; pg8::StaticOrder S; S.init(MT, DM, G, c);
          pg8::EpiMix<false> E{(const bf16*)(ws + WS_GC), (bf16*)(ws + WS_MIX)};
          pg8::gemm_phase<pg8::EpiMix<false>, pg8::StaticOrder, true, true>(lds, g, S, E); }
        asm volatile("s_waitcnt vmcnt(0)" ::: "memory"); __syncthreads();
        { pg8::Gemm g{(const bf16*)(ws + WS_AO), (const bf16*)(ws + WS_WAO), MT, DM, DA}; pg8::StaticOrder S; S.init(MT, DM, G, c);
          pg8::EpiMix<true> E{(const bf16*)(ws + WS_GA), (bf16*)(ws + WS_MIX)};
          pg8::gemm_phase<pg8::EpiMix<true>, pg8::StaticOrder, true, true>(lds, g, S, E); }
    }
    SEAM(3);
#ifndef REP4
#define REP4 1
#endif
    if (IN(4)) for (int rep_ = 0; rep_ < REP4; ++rep_) {
        if (rep_) xcd_barrier(bar);
        pg8::Gemm g{(const bf16*)(ws + WS_MIX), (const bf16*)(ws + WS_WOUT), MT, DM, DM}; pg8::StaticOrder S; S.init(MT, DM, G, c);
        pg8::EpiOut E{a.in[0], a.in[1], (float*)(ws + WS_H), (bf16*)(ws + WS_HB), (float*)(ws + WS_SS)};
        pg8::gemm_phase<pg8::EpiOut, pg8::StaticOrder, true, true>(lds, g, S, E);
    }
    SEAM(4);
#ifndef REP5
#define REP5 1
#endif
    if (IN(5)) for (int rep_ = 0; rep_ < REP5; ++rep_) {
        if (rep_) xcd_barrier(bar);
        pg8::Gemm g{(const bf16*)(ws + WS_HB), (const bf16*)(ws + WS_WGU), MT, NGU, DM}; pg8::StaticOrder S; S.init(MT, NGU, G, c);
        pg8::EpiGU E{(const float*)(ws + WS_SS), (bf16*)(ws + WS_ACT)};
        pg8::gemm_phase<pg8::EpiGU, pg8::StaticOrder, true, true>(lds, g, S, E);
    }
    SEAM(5);
#ifndef REP6
#define REP6 1
#endif
    if (IN(6)) for (int rep_ = 0; rep_ < REP6; ++rep_) {
        if (rep_) xcd_barrier(bar);
        pg8::Gemm g{(const bf16*)(ws + WS_ACT), (const bf16*)(ws + WS_WDN), MT, DM, DFF}; pg8::StaticOrder S; S.init(MT, DM, G, c);
        pg8::EpiDown E{(const float*)(ws + WS_H), a.out, (float*)(ws + WS_SS2)};
        pg8::gemm_phase<pg8::EpiDown, pg8::StaticOrder, true, true>(lds, g, S, E);
    }
    SEAM(6);
    if (IN(7)) final_norm(a, wave, lane);
#ifdef PROBE_SYNCS
    for (int i_ = 0; i_ < PROBE_SYNCS; ++i_) xcd_barrier(bar);
#endif
#undef IN
#undef SEAM
}

#ifndef N_LAUNCHES
#define N_LAUNCHES 1
#endif
extern "C" void kernel_launch(void* const* d_in, const int* in_sizes, int n_in, void* d_out, int out_size, void* d_ws, size_t ws_size, hipStream_t stream) {
    static int grid = 0;
    if (grid == 0) {
        if (n_in != 21 || (size_t)out_size != OUT_TOTAL || ws_size < WS_END) { fprintf(stderr, "kernel_launch: unexpected shapes (n_in %d out %d ws %zu)\n", n_in, out_size, ws_size); grid = -1; return; }
        int dev = 0, cus = 0, per_cu = 0;
        hipGetDevice(&dev); hipDeviceGetAttribute(&cus, hipDeviceAttributeMultiprocessorCount, dev);
        hipFuncSetAttribute((const void*)fwd_kernel, hipFuncAttributeMaxDynamicSharedMemorySize, LDS_BYTES);
        hipOccupancyMaxActiveBlocksPerMultiprocessor(&per_cu, (const void*)fwd_kernel, NTHREADS, LDS_BYTES);
        (void)hipGetLastError();
        if (per_cu < 1) fprintf(stderr, "kernel_launch: occupancy query says %d blocks per CU\n", per_cu);
        grid = cus > 0 ? cus : 256;
    }
    if (grid < 0) return;
    if (hipMemsetAsync((char*)d_ws + WS_CTL, 0, CTL_ZERO_BYTES, stream) != hipSuccess) { fprintf(stderr, "kernel_launch: memset failed\n"); return; }
    Args a{};
    for (int i = 0; i < 21; ++i) a.in[i] = (const float*)d_in[i];
    a.out = (float*)d_out; a.ws = (unsigned char*)d_ws;
#if N_LAUNCHES == 1
    a.ph_lo = 0; a.ph_hi = NPHASE;
    void* args[] = {&a};
    hipError_t e = hipLaunchCooperativeKernel((const void*)fwd_kernel, dim3(grid), dim3(NTHREADS), args, LDS_BYTES, stream);
    if (e != hipSuccess) fprintf(stderr, "cooperative launch failed: %s (grid %d)\n", hipGetErrorString(e), grid);
#else
    for (int p = 0; p < NPHASE; ++p) { a.ph_lo = p; a.ph_hi = p + 1; hipLaunchKernelGGL(fwd_kernel, dim3(grid), dim3(NTHREADS), LDS_BYTES, stream, a); }
#endif
}
```

```cpp
#include <hip/hip_runtime.h>
#include <hip/hip_cooperative_groups.h>
#include <cstdio>
#include <cstdint>
#include <cmath>
namespace cg = cooperative_groups;
constexpr int DM = 1024, MP = 16384, MS = 512, MT = MP + MS, SEQ = 4096, NH = 8, HD = 64, DA = 512, DC = 512, CW = 31, DFF = 2816, DIN = 4616, PAST = 4096, DB = 16, DS = 32;
constexpr int NIN = 4608, NGU = 2 * DFF;
constexpr size_t OFF_Y = 0, OFF_KP = (size_t)MT * DM, OFF_VP = OFF_KP + (size_t)MP * DA, OFF_LFP = OFF_VP + (size_t)MP * DA, OFF_CVP = OFF_LFP + (size_t)MP * NH,
                 OFF_KS = OFF_CVP + (size_t)4 * 30 * DC, OFF_VS = OFF_KS + (size_t)MS * DA, OFF_LFS = OFF_VS + (size_t)MS * DA, OFF_CVS = OFF_LFS + (size_t)MS * NH, OUT_TOTAL = OFF_CVS + (size_t)DB * 30 * DC;
static_assert(OUT_TOTAL == 35045376, "output size");
constexpr float LOG2E = 1.4426950408889634f;
constexpr float QSCALE = 0.125f * LOG2E;
#define N_LAUNCHES 1
namespace pg8 {
#define PG8_LAS __attribute__((address_space(3)))
typedef unsigned short bf16_t;
typedef short bf16x8 __attribute__((ext_vector_type(8)));
typedef float f32x4 __attribute__((ext_vector_type(4)));
typedef unsigned u32x4 __attribute__((ext_vector_type(4)));
constexpr int BM = 256, BK = 64, HALF = 128, HTB = HALF * BK * 2  , STAGE_BYTES = 8 * HTB, NXCD = 8, WGM = 8;

__host__ __device__ __forceinline__ int lds_byte(int r, int c) { const int st = (r >> 4) * 2 + (c >> 5), rr = r & 15, cc = c & 31, ob = rr * 64 + cc * 2; return st * 1024 + (ob ^ (((ob >> 9) & 1) << 5)); }
__host__ __device__ __forceinline__ void stage_rc(int b, int& R, int& C) { const int st = b / 1024, sb = b % 1024, swz = sb ^ (((sb >> 9) & 1) << 5); R = (st >> 1) * 16 + swz / 64; C = (st & 1) * 32 + (swz % 64) / 2; }
__host__ __device__ __forceinline__ int perm32(int rho) { const int n = rho >> 4, i = rho & 15; return 8 * (i >> 2) + 4 * n + (i & 3); }

struct Unit { int pm, pn; };
struct Gemm { const bf16_t* A; const bf16_t* Bt; int M, N, K; };

struct StaticOrder {
    int nM, nN, nwg, G, c;
    __host__ __device__ void init(int M, int N, int G_, int c_) { nM = M / BM; nN = N / BM; nwg = nM * nN; G = G_; c = c_; }
    __host__ __device__ bool next(int i, Unit& u) const {
        const long L = (long)i * G + c; if (L >= nwg) return false;
        int wgid = (int)L; { const int q = nwg / NXCD, r = nwg % NXCD, xcd = wgid % NXCD, off = wgid / NXCD; wgid = (xcd < r ? xcd * (q + 1) : r * (q + 1) + (xcd - r) * q) + off; }
        const int nig = WGM * nN, gid = wgid / nig, fm = gid * WGM, gsz = (nM - fm) < WGM ? (nM - fm) : WGM;
        u.pm = fm + ((wgid % nig) % gsz); u.pn = (wgid % nig) / gsz; return true;
    }
    __device__ __forceinline__ void a_ready(const Unit&) const {}
    __device__ __forceinline__ void done(const Unit&) const {}
};

__device__ __forceinline__ unsigned cvt_pk_bf16(float lo, float hi) { unsigned r; asm volatile("v_cvt_pk_bf16_f32 %0, %1, %2" : "=v"(r) : "v"(lo), "v"(hi)); return r; }
typedef float f32x2 __attribute__((ext_vector_type(2)));
template <class Epi, class Sched, bool ALIGN_EPI = false, bool SP2 = false>
__device__ __forceinline__ void gemm_phase(PG8_LAS unsigned char* lds, const Gemm g, const Sched& S, const Epi& E) {
    const int tid = threadIdx.x, wid = __builtin_amdgcn_readfirstlane(tid >> 6), lane = tid & 63, wr = wid >> 2, wc = wid & 3, fr = lane & 15, fq = lane >> 4;
    const int K = g.K, nt = K / BK;
    unsigned voffA[2], voffB[2];
#pragma unroll
    for (int i = 0; i < 2; ++i) { int R, C; stage_rc(tid * 16 + i * 8192, R, C); const int Rb = Epi::PERM ? ((R & ~31) + perm32(R & 31)) : R;
        voffA[i] = (unsigned)(R * K + C) * 2u; voffB[i] = (unsigned)(Rb * K + C) * 2u; }
    const size_t kstep = (size_t)(BK * 2);
    const size_t hstep = (size_t)HALF * K * 2;
    const size_t tstep = 2 * hstep;
    const unsigned ldsw = (unsigned)wid * 1024u;
    const int aoff = lds_byte(wr * 64 + fr, fq * 8), boff = lds_byte(wc * 32 + fr, fq * 8);
#define PG8_SA(b, h) (((b) * 2 + (h)) * HTB)
#define PG8_SB(b, h) ((4 + (b) * 2 + (h)) * HTB)
#define PG8_STAGE(bufoff, gbase, voff) do { _Pragma("unroll") for (int _i = 0; _i < 2; ++_i) \
        __builtin_amdgcn_global_load_lds((const unsigned*)((const char*)(gbase) + (voff)[_i]), (PG8_LAS unsigned*)(lds + (bufoff) + ldsw + _i * 8192), 16, 0, 0); } while (0)
#define PG8_LDA(dst, b, h) do { _Pragma("unroll") for (int m = 0; m < 4; ++m) _Pragma("unroll") for (int k = 0; k < 2; ++k) dst[m][k] = *(const PG8_LAS bf16x8*)(lds + PG8_SA(b, h) + aoff + m * 2048 + k * 1024); } while (0)
#define PG8_LDB(dst, b, h) do { _Pragma("unroll") for (int n = 0; n < 2; ++n) _Pragma("unroll") for (int k = 0; k < 2; ++k) dst[n][k] = *(const PG8_LAS bf16x8*)(lds + PG8_SB(b, h) + boff + n * 2048 + k * 1024); } while (0)
#define PG8_MMA(ai, bj, At, Bt) do { __builtin_amdgcn_s_setprio(1); _Pragma("unroll") for (int m = 0; m < 4; ++m) _Pragma("unroll") for (int n = 0; n < 2; ++n) _Pragma("unroll") for (int k = 0; k < 2; ++k) \
        acc[ai][bj][m][n] = __builtin_amdgcn_mfma_f32_16x16x32_bf16(Bt[n][k], At[m][k], acc[ai][bj][m][n], 0, 0, 0); __builtin_amdgcn_s_setprio(0); } while (0)
#define PG8_WAIT_V(n) asm volatile("s_waitcnt vmcnt(" #n ")" ::: "memory")
#define PG8_WAIT_L(n) asm volatile("s_waitcnt lgkmcnt(" #n ")" ::: "memory")
#define PG8_BAR __builtin_amdgcn_s_barrier()
#define PG8_SCHED __builtin_amdgcn_sched_barrier(0)
    Unit cur, nxt; int ui = 0;
    if (!S.next(0, cur)) return;
    f32x4 acc[2][2][4][2];
#pragma unroll
    for (int a = 0; a < 2; ++a)
#pragma unroll
        for (int b = 0; b < 2; ++b)
#pragma unroll
            for (int m = 0; m < 4; ++m)
#pragma unroll
                for (int n = 0; n < 2; ++n) acc[a][b][m][n] = (f32x4){0.f, 0.f, 0.f, 0.f};
    bf16x8 At[4][2], B0[2][2], B1[2][2];
    const char* cA = (const char*)g.A + (size_t)cur.pm * tstep; const char* cB = (const char*)g.Bt + (size_t)cur.pn * tstep;
    S.a_ready(cur);
    if constexpr (SP2) {
        PG8_STAGE(PG8_SB(0, 0), cB, voffB); PG8_STAGE(PG8_SB(0, 1), cB + hstep, voffB); PG8_STAGE(PG8_SA(0, 0), cA, voffA); PG8_STAGE(PG8_SA(0, 1), cA + hstep, voffA);
        if (wr == 1) PG8_BAR;
        PG8_WAIT_V(2); PG8_BAR;
        PG8_STAGE(PG8_SB(1, 0), cB + kstep, voffB); PG8_STAGE(PG8_SA(1, 0), cA + kstep, voffA); PG8_STAGE(PG8_SB(1, 1), cB + hstep + kstep, voffB);
        PG8_WAIT_V(6); PG8_BAR;
    } else {
        PG8_STAGE(PG8_SB(0, 0), cB, voffB); PG8_STAGE(PG8_SA(0, 0), cA, voffA); PG8_STAGE(PG8_SB(0, 1), cB + hstep, voffB); PG8_STAGE(PG8_SA(0, 1), cA + hstep, voffA);
        if (wr == 1) PG8_BAR;
        PG8_WAIT_V(4); PG8_BAR;
        PG8_STAGE(PG8_SB(1, 0), cB + kstep, voffB); PG8_STAGE(PG8_SA(1, 0), cA + kstep, voffA); PG8_STAGE(PG8_SB(1, 1), cB + hstep + kstep, voffB);
        PG8_WAIT_V(6); PG8_BAR;
    }
    for (;;) {
        const bool has_next = S.next(ui + 1, nxt);
        const char* nA = has_next ? (const char*)g.A + (size_t)nxt.pm * tstep : cA; const char* nB = has_next ? (const char*)g.Bt + (size_t)nxt.pn * tstep : cB;
        for (int t = 0; t < nt; t += 2) {
            const bool last = (t == nt - 2);
            const char* a1 = cA + (size_t)(t + 1) * kstep;
            const char* a2 = last ? nA : cA + (size_t)(t + 2) * kstep; const char* b2 = last ? nB : cB + (size_t)(t + 2) * kstep;
            const char* a3 = a2 + kstep; const char* b3 = b2 + kstep;
            if (last && has_next) S.a_ready(nxt);
            if constexpr (SP2) {
            PG8_LDB(B0, 0, 0); PG8_LDB(B1, 0, 1); PG8_SCHED; PG8_LDA(At, 0, 0); PG8_STAGE(PG8_SA(1, 1), a1 + hstep, voffA);
            PG8_WAIT_V(8); PG8_WAIT_L(0); PG8_BAR; PG8_MMA(0, 0, At, B0); PG8_MMA(0, 1, At, B1); PG8_BAR; PG8_SCHED;
            PG8_LDA(At, 0, 1); PG8_STAGE(PG8_SB(0, 0), b2, voffB); PG8_STAGE(PG8_SB(0, 1), b2 + hstep, voffB); PG8_STAGE(PG8_SA(0, 0), a2, voffA);
            PG8_WAIT_V(8); PG8_WAIT_L(0); PG8_BAR; PG8_MMA(1, 0, At, B0); PG8_MMA(1, 1, At, B1); PG8_BAR; PG8_SCHED;
            PG8_LDB(B0, 1, 0); PG8_LDB(B1, 1, 1); PG8_SCHED; PG8_LDA(At, 1, 0); PG8_STAGE(PG8_SA(0, 1), a2 + hstep, voffA);
            PG8_WAIT_V(8); PG8_WAIT_L(0); PG8_BAR; PG8_MMA(0, 0, At, B0); PG8_MMA(0, 1, At, B1); PG8_BAR; PG8_SCHED;
            PG8_LDA(At, 1, 1); PG8_STAGE(PG8_SB(1, 0), b3, voffB); PG8_STAGE(PG8_SB(1, 1), b3 + hstep, voffB); PG8_STAGE(PG8_SA(1, 0), a3, voffA);
            PG8_WAIT_V(8); PG8_WAIT_L(0); PG8_BAR; PG8_MMA(1, 0, At, B0); PG8_MMA(1, 1, At, B1); PG8_BAR; PG8_SCHED;
            } else {
            PG8_LDB(B0, 0, 0); PG8_SCHED; PG8_LDA(At, 0, 0); PG8_STAGE(PG8_SA(1, 1), a1 + hstep, voffA);
            PG8_WAIT_L(8); PG8_BAR; PG8_WAIT_L(0); PG8_MMA(0, 0, At, B0); PG8_BAR; PG8_SCHED;
            PG8_LDB(B1, 0, 1); PG8_STAGE(PG8_SB(0, 0), b2, voffB);
            PG8_BAR; PG8_WAIT_L(0); PG8_MMA(0, 1, At, B1); PG8_BAR;
            PG8_LDA(At, 0, 1); PG8_STAGE(PG8_SA(0, 0), a2, voffA);
            PG8_BAR; PG8_WAIT_L(0); PG8_MMA(1, 0, At, B0); PG8_BAR; PG8_SCHED;
            PG8_STAGE(PG8_SB(0, 1), b2 + hstep, voffB);
            PG8_WAIT_V(6); PG8_BAR; PG8_MMA(1, 1, At, B1); PG8_BAR;
            PG8_LDB(B0, 1, 0); PG8_SCHED; PG8_LDA(At, 1, 0); PG8_STAGE(PG8_SA(0, 1), a2 + hstep, voffA);
            PG8_WAIT_L(8); PG8_BAR; PG8_WAIT_L(0); PG8_MMA(0, 0, At, B0); PG8_BAR; PG8_SCHED;
            PG8_LDB(B1, 1, 1); PG8_STAGE(PG8_SB(1, 0), b3, voffB);
            PG8_BAR; PG8_WAIT_L(0); PG8_MMA(0, 1, At, B1); PG8_BAR;
            PG8_LDA(At, 1, 1); PG8_STAGE(PG8_SA(1, 0), a3, voffA);
            PG8_BAR; PG8_WAIT_L(0); PG8_MMA(1, 0, At, B0); PG8_BAR; PG8_SCHED;
            PG8_STAGE(PG8_SB(1, 1), b3 + hstep, voffB);
            PG8_WAIT_V(6); PG8_BAR; PG8_MMA(1, 1, At, B1); PG8_BAR;
            }
        }
        if constexpr (ALIGN_EPI) { if (wr == 0) PG8_BAR; }
        if constexpr (!Epi::AFTER_DRAIN) { E(acc, cur, wr, wc, fr, fq); S.done(cur); }
        if (!has_next) break;
#pragma unroll
        for (int a = 0; a < 2; ++a)
#pragma unroll
            for (int b = 0; b < 2; ++b)
#pragma unroll
                for (int m = 0; m < 4; ++m)
#pragma unroll
                    for (int n = 0; n < 2; ++n) acc[a][b][m][n] = (f32x4){0.f, 0.f, 0.f, 0.f};
        cur = nxt; cA = nA; cB = nB; ++ui;
        if constexpr (ALIGN_EPI) { if (wr == 1) PG8_BAR; }
    }
    PG8_WAIT_V(0);
    if constexpr (!ALIGN_EPI) { if (wr == 0) PG8_BAR; }
    PG8_BAR;
    if constexpr (Epi::AFTER_DRAIN) { E.fused(acc, cur, wr, wc, fr, fq, lds, wid, lane); S.done(cur); }
#undef PG8_SA
#undef PG8_SB
#undef PG8_STAGE
#undef PG8_LDA
#undef PG8_LDB
#undef PG8_MMA
#undef PG8_WAIT_V
#undef PG8_WAIT_L
#undef PG8_BAR
#undef PG8_SCHED
}
__device__ __forceinline__ float bf2f(unsigned short b) { return __uint_as_float((unsigned)b << 16); }
__device__ __forceinline__ float sigm(float x) { return __builtin_amdgcn_rcpf(1.0f + __expf(-x)); }
__device__ __forceinline__ u32x4 pack8(const f32x4 a, const f32x4 b) { u32x4 w; w.x = cvt_pk_bf16(a[0], a[1]); w.y = cvt_pk_bf16(a[2], a[3]); w.z = cvt_pk_bf16(b[0], b[1]); w.w = cvt_pk_bf16(b[2], b[3]); return w; }
__device__ __forceinline__ void unpack8(const u32x4 w, f32x4& a, f32x4& b) {
    a[0] = __uint_as_float(w.x << 16); a[1] = __uint_as_float(w.x & 0xffff0000u); a[2] = __uint_as_float(w.y << 16); a[3] = __uint_as_float(w.y & 0xffff0000u);
    b[0] = __uint_as_float(w.z << 16); b[1] = __uint_as_float(w.z & 0xffff0000u); b[2] = __uint_as_float(w.w << 16); b[3] = __uint_as_float(w.w & 0xffff0000u); }
__device__ __forceinline__ f32x4 sigm4(f32x4 v) { f32x4 r; r[0] = sigm(v[0]); r[1] = sigm(v[1]); r[2] = sigm(v[2]); r[3] = sigm(v[3]); return r; }

struct EpiIn {
    static constexpr bool PERM = true, AFTER_DRAIN = false;
    const float* rstd; bf16_t *CU, *Q, *K, *V, *GC, *GA; float* out;
    __device__ __forceinline__ void operator()(const f32x4 (&acc)[2][2][4][2], const Unit& u, int wr, int wc, int fr, int fq) const {
        const int pn = u.pn, row0 = u.pm * BM + wr * 64 + fr, cl = wc * 32 + 8 * fq;
#pragma unroll
        for (int ai = 0; ai < 2; ++ai)
#pragma unroll
            for (int m = 0; m < 4; ++m) {
                const int row = row0 + ai * HALF + m * 16; const float rs = rstd[row];
                if (pn < 4) {
                    const f32x4 a0 = acc[ai][0][m][0] * rs, a1 = acc[ai][0][m][1] * rs, g0 = acc[ai][1][m][0] * rs, g1 = acc[ai][1][m][1] * rs;
                    const f32x4 c0 = a0 * sigm4(g0), c1 = a1 * sigm4(g1); const int ch = 128 * pn + cl;
                    *(u32x4*)(CU + (size_t)row * DC + ch) = pack8(c0, c1);
                    float* hd = nullptr;
                    if (row < MP) { const int t = row & (SEQ - 1); if (t >= SEQ - 30) hd = out + OFF_CVP + ((size_t)(row >> 12) * 30 + (t - (SEQ - 30))) * DC + ch; }
                    else { const int sr = row - MP, t = sr & 31; if (t >= 2) hd = out + OFF_CVS + ((size_t)(sr >> 5) * 30 + (t - 2)) * DC + ch; }
                    if (hd) { *(f32x4*)hd = c0; *(f32x4*)(hd + 4) = c1; }
                } else if (pn < 10) {
                    const int which = (pn - 4) >> 1;
#pragma unroll
                    for (int bj = 0; bj < 2; ++bj) {
                        const int col = ((pn - 4) & 1) * 256 + bj * HALF + cl; const f32x4 v0 = acc[ai][bj][m][0] * rs, v1 = acc[ai][bj][m][1] * rs;
                        if (which == 0) { *(u32x4*)(Q + (size_t)row * DA + col) = pack8(v0 * QSCALE, v1 * QSCALE); }
                        else { bf16_t* B = which == 1 ? K : V; *(u32x4*)(B + (size_t)row * DA + col) = pack8(v0, v1);
                            float* d = (row < MP) ? out + (which == 1 ? OFF_KP : OFF_VP) + (size_t)row * DA + col : out + (which == 1 ? OFF_KS : OFF_VS) + (size_t)(row - MP) * DA + col;
                            *(f32x4*)d = v0; *(f32x4*)(d + 4) = v1; }
                    }
                } else {
                    bf16_t* B = pn < 14 ? GC : GA;
#pragma unroll
                    for (int bj = 0; bj < 2; ++bj) {
                        const int col = ((pn - 10) & 3) * 256 + bj * HALF + cl; const f32x4 v0 = acc[ai][bj][m][0] * rs, v1 = acc[ai][bj][m][1] * rs;
                        *(u32x4*)(B + (size_t)row * DM + col) = pack8(sigm4(v0), sigm4(v1)); }
                }
            }
    }
};
template <bool ADD> struct EpiMix {
    static constexpr bool PERM = true, AFTER_DRAIN = false;
    const bf16_t* G; bf16_t* MIX;
    __device__ __forceinline__ void operator()(const f32x4 (&acc)[2][2][4][2], const Unit& u, int wr, int wc, int fr, int fq) const {
        const int row0 = u.pm * BM + wr * 64 + fr, col0 = u.pn * BM + wc * 32 + 8 * fq;
#pragma unroll
        for (int ai = 0; ai < 2; ++ai)
#pragma unroll
            for (int m = 0; m < 4; ++m) {
                const size_t ro = (size_t)(row0 + ai * HALF + m * 16) * DM + col0;
#pragma unroll
                for (int bj = 0; bj < 2; ++bj) {
                    f32x4 g0, g1; unpack8(*(const u32x4*)(G + ro + bj * HALF), g0, g1);
                    f32x4 v0 = acc[ai][bj][m][0] * g0, v1 = acc[ai][bj][m][1] * g1;
                    if (ADD) { f32x4 o0, o1; unpack8(*(const u32x4*)(MIX + ro + bj * HALF), o0, o1); v0 += o0; v1 += o1; }
                    *(u32x4*)(MIX + ro + bj * HALF) = pack8(v0, v1); }
            }
    }
};
struct EpiOut {
    static constexpr bool PERM = true, AFTER_DRAIN = false;
    const float *xp, *xs; bf16_t* HB; float* SS;
    __device__ __forceinline__ void operator()(const f32x4 (&acc)[2][2][4][2], const Unit& u, int wr, int wc, int fr, int fq) const {
        const int row0 = u.pm * BM + wr * 64 + fr, col0 = u.pn * BM + wc * 32 + 8 * fq;
#pragma unroll
        for (int ai = 0; ai < 2; ++ai)
#pragma unroll
            for (int m = 0; m < 4; ++m) {
                const int row = row0 + ai * HALF + m * 16; const size_t ro = (size_t)row * DM + col0;
                const float* xr = (row < MP) ? xp + ro : xs + (ro - (size_t)MP * DM);
                float ss = 0.f;
#pragma unroll
                for (int bj = 0; bj < 2; ++bj) {
                    const f32x4 h0 = acc[ai][bj][m][0] + *(const f32x4*)(xr + bj * HALF), h1 = acc[ai][bj][m][1] + *(const f32x4*)(xr + bj * HALF + 4);
                    *(u32x4*)(HB + ro + bj * HALF) = pack8(h0, h1);
                    ss += (h0[0] * h0[0] + h0[1] * h0[1]) + (h0[2] * h0[2] + h0[3] * h0[3]) + (h1[0] * h1[0] + h1[1] * h1[1]) + (h1[2] * h1[2] + h1[3] * h1[3]); }
                ss += __shfl_xor(ss, 16); ss += __shfl_xor(ss, 32);
                if (fq == 0) SS[(size_t)row * 16 + u.pn * 4 + wc] = ss;
            }
    }
};
struct EpiGU {
    static constexpr bool PERM = true, AFTER_DRAIN = false;
    const float* SS; bf16_t* ACT;
    __device__ __forceinline__ void operator()(const f32x4 (&acc)[2][2][4][2], const Unit& u, int wr, int wc, int fr, int fq) const {
        const int row0 = u.pm * BM + wr * 64 + fr, ch = u.pn * HALF + wc * 32 + 8 * fq;
#pragma unroll
        for (int ai = 0; ai < 2; ++ai)
#pragma unroll
            for (int m = 0; m < 4; ++m) {
                const int row = row0 + ai * HALF + m * 16; const f32x4* sp = (const f32x4*)(SS + (size_t)row * 16);
                const f32x4 s0 = sp[0], s1 = sp[1], s2 = sp[2], s3 = sp[3];
                const float tot = ((s0[0] + s0[1]) + (s0[2] + s0[3])) + ((s1[0] + s1[1]) + (s1[2] + s1[3])) + ((s2[0] + s2[1]) + (s2[2] + s2[3])) + ((s3[0] + s3[1]) + (s3[2] + s3[3]));
                const float rs = 1.0f / sqrtf(tot * (1.0f / DM) + 1e-6f);
                const f32x4 g0 = acc[ai][0][m][0] * rs, g1 = acc[ai][0][m][1] * rs, u0 = acc[ai][1][m][0] * rs, u1 = acc[ai][1][m][1] * rs;
                *(u32x4*)(ACT + (size_t)row * DFF + ch) = pack8(g0 * sigm4(g0) * u0, g1 * sigm4(g1) * u1);
            }
    }
};
struct EpiDown {
    static constexpr bool PERM = true, AFTER_DRAIN = false;
    const bf16_t* HB; float* Y; float* SS;
    __device__ __forceinline__ void operator()(const f32x4 (&acc)[2][2][4][2], const Unit& u, int wr, int wc, int fr, int fq) const {
        const int row0 = u.pm * BM + wr * 64 + fr, col0 = u.pn * BM + wc * 32 + 8 * fq;
#pragma unroll
        for (int ai = 0; ai < 2; ++ai)
#pragma unroll
            for (int m = 0; m < 4; ++m) {
                const int row = row0 + ai * HALF + m * 16; const size_t ro = (size_t)row * DM + col0;
                float ss = 0.f;
#pragma unroll
                for (int bj = 0; bj < 2; ++bj) {
                    f32x4 r0, r1; unpack8(*(const u32x4*)(HB + ro + bj * HALF), r0, r1);
                    const f32x4 h0 = acc[ai][bj][m][0] + r0, h1 = acc[ai][bj][m][1] + r1;
                    *(f32x4*)(Y + ro + bj * HALF) = h0; *(f32x4*)(Y + ro + bj * HALF + 4) = h1;
                    ss += (h0[0] * h0[0] + h0[1] * h0[1]) + (h0[2] * h0[2] + h0[3] * h0[3]) + (h1[0] * h1[0] + h1[1] * h1[1]) + (h1[2] * h1[2] + h1[3] * h1[3]); }
                ss += __shfl_xor(ss, 16); ss += __shfl_xor(ss, 32);
                if (fq == 0) SS[(size_t)row * 16 + u.pn * 4 + wc] = ss;
            }
    }
};
}
#define LAS __attribute__((address_space(3)))
typedef unsigned short bf16;
typedef LAS unsigned char* ldsp;
typedef __attribute__((ext_vector_type(8))) short bf16x8;
typedef __attribute__((ext_vector_type(4))) short s16x4;
typedef __attribute__((ext_vector_type(16))) float f32x16;
typedef __attribute__((ext_vector_type(4))) float f32x4;
typedef __attribute__((ext_vector_type(4))) unsigned u32x4;
typedef __attribute__((ext_vector_type(2))) unsigned u32x2;
constexpr int NWAVES = 8, NTHREADS = 512;
constexpr int LDS_BYTES = 147456;
constexpr int LDS_QW = 137216;
constexpr int LDS_XB = 137232;
constexpr size_t CTL_BAR_BYTE = 16384, CTL_ZERO_BYTES = 65536;

__device__ __forceinline__ float wave_sum(float v) {
#pragma unroll
    for (int o = 1; o < 64; o <<= 1) v += __shfl_xor(v, o);
    return v;
}
__device__ __forceinline__ float bf2f(unsigned short b) { return __uint_as_float((unsigned)b << 16); }
__device__ __forceinline__ unsigned cvtpk(float lo, float hi) { return pg8::cvt_pk_bf16(lo, hi); }
#define BLOCK_BAR() asm volatile("s_waitcnt vmcnt(0) lgkmcnt(0)\n\ts_barrier" ::: "memory")
#define XB_TMO      128
#define XB_XCNT(j)  (256  + 64 * (j))
#define XB_XSUB(j)  (1280 + 64 * (j))
#define XB_XGEN(j)  (2304 + 64 * (j))
#define XB_TOP      3328
#define XB_TOPGEN   3392
#define XCD_BAR_WORDS 3456
#define XB_SPIN_CAP (1u << 18)

__device__ __forceinline__ unsigned xb_ld(unsigned* p)              { return __hip_atomic_load(p, __ATOMIC_RELAXED, __HIP_MEMORY_SCOPE_AGENT); }
__device__ __forceinline__ unsigned xb_add(unsigned* p, unsigned v) { return __hip_atomic_fetch_add(p, v, __ATOMIC_RELAXED, __HIP_MEMORY_SCOPE_AGENT); }
__device__ __forceinline__ unsigned xb_xcc_id() { return (unsigned)__builtin_amdgcn_s_getreg((3 << 11) | 20) & 0xFu; }
#define XB_SPIN(cond, bar) do { unsigned _sp = 0; while (cond) { __builtin_amdgcn_s_sleep(1); \
    if ((++_sp & 255u) == 0u) { if (xb_ld(&(bar)[XB_TMO])) break; if (_sp > XB_SPIN_CAP) { atomicAdd(&(bar)[XB_TMO], 1u); break; } } } } while (0)

struct XcdBarrier {
    unsigned* bar; unsigned x;
    volatile LAS unsigned* st;
};

__device__ __forceinline__ XcdBarrier xcd_barrier_post(unsigned* bar, volatile LAS unsigned* st) {
    XcdBarrier b; b.bar = bar; b.x = xb_xcc_id(); b.st = st;
    if (threadIdx.x == 0) (void)xb_add(&bar[XB_XCNT(b.x)], 1u);
    return b;
}
__device__ __forceinline__ void xcd_barrier_complete(unsigned* bar, unsigned x, unsigned& nloc, unsigned& nx) {
    const unsigned G = gridDim.x * gridDim.y * gridDim.z;
    unsigned sum, cnt, mine, sp = 0u;
    for (;;) {
        sum = 0u; cnt = 0u; mine = 0u;
#pragma unroll
        for (unsigned j = 0; j < 16; ++j) { const unsigned c = xb_ld(&bar[XB_XCNT(j)]); sum += c; cnt += (c > 0u) ? 1u : 0u; mine = (j == x) ? c : mine; }
        if (sum == G) break;
        __builtin_amdgcn_s_sleep(1);
        if ((++sp & 255u) == 0u) { if (xb_ld(&bar[XB_TMO])) break; if (sp > XB_SPIN_CAP) { atomicAdd(&bar[XB_TMO], 1u); break; } }
    }
    nloc = mine > 0u ? mine : 1u; nx = cnt > 0u ? cnt : 1u;
}

__device__ __forceinline__ void xcd_barrier(const XcdBarrier& b) {
    asm volatile("s_waitcnt vmcnt(0)" ::: "memory");
    __syncthreads();
    if (threadIdx.x == 0) {
        unsigned* bar = b.bar;
        __builtin_amdgcn_s_waitcnt(0);
        unsigned nloc = b.st[0], nx = b.st[1];
        if (nloc == 0u) { xcd_barrier_complete(bar, b.x, nloc, nx); b.st[0] = nloc; b.st[1] = nx; }
        const unsigned old = xb_add(&bar[XB_XSUB(b.x)], 1u);
        const unsigned gen = old / nloc;
        if (old + 1u == (gen + 1u) * nloc) {
            __builtin_amdgcn_fence(__ATOMIC_RELEASE, "agent");
            asm volatile("s_waitcnt vmcnt(0)" ::: "memory");
            const unsigned og = xb_add(&bar[XB_TOP], 1u);
            const unsigned tg = og / nx;
            if (og + 1u == (tg + 1u) * nx) xb_add(&bar[XB_TOPGEN], 1u);
            else XB_SPIN(xb_ld(&bar[XB_TOPGEN]) == tg, bar);
            __builtin_amdgcn_fence(__ATOMIC_ACQUIRE, "agent");
            xb_add(&bar[XB_XGEN(b.x)], 1u);
            asm volatile("s_waitcnt vmcnt(0)" ::: "memory");
        } else {
            XB_SPIN(xb_ld(&bar[XB_XGEN(b.x)]) == gen, bar);
            __builtin_amdgcn_fence(__ATOMIC_ACQUIRE, "agent");
            asm volatile("s_waitcnt vmcnt(0)" ::: "memory");
        }
    }
    __syncthreads();
}


constexpr size_t MiB = 1u << 20;
constexpr size_t WS_CTL = 0, WS_WIN = 1 * MiB, WS_WPW = 10 * MiB, WS_WAO = 11 * MiB, WS_WOUT = 12 * MiB, WS_WGU = 14 * MiB, WS_WDN = 25 * MiB, WS_RSTD = 31 * MiB,
                 WS_SS = 32 * MiB, WS_SS2 = 34 * MiB, WS_CBP = 36 * MiB, WS_CBS = 37 * MiB, WS_XB = 40 * MiB, WS_CU = 73 * MiB, WS_Q = 90 * MiB, WS_K = 107 * MiB, WS_V = 124 * MiB,
                 WS_GC = 141 * MiB, WS_GA = 174 * MiB, WS_CS = 207 * MiB, WS_AO = 224 * MiB, WS_MIX = 241 * MiB, WS_H = 274 * MiB, WS_HB = 340 * MiB, WS_ACT = 373 * MiB, WS_END = 464 * MiB;
constexpr int CBS_PITCH = 4160;

struct Args { const float* in[21]; float* out; unsigned char* ws; int ph_lo, ph_hi; };

__device__ __forceinline__ void transpose_item(const float* W, int N, int K, int src_col0, int k0, bf16* WT, int dst_row0, const float* gk, LAS float* scr, int lane) {
#pragma unroll 8
    for (int i = 0; i < 32; ++i) { const int kk = 2 * i + (lane >> 5); const float g = gk ? gk[k0 + kk] : 1.0f; scr[kk * 33 + (lane & 31)] = W[(size_t)(k0 + kk) * N + src_col0 + (lane & 31)] * g; }
    asm volatile("s_waitcnt lgkmcnt(0)" ::: "memory");
    const int c = lane & 7;
#pragma unroll
    for (int j = 0; j < 4; ++j) { const int n = (lane >> 3) + 8 * j; const LAS float* s = scr + (8 * c) * 33 + n;
        u32x4 o; o.x = cvtpk(s[0 * 33], s[1 * 33]); o.y = cvtpk(s[2 * 33], s[3 * 33]); o.z = cvtpk(s[4 * 33], s[5 * 33]); o.w = cvtpk(s[6 * 33], s[7 * 33]);
        *(u32x4*)(WT + (size_t)(dst_row0 + n) * K + k0 + 8 * c) = o; }
    asm volatile("s_waitcnt lgkmcnt(0)" ::: "memory");
}

__device__ __forceinline__ void p0_prologue(const Args& a, ldsp lds, int wave, int lane) {
    unsigned char* ws = a.ws;
    const int gw = blockIdx.x * NWAVES + wave, NGW = gridDim.x * NWAVES;
    if (blockIdx.x == 0 && threadIdx.x == 0) __hip_atomic_store((unsigned*)(ws + WS_CTL), 0u, __ATOMIC_RELAXED, __HIP_MEMORY_SCOPE_AGENT);
    LAS float* gwf = (LAS float*)lds;
    { const float* win = a.in[7]; const float* g = a.in[6];
      for (int e = threadIdx.x; e < 8 * DM; e += NTHREADS) { const int k = e >> 3, h = e & 7; gwf[h * DM + k] = win[(size_t)k * DIN + 2560 + h] * g[k]; } }
    LAS float* scr = (LAS float*)(lds + 32768 + wave * 8448);
    constexpr int I_IN = (DM / 64) * (NIN / 32), I_PW = (DC / 64) * (DM / 32), I_AO = (DA / 64) * (DM / 32), I_OUT = (DM / 64) * (DM / 32), I_GU = (DM / 64) * (NGU / 32), I_DN = (DFF / 64) * (DM / 32);
    constexpr int NITEMS = I_IN + I_PW + I_AO + I_OUT + I_GU + I_DN;
    for (int it = gw; it < NITEMS; it += NGW) {
        int r = it;
        if (r < I_IN) { const int nblk = NIN / 32, kb = r / nblk, nb = r % nblk, n = 32 * nb; int src;
            if (n < 1024) { const int pn = n >> 8, rr = n & 255; src = rr < 128 ? 128 * pn + rr : 512 + 128 * pn + (rr - 128); } else if (n < 2560) src = n; else src = n + 8;
            transpose_item(a.in[7], DIN, DM, src, 64 * kb, (bf16*)(ws + WS_WIN), n, a.in[6], scr, lane); continue; } r -= I_IN;
        if (r < I_PW) { const int nblk = DM / 32, kb = r / nblk, nb = r % nblk; transpose_item(a.in[13], DM, DC, 32 * nb, 64 * kb, (bf16*)(ws + WS_WPW), 32 * nb, nullptr, scr, lane); continue; } r -= I_PW;
        if (r < I_AO) { const int nblk = DM / 32, kb = r / nblk, nb = r % nblk; transpose_item(a.in[14], DM, DA, 32 * nb, 64 * kb, (bf16*)(ws + WS_WAO), 32 * nb, nullptr, scr, lane); continue; } r -= I_AO;
        if (r < I_OUT) { const int nblk = DM / 32, kb = r / nblk, nb = r % nblk; transpose_item(a.in[15], DM, DM, 32 * nb, 64 * kb, (bf16*)(ws + WS_WOUT), 32 * nb, nullptr, scr, lane); continue; } r -= I_OUT;
        if (r < I_GU) { const int nblk = NGU / 32, kb = r / nblk, nb = r % nblk, n = 32 * nb, pn = n >> 8, rr = n & 255;
            const float* src = rr < 128 ? a.in[17] : a.in[18]; const int sc = rr < 128 ? 128 * pn + rr : 128 * pn + (rr - 128);
            transpose_item(src, DFF, DM, sc, 64 * kb, (bf16*)(ws + WS_WGU), n, a.in[16], scr, lane); continue; } r -= I_GU;
        { const int nblk = DM / 32, kb = r / nblk, nb = r % nblk; transpose_item(a.in[19], DM, DFF, 32 * nb, 64 * kb, (bf16*)(ws + WS_WDN), 32 * nb, nullptr, scr, lane); }
    }
    __syncthreads();
    float* rstd = (float*)(ws + WS_RSTD); bf16* XB = (bf16*)(ws + WS_XB); const float* bfv = a.in[8];
    for (int m = gw; m < MT; m += NGW) {
        const float* xrow = (m < MP) ? a.in[0] + (size_t)m * DM : a.in[1] + (size_t)(m - MP) * DM;
        const f32x4* xr = (const f32x4*)xrow + lane;
        f32x4 v[4]; float s = 0.f;
#pragma unroll
        for (int j = 0; j < 4; ++j) { v[j] = xr[64 * j]; s += (v[j].x * v[j].x + v[j].y * v[j].y) + (v[j].z * v[j].z + v[j].w * v[j].w); }
        const float rs = 1.0f / sqrtf(wave_sum(s) * (1.0f / DM) + 1e-6f);
        unsigned long long* o8 = (unsigned long long*)(XB + (size_t)m * DM) + lane;
#pragma unroll
        for (int j = 0; j < 4; ++j) o8[64 * j] = (unsigned long long)cvtpk(v[j].x, v[j].y) | ((unsigned long long)cvtpk(v[j].z, v[j].w) << 32);
        float f[8];
#pragma unroll
        for (int h = 0; h < 8; ++h) { float acc = 0.f;
#pragma unroll
            for (int j = 0; j < 4; ++j) { const f32x4 w = *(const LAS f32x4*)(gwf + h * DM + 4 * lane + 256 * j); acc += (v[j].x * w.x + v[j].y * w.y) + (v[j].z * w.z + v[j].w * w.w); }
            f[h] = wave_sum(acc); }
        float fl = f[0];
#pragma unroll
        for (int h = 1; h < 8; ++h) fl = (lane == h) ? f[h] : fl;
        if (lane == 0) rstd[m] = rs;
        if (lane < 8) { const float z = fl * rs + bfv[lane]; const float lf = fminf(z, 0.f) - log1pf(expf(-fabsf(z)));
            float* dst = (m < MP) ? a.out + OFF_LFP + (size_t)m * NH + lane : a.out + OFF_LFS + (size_t)(m - MP) * NH + lane; *dst = lf; }
    }
}

__device__ __forceinline__ void cumsum_phase(const Args& a, int wave, int lane) {
    const int gw = blockIdx.x * NWAVES + wave;
    if (gw >= 160) return;
    unsigned char* ws = a.ws;
    const float* src; float* dst; const float* extra = nullptr;
    if (gw < 32) { const int b = gw >> 3, h = gw & 7; src = a.out + OFF_LFP + (size_t)b * SEQ * NH + h; dst = (float*)(ws + WS_CBP) + (size_t)gw * SEQ; }
    else { const int s = gw - 32, b = s >> 3, h = s & 7; src = a.in[4] + (size_t)b * PAST * NH + h; dst = (float*)(ws + WS_CBS) + (size_t)s * CBS_PITCH; extra = a.out + OFF_LFS + (size_t)b * DS * NH + h; }
    const float* p = src + (size_t)lane * 64 * NH;
    float tot = 0.f;
    for (int i = 0; i < 64; ++i) tot += p[i * NH];
    float incl = tot;
#pragma unroll
    for (int o = 1; o < 64; o <<= 1) { const float t = __shfl_up(incl, o); if (lane >= o) incl += t; }
    float run = incl - tot;
    for (int i = 0; i < 64; ++i) { run += p[i * NH]; dst[lane * 64 + i] = -run * LOG2E; }
    if (extra) {
        const float total = __shfl(incl, 63);
        float v = (lane < 32) ? extra[lane * NH] : 0.f; float ic = v;
#pragma unroll
        for (int o = 1; o < 64; o <<= 1) { const float t = __shfl_up(ic, o); if (lane >= o) ic += t; }
        dst[PAST + lane] = (lane < 32) ? -(total + ic) * LOG2E : 0.f;
    }
}

namespace att {
__device__ __forceinline__ int crow(int r, int hi) { return (r & 3) + 8 * (r >> 2) + 4 * hi; }
#define SBAR() __builtin_amdgcn_sched_barrier(0)
__device__ __forceinline__ void qkt(f32x16& p0, f32x16& p1, const LAS unsigned char* Kslot, const bf16x8* qr, int r32, int hi) {
    const LAS unsigned char* kb = Kslot + hi * 1024 + r32 * 16;
    f32x16 z = {};
#pragma unroll
    for (int d0 = 0; d0 < 4; ++d0) {
        const bf16x8 b0 = *(const LAS bf16x8*)(kb + d0 * 2048), b1 = *(const LAS bf16x8*)(kb + d0 * 2048 + 512);
        if (d0 == 0) { p0 = __builtin_amdgcn_mfma_f32_32x32x16_bf16(b0, qr[0], z, 0, 0, 0); p1 = __builtin_amdgcn_mfma_f32_32x32x16_bf16(b1, qr[0], z, 0, 0, 0); }
        else { p0 = __builtin_amdgcn_mfma_f32_32x32x16_bf16(b0, qr[d0], p0, 0, 0, 0); p1 = __builtin_amdgcn_mfma_f32_32x32x16_bf16(b1, qr[d0], p1, 0, 0, 0); } }
}
__device__ __forceinline__ void pv(f32x16* o, int vb, bf16x8 pa0, bf16x8 pa1, bf16x8 pa2, bf16x8 pa3) {
#pragma unroll
    for (int d0 = 0; d0 < 2; ++d0) { s16x4 lo[4], hi[4];
#pragma unroll
        for (int ks = 0; ks < 4; ++ks) {
            asm volatile("ds_read_b64_tr_b16 %0,%1 offset:%c2" : "=&v"(lo[ks]) : "v"(vb), "i"(d0 * 4096 + ks * 1024) : "memory");
            asm volatile("ds_read_b64_tr_b16 %0,%1 offset:%c2" : "=&v"(hi[ks]) : "v"(vb), "i"(d0 * 4096 + ks * 1024 + 512) : "memory"); }
        asm volatile("s_waitcnt lgkmcnt(0)" ::: "memory"); SBAR();
#define PK(k) (bf16x8){lo[k][0], lo[k][1], lo[k][2], lo[k][3], hi[k][0], hi[k][1], hi[k][2], hi[k][3]}
        o[d0] = __builtin_amdgcn_mfma_f32_32x32x16_bf16(pa0, PK(0), o[d0], 0, 0, 0);
        o[d0] = __builtin_amdgcn_mfma_f32_32x32x16_bf16(pa1, PK(1), o[d0], 0, 0, 0);
        o[d0] = __builtin_amdgcn_mfma_f32_32x32x16_bf16(pa2, PK(2), o[d0], 0, 0, 0);
        o[d0] = __builtin_amdgcn_mfma_f32_32x32x16_bf16(pa3, PK(3), o[d0], 0, 0, 0);
#undef PK
    }
}
__device__ __forceinline__ float rowmax(const f32x16& p0, const f32x16& p1) {
    float m = fmaxf(p0[0], p1[0]);
#pragma unroll
    for (int r = 1; r < 16; ++r) m = fmaxf(m, fmaxf(p0[r], p1[r]));
    auto rr = __builtin_amdgcn_permlane32_swap(__float_as_uint(m), __float_as_uint(m), false, false);
    return fmaxf(__uint_as_float(rr[0]), __uint_as_float(rr[1]));
}
__device__ __forceinline__ void tile_a(const LAS unsigned char* Kslot, const LAS float* bs, const bf16x8* qr, bool mask, int koff, int qrel, int r32, int hi,
                                          float& m_run, float& l_run, f32x16* o, LAS float* wsf, u32x4& pw0, u32x4& pw1, u32x4& pw2, u32x4& pw3) {
    f32x16 p0, p1; qkt(p0, p1, Kslot, qr, r32, hi);
#pragma unroll
    for (int i = 0; i < 4; ++i) { const f32x4 b0 = *(const LAS f32x4*)(bs + 8 * i + 4 * hi), b1 = *(const LAS f32x4*)(bs + 32 + 8 * i + 4 * hi);
#pragma unroll
        for (int j = 0; j < 4; ++j) { p0[4 * i + j] += b0[j]; p1[4 * i + j] += b1[j]; } }
    if (mask) {
#pragma unroll
        for (int r = 0; r < 16; ++r) { const int kv = koff + crow(r, hi); if (kv > qrel) p0[r] = -INFINITY; if (kv + 32 > qrel) p1[r] = -INFINITY; } }
    const float rm = rowmax(p0, p1);
    const float mn = fmaxf(m_run, rm), f = __builtin_amdgcn_exp2f(m_run - mn); m_run = mn;
    float s = 0.f;
#pragma unroll
    for (int r = 0; r < 16; ++r) { p0[r] = __builtin_amdgcn_exp2f(p0[r] - mn); p1[r] = __builtin_amdgcn_exp2f(p1[r] - mn); s += p0[r] + p1[r]; }
    l_run = l_run * f + s;
    if (hi == 0) wsf[r32] = f;
    asm volatile("s_waitcnt lgkmcnt(0)" ::: "memory");
#pragma unroll
    for (int i = 0; i < 4; ++i) { const f32x4 fv = *(const LAS f32x4*)(wsf + 8 * i + 4 * hi);
#pragma unroll
        for (int j = 0; j < 4; ++j) { o[0][4 * i + j] *= fv[j]; o[1][4 * i + j] *= fv[j]; } }
#pragma unroll
    for (int j = 0; j < 4; ++j) { pw0[j] = cvtpk(p0[2 * j], p0[2 * j + 1]); pw1[j] = cvtpk(p0[8 + 2 * j], p0[9 + 2 * j]); pw2[j] = cvtpk(p1[2 * j], p1[2 * j + 1]); pw3[j] = cvtpk(p1[8 + 2 * j], p1[9 + 2 * j]); }
}
__device__ __forceinline__ void tile_core(const LAS unsigned char* Kslot, int vb, const LAS float* bs, const bf16x8* qr, bool mask, int koff, int qrel, int r32, int hi,
                                          float& m_run, float& l_run, f32x16* o, LAS float* wsf) {
    u32x4 pw0, pw1, pw2, pw3;
    tile_a(Kslot, bs, qr, mask, koff, qrel, r32, hi, m_run, l_run, o, wsf, pw0, pw1, pw2, pw3);
    pv(o, vb, __builtin_bit_cast(bf16x8, pw0), __builtin_bit_cast(bf16x8, pw1), __builtin_bit_cast(bf16x8, pw2), __builtin_bit_cast(bf16x8, pw3));
}
__device__ __forceinline__ int vbase(int lane, int hi) { return ((lane >> 4) & 1) * 32 + (lane & 3) * 8 + (4 * hi + ((lane & 15) >> 2)) * 64; }

constexpr int PL_K = 0, PL_V = 16384, PL_B = 32768, PL_WS = 33280, PL_OST = 36864;
__device__ __forceinline__ void prompt_unit(int b, int h, int qb, const bf16* Q, const bf16* K, const bf16* V, const float* CB, bf16* O, ldsp lds) {
    int tid_ = threadIdx.x; asm volatile("" : "+v"(tid_));
    const int tid = tid_, lane = tid & 63, r32 = lane & 31, hi = lane >> 5; const int wid = __builtin_amdgcn_readfirstlane(tid >> 6);
    const size_t rowbase = (size_t)b * SEQ; const int q0 = qb * 256;
    const bf16* Qw = Q + (rowbase + q0 + wid * 32) * DA + h * HD;
    const bf16* Kh = K + rowbase * DA + h * HD; const bf16* Vh = V + rowbase * DA + h * HD;
    const float* cb = CB + (size_t)(b * NH + h) * SEQ;
    const bf16* ksrc = Kh + (size_t)lane * DA + wid * 8;
    const bf16* vsrc = Vh + (size_t)(16 * (wid & 3) + (lane >> 2)) * DA + (wid >> 2) * 32 + (lane & 3) * 8;
    const int NT = (q0 + 256) / 64;
#define DMA_TILE(t, slot) do { \
        __builtin_amdgcn_global_load_lds((const unsigned*)(ksrc + (size_t)(t) * 64 * DA), (LAS unsigned*)(lds + PL_K + (slot) * 8192 + wid * 1024), 16, 0, 0); \
        __builtin_amdgcn_global_load_lds((const unsigned*)(vsrc + (size_t)(t) * 64 * DA), (LAS unsigned*)(lds + PL_V + (slot) * 8192 + wid * 1024), 16, 0, 0); \
        if (wid == 0) __builtin_amdgcn_global_load_lds((const unsigned*)(cb + (t) * 64 + lane), (LAS unsigned*)(lds + PL_B + (slot) * 256), 4, 0, 0); } while (0)
    DMA_TILE(0, 0);
    bf16x8 qr[4];
#pragma unroll
    for (int d0 = 0; d0 < 4; ++d0) qr[d0] = *(const bf16x8*)(Qw + (size_t)r32 * DA + d0 * 16 + hi * 8);
    float m_run = -1e30f, l_run = 0.f; f32x16 o[2]; o[0] = f32x16{}; o[1] = f32x16{};
    LAS float* wsf = (LAS float*)(lds + PL_WS + wid * 256);
    const int lds0 = (int)(unsigned)(uintptr_t)lds;
    const int vb0 = lds0 + PL_V + vbase(lane, hi);
    const int qrel = wid * 32 + r32;
    for (int t = 0; t < NT; ++t) {
        BLOCK_BAR();
        const int slot = t & 1;
        if (t + 1 < NT) DMA_TILE(t + 1, slot ^ 1);
        const int jb = t - (NT - 4);
        if (jb < 0 || 64 * jb <= wid * 32 + 31)
            tile_core(lds + PL_K + slot * 8192, vb0 + slot * 8192, (const LAS float*)(lds + PL_B + slot * 256), qr, jb >= 0, 64 * jb, qrel, r32, hi, m_run, l_run, o, wsf);
    }
#undef DMA_TILE
    { auto rr = __builtin_amdgcn_permlane32_swap(__float_as_uint(l_run), __float_as_uint(l_run), false, false); l_run = __uint_as_float(rr[0]) + __uint_as_float(rr[1]); }
    if (hi == 0) wsf[32 + r32] = l_run;
    asm volatile("s_waitcnt lgkmcnt(0)" ::: "memory");
    float rli[16];
#pragma unroll
    for (int r = 0; r < 16; ++r) rli[r] = 1.0f / wsf[32 + crow(r, hi)];
    bf16* Ow = O + (rowbase + q0 + wid * 32) * DA + h * HD;
    { LAS bf16* stg = (LAS bf16*)(lds + PL_OST + wid * 4096);
#pragma unroll
      for (int r = 0; r < 16; ++r) { const int orow = crow(r, hi);
#pragma unroll
          for (int d0 = 0; d0 < 2; ++d0) { const float v = o[d0][r] * rli[r]; stg[orow * 64 + d0 * 32 + r32] = (bf16)(cvtpk(v, v) & 0xffffu); } }
      asm volatile("s_waitcnt lgkmcnt(0)" ::: "memory");
#pragma unroll
      for (int i = 0; i < 4; ++i) { const int row = i * 8 + (lane >> 3), ch = lane & 7; const u32x4 v = *(const LAS u32x4*)(stg + row * 64 + ch * 8); *(u32x4*)(Ow + (size_t)row * DA + ch * 8) = v; } }
    BLOCK_BAR();
}

constexpr int SL_B = 131072, SL_WS = 133120, SL_M = 135168, SL_L = 136192;
__device__ __forceinline__ void sample_unit(int b, int h, const Args& a, ldsp lds) {
    int tid_ = threadIdx.x; asm volatile("" : "+v"(tid_));
    const int tid = tid_, lane = tid & 63, r32 = lane & 31, hi = lane >> 5; const int wid = __builtin_amdgcn_readfirstlane(tid >> 6);
    unsigned char* ws = a.ws;
    const bf16* Q = (const bf16*)(ws + WS_Q); const bf16* Kn = (const bf16*)(ws + WS_K); const bf16* Vn = (const bf16*)(ws + WS_V); bf16* O = (bf16*)(ws + WS_AO);
    const float* cbs = (const float*)(ws + WS_CBS) + (size_t)(b * NH + h) * CBS_PITCH;
    const size_t srow = (size_t)MP + (size_t)b * DS;
    const float* ck = a.in[2] + ((size_t)b * PAST * NH + h) * HD; const float* cv = a.in[3] + ((size_t)b * PAST * NH + h) * HD;
    ldsp Kw = lds + wid * 16384; ldsp Vw = Kw + 8192;
    LAS float* bsw = (LAS float*)(lds + SL_B + wid * 256); LAS float* wsf = (LAS float*)(lds + SL_WS + wid * 256);
    bf16x8 qr[4];
#pragma unroll
    for (int d0 = 0; d0 < 4; ++d0) qr[d0] = *(const bf16x8*)(Q + (srow + r32) * DA + h * HD + d0 * 16 + hi * 8);
    float m_run = -1e30f, l_run = 0.f; f32x16 o[2]; o[0] = f32x16{}; o[1] = f32x16{};
    const int vb0 = (int)(unsigned)(uintptr_t)Vw + vbase(lane, hi);
    const int f4 = lane & 15, kq = lane >> 4; const int voff = (kq * DA + 4 * f4) * 4;
    const __amdgpu_buffer_rsrc_t rk = __builtin_amdgcn_make_buffer_rsrc((void*)ck, 0, PAST * 2048, 0x00027000), rv = __builtin_amdgcn_make_buffer_rsrc((void*)cv, 0, PAST * 2048, 0x00027000);
    const int koffK = (f4 >> 1) * 1024 + (f4 & 1) * 8;
    const int koffV = (f4 >> 3) * 4096 + ((f4 & 7) >> 1) * 16 + (f4 & 1) * 8;
    f32x4 kreg[8];
#pragma unroll
    for (int i = 0; i < 8; ++i) kreg[i] = __builtin_bit_cast(f32x4, __builtin_amdgcn_raw_buffer_load_b128(rk, voff, (512 * wid + 4 * i) * 2048, 0));
    for (int tt = 0; tt < 8; ++tt) {
        const int key0 = 512 * wid + 64 * tt;
        { f32x4 kreg2[8];
#pragma unroll
          for (int i = 0; i < 8; ++i) kreg2[i] = __builtin_bit_cast(f32x4, __builtin_amdgcn_raw_buffer_load_b128(rk, voff, (key0 + 32 + 4 * i) * 2048, 0));
#pragma unroll
          for (int i = 0; i < 8; ++i) { const int key = 4 * i + kq; u32x2 w; w.x = cvtpk(kreg[i].x, kreg[i].y); w.y = cvtpk(kreg[i].z, kreg[i].w); *(LAS u32x2*)(Kw + koffK + key * 16) = w; }
#pragma unroll
          for (int i = 0; i < 8; ++i) { const int key = 32 + 4 * i + kq; u32x2 w; w.x = cvtpk(kreg2[i].x, kreg2[i].y); w.y = cvtpk(kreg2[i].z, kreg2[i].w); *(LAS u32x2*)(Kw + koffK + key * 16) = w; } }
        asm volatile("" ::: "memory");
        f32x4 vreg[16];
#pragma unroll
        for (int i = 0; i < 16; ++i) vreg[i] = __builtin_bit_cast(f32x4, __builtin_amdgcn_raw_buffer_load_b128(rv, voff, (key0 + 4 * i) * 2048, 0));
        bsw[lane] = cbs[key0 + lane];
        asm volatile("s_waitcnt lgkmcnt(0)" ::: "memory");
        u32x4 pw0, pw1, pw2, pw3;
        tile_a(Kw, bsw, qr, false, 0, 0, r32, hi, m_run, l_run, o, wsf, pw0, pw1, pw2, pw3);
        asm volatile("" ::: "memory");
#pragma unroll
        for (int i = 0; i < 16; ++i) { const int key = 4 * i + kq; u32x2 w; w.x = cvtpk(vreg[i].x, vreg[i].y); w.y = cvtpk(vreg[i].z, vreg[i].w); *(LAS u32x2*)(Vw + koffV + (key >> 4) * 1024 + (key & 15) * 64) = w; }
        asm volatile("" ::: "memory");
        if (tt < 7) {
#pragma unroll
            for (int i = 0; i < 8; ++i) kreg[i] = __builtin_bit_cast(f32x4, __builtin_amdgcn_raw_buffer_load_b128(rk, voff, (key0 + 64 + 4 * i) * 2048, 0)); }
        asm volatile("s_waitcnt lgkmcnt(0)" ::: "memory");
        pv(o, vb0, __builtin_bit_cast(bf16x8, pw0), __builtin_bit_cast(bf16x8, pw1), __builtin_bit_cast(bf16x8, pw2), __builtin_bit_cast(bf16x8, pw3));
    }
    if (wid == 7) {
        const int key = lane >> 1, half = lane & 1;
        const u32x4* kp = (const u32x4*)(Kn + (srow + key) * DA + h * HD + half * 32); const u32x4* vp = (const u32x4*)(Vn + (srow + key) * DA + h * HD + half * 32);
#pragma unroll
        for (int c = 0; c < 4; ++c) { *(LAS u32x4*)(Kw + (4 * half + c) * 1024 + key * 16) = kp[c]; *(LAS u32x4*)(Kw + (4 * half + c) * 1024 + (key + 32) * 16) = (u32x4){0u, 0u, 0u, 0u}; }
#pragma unroll
        for (int c = 0; c < 4; ++c) { *(LAS u32x4*)(Vw + (half * 4 + (key >> 4)) * 1024 + ((key & 15) * 4 + c) * 16) = vp[c]; *(LAS u32x4*)(Vw + (half * 4 + 2 + (key >> 4)) * 1024 + ((key & 15) * 4 + c) * 16) = (u32x4){0u, 0u, 0u, 0u}; }
        bsw[lane] = cbs[PAST + lane];
        asm volatile("s_waitcnt lgkmcnt(0)" ::: "memory");
        tile_core(Kw, vb0, bsw, qr, true, 0, r32, r32, hi, m_run, l_run, o, wsf);
    }
    { auto rr = __builtin_amdgcn_permlane32_swap(__float_as_uint(l_run), __float_as_uint(l_run), false, false); l_run = __uint_as_float(rr[0]) + __uint_as_float(rr[1]); }
    LAS float* Mw = (LAS float*)(lds + SL_M); LAS float* Lw = (LAS float*)(lds + SL_L);
    if (hi == 0) { Mw[wid * 32 + r32] = m_run; Lw[wid * 32 + r32] = l_run; }
    BLOCK_BAR();
    float M = -1e30f;
#pragma unroll
    for (int w = 0; w < 8; ++w) M = fmaxf(M, Mw[w * 32 + r32]);
    float L = 0.f;
#pragma unroll
    for (int w = 0; w < 8; ++w) L += Lw[w * 32 + r32] * __builtin_amdgcn_exp2f(Mw[w * 32 + r32] - M);
    const float g = __builtin_amdgcn_exp2f(m_run - M) / L;
    if (hi == 0) wsf[r32] = g;
    asm volatile("s_waitcnt lgkmcnt(0)" ::: "memory");
    LAS float* OW = (LAS float*)Kw;
#pragma unroll
    for (int r = 0; r < 16; ++r) { const int q = crow(r, hi); const float gg = wsf[q];
#pragma unroll
        for (int d0 = 0; d0 < 2; ++d0) OW[q * 64 + d0 * 32 + r32] = o[d0][r] * gg; }
    BLOCK_BAR();
    { const int q = tid >> 4, d = (tid & 15) * 4; f32x4 acc = {0.f, 0.f, 0.f, 0.f};
#pragma unroll
      for (int w = 0; w < 8; ++w) acc += *(const LAS f32x4*)(lds + w * 16384 + (q * 64 + d) * 4);
      u32x2 wv; wv.x = cvtpk(acc.x, acc.y); wv.y = cvtpk(acc.z, acc.w); *(u32x2*)(O + (srow + q) * DA + h * HD + d) = wv; }
    BLOCK_BAR();
}
#undef SBAR
}

__device__ __forceinline__ void conv_unit(int u, const Args& a, ldsp lds) {
    int tid_ = threadIdx.x; asm volatile("" : "+v"(tid_));
    const int tid = tid_, lane = tid & 63; const int wid = __builtin_amdgcn_readfirstlane(tid >> 6);
    unsigned char* ws = a.ws; const bf16* CU = (const bf16*)(ws + WS_CU); bf16* CS = (bf16*)(ws + WS_CS);
    const int row0 = 32 * u, ch = tid;
    const float* wdw = a.in[9]; const float* bdw = a.in[10]; const float* lng = a.in[11]; const float* lnb = a.in[12];
    asm volatile("" : "+s"(wdw), "+s"(bdw), "+s"(lng), "+s"(lnb));
    float w[CW];
#pragma unroll
    for (int j = 0; j < CW; ++j) w[j] = wdw[j * DC + ch];
    const float bias = bdw[ch];
    float in[62];
    if (row0 < MP) { const bool first = (row0 & (SEQ - 1)) == 0;
#pragma unroll
        for (int i = 0; i < 62; ++i) { float v = 0.f; if (!(first && i < 30)) v = bf2f(CU[(size_t)(row0 - 30 + i) * DC + ch]); in[i] = v; } }
    else { const int b = (row0 - MP) >> 5; const float* st = a.in[5] + (size_t)b * 30 * DC + ch;
#pragma unroll
        for (int i = 0; i < 30; ++i) in[i] = st[(size_t)i * DC];
#pragma unroll
        for (int i = 30; i < 62; ++i) in[i] = bf2f(CU[(size_t)(row0 - 30 + i) * DC + ch]); }
    LAS float* Y = (LAS float*)lds;
#pragma unroll
    for (int r = 0; r < 32; ++r) { float acc = bias;
#pragma unroll
        for (int j = 0; j < CW; ++j) acc += w[j] * in[r + j];
        Y[r * DC + ch] = acc; }
    BLOCK_BAR();
    const float* lg = lng + 8 * lane; const float* lb = lnb + 8 * lane;
    const f32x4 g0 = *(const f32x4*)lg, g1 = *(const f32x4*)(lg + 4), b0 = *(const f32x4*)lb, b1 = *(const f32x4*)(lb + 4);
#pragma unroll
    for (int rr = 0; rr < 4; ++rr) { const int r = wid * 4 + rr;
        f32x4 v0 = *(const LAS f32x4*)(Y + r * DC + 8 * lane), v1 = *(const LAS f32x4*)(Y + r * DC + 8 * lane + 4);
        const float mean = wave_sum((v0.x + v0.y) + (v0.z + v0.w) + (v1.x + v1.y) + (v1.z + v1.w)) * (1.0f / DC);
        v0 = v0 - mean; v1 = v1 - mean;
        const float var = wave_sum((v0.x * v0.x + v0.y * v0.y) + (v0.z * v0.z + v0.w * v0.w) + (v1.x * v1.x + v1.y * v1.y) + (v1.z * v1.z + v1.w * v1.w)) * (1.0f / DC);
        const float rs = 1.0f / sqrtf(var + 1e-5f);
        f32x4 y0 = v0 * rs * g0 + b0, y1 = v1 * rs * g1 + b1;
        y0 = y0 * pg8::sigm4(y0); y1 = y1 * pg8::sigm4(y1);
        *(u32x4*)(CS + (size_t)(row0 + r) * DC + 8 * lane) = pg8::pack8(y0, y1); }
    BLOCK_BAR();
}

constexpr int NU_SAMPLE = DB * NH, NU_PROMPT = 4 * NH * 16, NU_CONV = MT / 32, NU_TOTAL = NU_SAMPLE + NU_PROMPT + NU_CONV;
__device__ __forceinline__ void queue_phase(const Args& a, ldsp lds) {
    unsigned char* ws = a.ws; unsigned* ctr = (unsigned*)(ws + WS_CTL);
    volatile LAS unsigned* qw = (volatile LAS unsigned*)(lds + LDS_QW);
    for (;;) {
        if (threadIdx.x == 0) qw[0] = __hip_atomic_fetch_add(ctr, 1u, __ATOMIC_RELAXED, __HIP_MEMORY_SCOPE_AGENT);
        __syncthreads();
        const int id = (int)qw[0];
        __syncthreads();
        if (id >= NU_TOTAL) break;
        if (id < NU_SAMPLE) att::sample_unit(id >> 3, id & 7, a, lds);
        else if (id < NU_SAMPLE + NU_PROMPT) { const int j = id - NU_SAMPLE, qb = 15 - (j >> 5), bh = j & 31;
            att::prompt_unit(bh >> 3, bh & 7, qb, (const bf16*)(ws + WS_Q), (const bf16*)(ws + WS_K), (const bf16*)(ws + WS_V), (const float*)(ws + WS_CBP), (bf16*)(ws + WS_AO), lds); }
        else conv_unit(id - NU_SAMPLE - NU_PROMPT, a, lds);
    }
}

constexpr int SG_PITCH = 68;
template <int K> __device__ __forceinline__ void sg_accum(const bf16* A, const bf16* Bt, int row0, int col0, int wave, int lane, f32x4 (&acc)[2][4]) {
    const int fr = lane & 15, fq = lane >> 4;
    const bf16* ap = A + (size_t)(row0 + fr) * K + 8 * fq; const bf16* bp = Bt + (size_t)(col0 + fr) * K + 8 * fq;
#pragma unroll 2
    for (int ks = wave; ks < K / 32; ks += 8) {
        bf16x8 av[2], bv[4];
#pragma unroll
        for (int mi = 0; mi < 2; ++mi) av[mi] = *(const bf16x8*)(ap + (size_t)mi * 16 * K + ks * 32);
#pragma unroll
        for (int ni = 0; ni < 4; ++ni) bv[ni] = *(const bf16x8*)(bp + (size_t)ni * 16 * K + ks * 32);
#pragma unroll
        for (int mi = 0; mi < 2; ++mi)
#pragma unroll
            for (int ni = 0; ni < 4; ++ni) acc[mi][ni] = __builtin_amdgcn_mfma_f32_16x16x32_bf16(bv[ni], av[mi], acc[mi][ni], 0, 0, 0);
    }
}
__device__ __forceinline__ f32x4 sg_reduce(ldsp lds, const f32x4 (&acc)[2][4], int wave, int lane, int tid) {
    const int fr = lane & 15, fq = lane >> 4;
    LAS float* R = (LAS float*)lds + wave * (32 * SG_PITCH);
#pragma unroll
    for (int mi = 0; mi < 2; ++mi)
#pragma unroll
        for (int ni = 0; ni < 4; ++ni) *(LAS f32x4*)(R + (16 * mi + fr) * SG_PITCH + 16 * ni + 4 * fq) = acc[mi][ni];
    BLOCK_BAR();
    f32x4 sum = {0.f, 0.f, 0.f, 0.f};
#pragma unroll
    for (int w = 0; w < 8; ++w) sum += *(const LAS f32x4*)((LAS float*)lds + w * (32 * SG_PITCH) + (tid >> 4) * SG_PITCH + 4 * (tid & 15));
    BLOCK_BAR();
    return sum;
}
__device__ __forceinline__ f32x4 bf4(const bf16* p) { const u32x2 w = *(const u32x2*)p; f32x4 r; r[0] = __uint_as_float(w.x << 16); r[1] = __uint_as_float(w.x & 0xffff0000u); r[2] = __uint_as_float(w.y << 16); r[3] = __uint_as_float(w.y & 0xffff0000u); return r; }
__device__ __forceinline__ void st_bf4(bf16* p, const f32x4 v) { u32x2 w; w.x = cvtpk(v[0], v[1]); w.y = cvtpk(v[2], v[3]); *(u32x2*)p = w; }
__device__ __forceinline__ float row16_sum(float v) { v += __shfl_xor(v, 1); v += __shfl_xor(v, 2); v += __shfl_xor(v, 4); v += __shfl_xor(v, 8); return v; }
#define SG_ZERO(acc) do { _Pragma("unroll") for (int mi_ = 0; mi_ < 2; ++mi_) _Pragma("unroll") for (int ni_ = 0; ni_ < 4; ++ni_) acc[mi_][ni_] = (f32x4){0.f, 0.f, 0.f, 0.f}; } while (0)
__device__ __forceinline__ void small_mix(const Args& a, ldsp lds, int wave, int lane) {
    unsigned char* ws = a.ws; int tid_ = threadIdx.x; asm volatile("" : "+v"(tid_)); const int tid = tid_;
    for (int u = blockIdx.x; u < 256; u += gridDim.x) {
        const int row0 = MP + 32 * (u >> 4), col0 = 64 * (u & 15);
        f32x4 acc[2][4]; SG_ZERO(acc);
        sg_accum<DC>((const bf16*)(ws + WS_CS), (const bf16*)(ws + WS_WPW), row0, col0, wave, lane, acc);
        const f32x4 r1 = sg_reduce(lds, acc, wave, lane, tid);
        SG_ZERO(acc);
        sg_accum<DA>((const bf16*)(ws + WS_AO), (const bf16*)(ws + WS_WAO), row0, col0, wave, lane, acc);
        const f32x4 r2 = sg_reduce(lds, acc, wave, lane, tid);
        const size_t o = (size_t)(row0 + (tid >> 4)) * DM + col0 + 4 * (tid & 15);
        st_bf4((bf16*)(ws + WS_MIX) + o, bf4((const bf16*)(ws + WS_GC) + o) * r1 + bf4((const bf16*)(ws + WS_GA) + o) * r2);
    }
}
__device__ __forceinline__ void small_out(const Args& a, ldsp lds, int wave, int lane) {
    unsigned char* ws = a.ws; int tid_ = threadIdx.x; asm volatile("" : "+v"(tid_)); const int tid = tid_;
    for (int u = blockIdx.x; u < 256; u += gridDim.x) {
        const int row0 = MP + 32 * (u >> 4), col0 = 64 * (u & 15);
        f32x4 acc[2][4]; SG_ZERO(acc);
        sg_accum<DM>((const bf16*)(ws + WS_MIX), (const bf16*)(ws + WS_WOUT), row0, col0, wave, lane, acc);
        const f32x4 r = sg_reduce(lds, acc, wave, lane, tid);
        const int row = row0 + (tid >> 4); const size_t o = (size_t)row * DM + col0 + 4 * (tid & 15);
        const f32x4 h = r + *(const f32x4*)(a.in[1] + (o - (size_t)MP * DM));
        st_bf4((bf16*)(ws + WS_HB) + o, h);
        const float ss = row16_sum((h[0] * h[0] + h[1] * h[1]) + (h[2] * h[2] + h[3] * h[3]));
        if ((tid & 15) == 0) ((float*)(ws + WS_SS))[(size_t)row * 16 + (u & 15)] = ss;
    }
}
__device__ __forceinline__ void small_down(const Args& a, ldsp lds, int wave, int lane) {
    unsigned char* ws = a.ws; int tid_ = threadIdx.x; asm volatile("" : "+v"(tid_)); const int tid = tid_;
    for (int u = blockIdx.x; u < 256; u += gridDim.x) {
        const int row0 = MP + 32 * (u >> 4), col0 = 64 * (u & 15);
        f32x4 acc[2][4]; SG_ZERO(acc);
        sg_accum<DFF>((const bf16*)(ws + WS_ACT), (const bf16*)(ws + WS_WDN), row0, col0, wave, lane, acc);
        const f32x4 r = sg_reduce(lds, acc, wave, lane, tid);
        const int row = row0 + (tid >> 4); const size_t o = (size_t)row * DM + col0 + 4 * (tid & 15);
        const f32x4 h = r + bf4((const bf16*)(ws + WS_HB) + o);
        *(f32x4*)(a.out + o) = h;
        const float ss = row16_sum((h[0] * h[0] + h[1] * h[1]) + (h[2] * h[2] + h[3] * h[3]));
        if ((tid & 15) == 0) ((float*)(ws + WS_SS2))[(size_t)row * 16 + (u & 15)] = ss;
    }
}

__device__ __forceinline__ void final_norm(const Args& a, int wave, int lane) {
    const int gw = blockIdx.x * NWAVES + wave, NGW = gridDim.x * NWAVES;
    const float* SS2 = (const float*)(a.ws + WS_SS2); const float* g = a.in[20];
    f32x4 gv[4];
#pragma unroll
    for (int j = 0; j < 4; ++j) gv[j] = ((const f32x4*)g)[lane + 64 * j];
    for (int m = gw; m < MT; m += NGW) {
        const float part = (lane < 16) ? SS2[(size_t)m * 16 + lane] : 0.f;
        const float rs = 1.0f / sqrtf(wave_sum(part) * (1.0f / DM) + 1e-6f);
        f32x4* yr = (f32x4*)(a.out + (size_t)m * DM) + lane;
#pragma unroll
        for (int j = 0; j < 4; ++j) { const f32x4 v = yr[64 * j]; yr[64 * j] = v * rs * gv[j]; }
    }
}

constexpr int NPHASE = 8;
__global__ void __launch_bounds__(NTHREADS, 2) fwd_kernel(Args a) {
    extern __shared__ __attribute__((aligned(16))) unsigned char lds_raw[];
    ldsp lds = (ldsp)lds_raw;
    const int tid = threadIdx.x, lane = tid & 63; const int wave = __builtin_amdgcn_readfirstlane(tid >> 6);
    unsigned char* ws = a.ws;
    const int lo = a.ph_lo, hi = a.ph_hi; const int G = gridDim.x, c = blockIdx.x;
#ifdef PHASE_ONLY
#define IN(k) ((k) == PHASE_ONLY && lo <= (k) && (k) < hi)
#else
#define IN(k) (lo <= (k) && (k) < hi)
#endif
    if (tid < 4) ((LAS unsigned*)(lds + LDS_XB))[tid] = 0u;
    __syncthreads();
    XcdBarrier bar; bar.bar = (unsigned*)(ws + WS_CTL + CTL_BAR_BYTE); bar.x = 0; bar.st = nullptr;
    if (hi - lo > 1) bar = xcd_barrier_post((unsigned*)(ws + WS_CTL + CTL_BAR_BYTE), (volatile LAS unsigned*)(lds + LDS_XB));
    if (lo < 0) cg::this_grid().sync();
#define SEAM(k) do { if (IN(k) && IN((k) + 1)) { xcd_barrier(bar); } } while (0)
#ifndef REP0
#define REP0 1
#endif
    if (IN(0)) for (int rep_ = 0; rep_ < REP0; ++rep_) { p0_prologue(a, lds, wave, lane); __syncthreads(); }
    SEAM(0);
#ifndef REP1
#define REP1 1
#endif
    if (IN(1)) for (int rep_ = 0; rep_ < REP1; ++rep_) {
        if (rep_) xcd_barrier(bar);
        cumsum_phase(a, wave, lane);
        pg8::Gemm g{(const bf16*)(ws + WS_XB), (const bf16*)(ws + WS_WIN), MT, NIN, DM}; pg8::StaticOrder S; S.init(MT, NIN, G, c);
        pg8::EpiIn E{(const float*)(ws + WS_RSTD), (bf16*)(ws + WS_CU), (bf16*)(ws + WS_Q), (bf16*)(ws + WS_K), (bf16*)(ws + WS_V), (bf16*)(ws + WS_GC), (bf16*)(ws + WS_GA), a.out};
        pg8::gemm_phase<pg8::EpiIn, pg8::StaticOrder, true, true>(lds, g, S, E);
    }
    SEAM(1);
    if (IN(2)) queue_phase(a, lds);
#ifdef PROBE_Q2
    xcd_barrier(bar); if (blockIdx.x == 0 && threadIdx.x == 0) __hip_atomic_store((unsigned*)(ws + WS_CTL), 0u, __ATOMIC_RELAXED, __HIP_MEMORY_SCOPE_AGENT); xcd_barrier(bar);
    if (IN(2)) queue_phase(a, lds);
#endif
    SEAM(2);
#ifndef REP3
#define REP3 1
#endif
    if (IN(3)) for (int rep_ = 0; rep_ < REP3; ++rep_) {
        if (rep_) xcd_barrier(bar);
        { pg8::Gemm g{(const bf16*)(ws + WS_CS), (const bf16*)(ws + WS_WPW), MP, DM, DC}; pg8::StaticOrder S; S.init(MP, DM, G, c);
          pg8::EpiMix<false> E{(const bf16*)(ws + WS_GC), (bf16*)(ws + WS_MIX)};
          pg8::gemm_phase<pg8::EpiMix<false>, pg8::StaticOrder, true, true>(lds, g, S, E); }
        asm volatile("s_waitcnt vmcnt(0)" ::: "memory"); __syncthreads();
        { pg8::Gemm g{(const bf16*)(ws + WS_AO), (const bf16*)(ws + WS_WAO), MP, DM, DA}; pg8::StaticOrder S; S.init(MP, DM, G, c);
          pg8::EpiMix<true> E{(const bf16*)(ws + WS_GA), (bf16*)(ws + WS_MIX)};
          pg8::gemm_phase<pg8::EpiMix<true>, pg8::StaticOrder, true, true>(lds, g, S, E); }
        small_mix(a, lds, wave, lane);
    }
    SEAM(3);
#ifndef REP4
#define REP4 1
#endif
    if (IN(4)) for (int rep_ = 0; rep_ < REP4; ++rep_) {
        if (rep_) xcd_barrier(bar);
        pg8::Gemm g{(const bf16*)(ws + WS_MIX), (const bf16*)(ws + WS_WOUT), MP, DM, DM}; pg8::StaticOrder S; S.init(MP, DM, G, c);
        pg8::EpiOut E{a.in[0], a.in[1], (bf16*)(ws + WS_HB), (float*)(ws + WS_SS)};
        pg8::gemm_phase<pg8::EpiOut, pg8::StaticOrder, true, true>(lds, g, S, E);
        small_out(a, lds, wave, lane);
    }
    SEAM(4);
#ifndef REP5
#define REP5 1
#endif
    if (IN(5)) for (int rep_ = 0; rep_ < REP5; ++rep_) {
        if (rep_) xcd_barrier(bar);
        pg8::Gemm g{(const bf16*)(ws + WS_HB), (const bf16*)(ws + WS_WGU), MT, NGU, DM}; pg8::StaticOrder S; S.init(MT, NGU, G, c);
        pg8::EpiGU E{(const float*)(ws + WS_SS), (bf16*)(ws + WS_ACT)};
        pg8::gemm_phase<pg8::EpiGU, pg8::StaticOrder, true, true>(lds, g, S, E);
    }
    SEAM(5);
#ifndef REP6
#define REP6 1
#endif
    if (IN(6)) for (int rep_ = 0; rep_ < REP6; ++rep_) {
        if (rep_) xcd_barrier(bar);
        pg8::Gemm g{(const bf16*)(ws + WS_ACT), (const bf16*)(ws + WS_WDN), MP, DM, DFF}; pg8::StaticOrder S; S.init(MP, DM, G, c);
        pg8::EpiDown E{(const bf16*)(ws + WS_HB), a.out, (float*)(ws + WS_SS2)};
        pg8::gemm_phase<pg8::EpiDown, pg8::StaticOrder, true, true>(lds, g, S, E);
        small_down(a, lds, wave, lane);
    }
    SEAM(6);
    if (IN(7)) final_norm(a, wave, lane);
#ifdef PROBE_SYNCS
    for (int i_ = 0; i_ < PROBE_SYNCS; ++i_) xcd_barrier(bar);
#endif
#undef IN
#undef SEAM
}

#ifndef N_LAUNCHES
#define N_LAUNCHES 1
#endif
extern "C" void kernel_launch(void* const* d_in, const int* in_sizes, int n_in, void* d_out, int out_size, void* d_ws, size_t ws_size, hipStream_t stream) {
    static int grid = 0;
    if (grid == 0) {
        if (n_in != 21 || (size_t)out_size != OUT_TOTAL || ws_size < WS_END) { fprintf(stderr, "kernel_launch: unexpected shapes (n_in %d out %d ws %zu)\n", n_in, out_size, ws_size); grid = -1; return; }
        int dev = 0, cus = 0, per_cu = 0;
        hipGetDevice(&dev); hipDeviceGetAttribute(&cus, hipDeviceAttributeMultiprocessorCount, dev);
        hipFuncSetAttribute((const void*)fwd_kernel, hipFuncAttributeMaxDynamicSharedMemorySize, LDS_BYTES);
        hipOccupancyMaxActiveBlocksPerMultiprocessor(&per_cu, (const void*)fwd_kernel, NTHREADS, LDS_BYTES);
        (void)hipGetLastError();
        if (per_cu < 1) fprintf(stderr, "kernel_launch: occupancy query says %d blocks per CU\n", per_cu);
        grid = cus > 0 ? cus : 256;
    }
    if (grid < 0) return;
    if (hipMemsetAsync((char*)d_ws + WS_CTL, 0, CTL_ZERO_BYTES, stream) != hipSuccess) { fprintf(stderr, "kernel_launch: memset failed\n"); return; }
    Args a{};
    for (int i = 0; i < 21; ++i) a.in[i] = (const float*)d_in[i];
    a.out = (float*)d_out; a.ws = (unsigned char*)d_ws;
#if N_LAUNCHES == 1
    a.ph_lo = 0; a.ph_hi = NPHASE;
    void* args[] = {&a};
    hipError_t e = hipLaunchCooperativeKernel((const void*)fwd_kernel, dim3(grid), dim3(NTHREADS), args, LDS_BYTES, stream);
    if (e != hipSuccess) fprintf(stderr, "cooperative launch failed: %s (grid %d)\n", hipGetErrorString(e), grid);
#else
    for (int p = 0; p < NPHASE; ++p) { a.ph_lo = p; a.ph_hi = p + 1; hipLaunchKernelGGL(fwd_kernel, dim3(grid), dim3(NTHREADS), LDS_BYTES, stream, a); }
#endif
}
```

```cpp
#include <hip/hip_runtime.h>
#include <hip/hip_cooperative_groups.h>
#include <cstdio>
#include <cstdint>
#include <cmath>
namespace cg = cooperative_groups;
constexpr int DM = 1024, MP = 16384, MS = 512, MT = MP + MS, SEQ = 4096, NH = 8, HD = 64, DA = 512, DC = 512, CW = 31, DFF = 2816, DIN = 4616, PAST = 4096, DB = 16, DS = 32;
constexpr int NIN = 4608, NGU = 2 * DFF;
constexpr size_t OFF_Y = 0, OFF_KP = (size_t)MT * DM, OFF_VP = OFF_KP + (size_t)MP * DA, OFF_LFP = OFF_VP + (size_t)MP * DA, OFF_CVP = OFF_LFP + (size_t)MP * NH,
                 OFF_KS = OFF_CVP + (size_t)4 * 30 * DC, OFF_VS = OFF_KS + (size_t)MS * DA, OFF_LFS = OFF_VS + (size_t)MS * DA, OFF_CVS = OFF_LFS + (size_t)MS * NH, OUT_TOTAL = OFF_CVS + (size_t)DB * 30 * DC;
static_assert(OUT_TOTAL == 35045376, "output size");
constexpr float LOG2E = 1.4426950408889634f;
constexpr float QSCALE = 0.125f * LOG2E;
#define N_LAUNCHES 1
namespace pg8 {
#define PG8_LAS __attribute__((address_space(3)))
typedef unsigned short bf16_t;
typedef short bf16x8 __attribute__((ext_vector_type(8)));
typedef float f32x4 __attribute__((ext_vector_type(4)));
typedef unsigned u32x4 __attribute__((ext_vector_type(4)));
constexpr int BM = 256, BK = 64, HALF = 128, HTB = HALF * BK * 2  , STAGE_BYTES = 8 * HTB, NXCD = 8, WGM = 8;

__host__ __device__ __forceinline__ int lds_byte(int r, int c) { const int st = (r >> 4) * 2 + (c >> 5), rr = r & 15, cc = c & 31, ob = rr * 64 + cc * 2; return st * 1024 + (ob ^ (((ob >> 9) & 1) << 5)); }
__host__ __device__ __forceinline__ void stage_rc(int b, int& R, int& C) { const int st = b / 1024, sb = b % 1024, swz = sb ^ (((sb >> 9) & 1) << 5); R = (st >> 1) * 16 + swz / 64; C = (st & 1) * 32 + (swz % 64) / 2; }
__host__ __device__ __forceinline__ int perm32(int rho) { const int n = rho >> 4, i = rho & 15; return 8 * (i >> 2) + 4 * n + (i & 3); }

struct Unit { int pm, pn; };
struct Gemm { const bf16_t* A; const bf16_t* Bt; int M, N, K; };

struct StaticOrder {
    int nM, nN, nwg, G, c;
    __host__ __device__ void init(int M, int N, int G_, int c_) { nM = M / BM; nN = N / BM; nwg = nM * nN; G = G_; c = c_; }
    __host__ __device__ bool next(int i, Unit& u) const {
        const long L = (long)i * G + c; if (L >= nwg) return false;
        int wgid = (int)L; { const int q = nwg / NXCD, r = nwg % NXCD, xcd = wgid % NXCD, off = wgid / NXCD; wgid = (xcd < r ? xcd * (q + 1) : r * (q + 1) + (xcd - r) * q) + off; }
        const int nig = WGM * nN, gid = wgid / nig, fm = gid * WGM, gsz = (nM - fm) < WGM ? (nM - fm) : WGM;
        u.pm = fm + ((wgid % nig) % gsz); u.pn = (wgid % nig) / gsz; return true;
    }
    __device__ __forceinline__ void a_ready(const Unit&) const {}
    __device__ __forceinline__ void done(const Unit&) const {}
};

__device__ __forceinline__ unsigned cvt_pk_bf16(float lo, float hi) { unsigned r; asm volatile("v_cvt_pk_bf16_f32 %0, %1, %2" : "=v"(r) : "v"(lo), "v"(hi)); return r; }
typedef float f32x2 __attribute__((ext_vector_type(2)));
template <class Epi, class Sched, bool ALIGN_EPI = false, bool SP2 = false>
__device__ __forceinline__ void gemm_phase(PG8_LAS unsigned char* lds, const Gemm g, const Sched& S, const Epi& E) {
    const int tid = threadIdx.x, wid = __builtin_amdgcn_readfirstlane(tid >> 6), lane = tid & 63, wr = wid >> 2, wc = wid & 3, fr = lane & 15, fq = lane >> 4;
    const int K = g.K, nt = K / BK;
    unsigned voffA[2], voffB[2];
#pragma unroll
    for (int i = 0; i < 2; ++i) { int R, C; stage_rc(tid * 16 + i * 8192, R, C); const int Rb = Epi::PERM ? ((R & ~31) + perm32(R & 31)) : R;
        voffA[i] = (unsigned)(R * K + C) * 2u; voffB[i] = (unsigned)(Rb * K + C) * 2u; }
    const size_t kstep = (size_t)(BK * 2);
    const size_t hstep = (size_t)HALF * K * 2;
    const size_t tstep = 2 * hstep;
    const unsigned ldsw = (unsigned)wid * 1024u;
    const int aoff = lds_byte(wr * 64 + fr, fq * 8), boff = lds_byte(wc * 32 + fr, fq * 8);
#define PG8_SA(b, h) (((b) * 2 + (h)) * HTB)
#define PG8_SB(b, h) ((4 + (b) * 2 + (h)) * HTB)
#define PG8_STAGE(bufoff, gbase, voff) do { _Pragma("unroll") for (int _i = 0; _i < 2; ++_i) \
        __builtin_amdgcn_global_load_lds((const unsigned*)((const char*)(gbase) + (voff)[_i]), (PG8_LAS unsigned*)(lds + (bufoff) + ldsw + _i * 8192), 16, 0, 0); } while (0)
#define PG8_LDA(dst, b, h) do { _Pragma("unroll") for (int m = 0; m < 4; ++m) _Pragma("unroll") for (int k = 0; k < 2; ++k) dst[m][k] = *(const PG8_LAS bf16x8*)(lds + PG8_SA(b, h) + aoff + m * 2048 + k * 1024); } while (0)
#define PG8_LDB(dst, b, h) do { _Pragma("unroll") for (int n = 0; n < 2; ++n) _Pragma("unroll") for (int k = 0; k < 2; ++k) dst[n][k] = *(const PG8_LAS bf16x8*)(lds + PG8_SB(b, h) + boff + n * 2048 + k * 1024); } while (0)
#define PG8_MMA(ai, bj, At, Bt) do { __builtin_amdgcn_s_setprio(1); _Pragma("unroll") for (int m = 0; m < 4; ++m) _Pragma("unroll") for (int n = 0; n < 2; ++n) _Pragma("unroll") for (int k = 0; k < 2; ++k) \
        acc[ai][bj][m][n] = __builtin_amdgcn_mfma_f32_16x16x32_bf16(Bt[n][k], At[m][k], acc[ai][bj][m][n], 0, 0, 0); __builtin_amdgcn_s_setprio(0); } while (0)
#define PG8_WAIT_V(n) asm volatile("s_waitcnt vmcnt(" #n ")" ::: "memory")
#define PG8_WAIT_L(n) asm volatile("s_waitcnt lgkmcnt(" #n ")" ::: "memory")
#define PG8_BAR __builtin_amdgcn_s_barrier()
#define PG8_SCHED __builtin_amdgcn_sched_barrier(0)
    Unit cur, nxt; int ui = 0;
    if (!S.next(0, cur)) return;
    f32x4 acc[2][2][4][2];
#pragma unroll
    for (int a = 0; a < 2; ++a)
#pragma unroll
        for (int b = 0; b < 2; ++b)
#pragma unroll
            for (int m = 0; m < 4; ++m)
#pragma unroll
                for (int n = 0; n < 2; ++n) acc[a][b][m][n] = (f32x4){0.f, 0.f, 0.f, 0.f};
    bf16x8 At[4][2], B0[2][2], B1[2][2];
    const char* cA = (const char*)g.A + (size_t)cur.pm * tstep; const char* cB = (const char*)g.Bt + (size_t)cur.pn * tstep;
    S.a_ready(cur);
    if constexpr (SP2) {
        PG8_STAGE(PG8_SB(0, 0), cB, voffB); PG8_STAGE(PG8_SB(0, 1), cB + hstep, voffB); PG8_STAGE(PG8_SA(0, 0), cA, voffA); PG8_STAGE(PG8_SA(0, 1), cA + hstep, voffA);
        if (wr == 1) PG8_BAR;
        PG8_WAIT_V(2); PG8_BAR;
        PG8_STAGE(PG8_SB(1, 0), cB + kstep, voffB); PG8_STAGE(PG8_SA(1, 0), cA + kstep, voffA); PG8_STAGE(PG8_SB(1, 1), cB + hstep + kstep, voffB);
        PG8_WAIT_V(6); PG8_BAR;
    } else {
        PG8_STAGE(PG8_SB(0, 0), cB, voffB); PG8_STAGE(PG8_SA(0, 0), cA, voffA); PG8_STAGE(PG8_SB(0, 1), cB + hstep, voffB); PG8_STAGE(PG8_SA(0, 1), cA + hstep, voffA);
        if (wr == 1) PG8_BAR;
        PG8_WAIT_V(4); PG8_BAR;
        PG8_STAGE(PG8_SB(1, 0), cB + kstep, voffB); PG8_STAGE(PG8_SA(1, 0), cA + kstep, voffA); PG8_STAGE(PG8_SB(1, 1), cB + hstep + kstep, voffB);
        PG8_WAIT_V(6); PG8_BAR;
    }
    for (;;) {
        const bool has_next = S.next(ui + 1, nxt);
        const char* nA = has_next ? (const char*)g.A + (size_t)nxt.pm * tstep : cA; const char* nB = has_next ? (const char*)g.Bt + (size_t)nxt.pn * tstep : cB;
        for (int t = 0; t < nt; t += 2) {
            const bool last = (t == nt - 2);
            const char* a1 = cA + (size_t)(t + 1) * kstep;
            const char* a2 = last ? nA : cA + (size_t)(t + 2) * kstep; const char* b2 = last ? nB : cB + (size_t)(t + 2) * kstep;
            const char* a3 = a2 + kstep; const char* b3 = b2 + kstep;
            if (last && has_next) S.a_ready(nxt);
            if constexpr (SP2) {
            PG8_LDB(B0, 0, 0); PG8_LDB(B1, 0, 1); PG8_SCHED; PG8_LDA(At, 0, 0); PG8_STAGE(PG8_SA(1, 1), a1 + hstep, voffA);
            PG8_WAIT_V(8); PG8_WAIT_L(0); PG8_BAR; PG8_MMA(0, 0, At, B0); PG8_MMA(0, 1, At, B1); PG8_BAR; PG8_SCHED;
            PG8_LDA(At, 0, 1); PG8_STAGE(PG8_SB(0, 0), b2, voffB); PG8_STAGE(PG8_SB(0, 1), b2 + hstep, voffB); PG8_STAGE(PG8_SA(0, 0), a2, voffA);
            PG8_WAIT_V(8); PG8_WAIT_L(0); PG8_BAR; PG8_MMA(1, 0, At, B0); PG8_MMA(1, 1, At, B1); PG8_BAR; PG8_SCHED;
            PG8_LDB(B0, 1, 0); PG8_LDB(B1, 1, 1); PG8_SCHED; PG8_LDA(At, 1, 0); PG8_STAGE(PG8_SA(0, 1), a2 + hstep, voffA);
            PG8_WAIT_V(8); PG8_WAIT_L(0); PG8_BAR; PG8_MMA(0, 0, At, B0); PG8_MMA(0, 1, At, B1); PG8_BAR; PG8_SCHED;
            PG8_LDA(At, 1, 1); PG8_STAGE(PG8_SB(1, 0), b3, voffB); PG8_STAGE(PG8_SB(1, 1), b3 + hstep, voffB); PG8_STAGE(PG8_SA(1, 0), a3, voffA);
            PG8_WAIT_V(8); PG8_WAIT_L(0); PG8_BAR; PG8_MMA(1, 0, At, B0); PG8_MMA(1, 1, At, B1); PG8_BAR; PG8_SCHED;
            } else {
            PG8_LDB(B0, 0, 0); PG8_SCHED; PG8_LDA(At, 0, 0); PG8_STAGE(PG8_SA(1, 1), a1 + hstep, voffA);
            PG8_WAIT_L(8); PG8_BAR; PG8_WAIT_L(0); PG8_MMA(0, 0, At, B0); PG8_BAR; PG8_SCHED;
            PG8_LDB(B1, 0, 1); PG8_STAGE(PG8_SB(0, 0), b2, voffB);
            PG8_BAR; PG8_WAIT_L(0); PG8_MMA(0, 1, At, B1); PG8_BAR;
            PG8_LDA(At, 0, 1); PG8_STAGE(PG8_SA(0, 0), a2, voffA);
            PG8_BAR; PG8_WAIT_L(0); PG8_MMA(1, 0, At, B0); PG8_BAR; PG8_SCHED;
            PG8_STAGE(PG8_SB(0, 1), b2 + hstep, voffB);
            PG8_WAIT_V(6); PG8_BAR; PG8_MMA(1, 1, At, B1); PG8_BAR;
            PG8_LDB(B0, 1, 0); PG8_SCHED; PG8_LDA(At, 1, 0); PG8_STAGE(PG8_SA(0, 1), a2 + hstep, voffA);
            PG8_WAIT_L(8); PG8_BAR; PG8_WAIT_L(0); PG8_MMA(0, 0, At, B0); PG8_BAR; PG8_SCHED;
            PG8_LDB(B1, 1, 1); PG8_STAGE(PG8_SB(1, 0), b3, voffB);
            PG8_BAR; PG8_WAIT_L(0); PG8_MMA(0, 1, At, B1); PG8_BAR;
            PG8_LDA(At, 1, 1); PG8_STAGE(PG8_SA(1, 0), a3, voffA);
            PG8_BAR; PG8_WAIT_L(0); PG8_MMA(1, 0, At, B0); PG8_BAR; PG8_SCHED;
            PG8_STAGE(PG8_SB(1, 1), b3 + hstep, voffB);
            PG8_WAIT_V(6); PG8_BAR; PG8_MMA(1, 1, At, B1); PG8_BAR;
            }
        }
        if constexpr (ALIGN_EPI) { if (wr == 0) PG8_BAR; }
        if constexpr (!Epi::AFTER_DRAIN) { E(acc, cur, wr, wc, fr, fq); S.done(cur); }
        if (!has_next) break;
#pragma unroll
        for (int a = 0; a < 2; ++a)
#pragma unroll
            for (int b = 0; b < 2; ++b)
#pragma unroll
                for (int m = 0; m < 4; ++m)
#pragma unroll
                    for (int n = 0; n < 2; ++n) acc[a][b][m][n] = (f32x4){0.f, 0.f, 0.f, 0.f};
        cur = nxt; cA = nA; cB = nB; ++ui;
        if constexpr (ALIGN_EPI) { if (wr == 1) PG8_BAR; }
    }
    PG8_WAIT_V(0);
    if constexpr (!ALIGN_EPI) { if (wr == 0) PG8_BAR; }
    PG8_BAR;
    if constexpr (Epi::AFTER_DRAIN) { E.fused(acc, cur, wr, wc, fr, fq, lds, wid, lane); S.done(cur); }
#undef PG8_SA
#undef PG8_SB
#undef PG8_STAGE
#undef PG8_LDA
#undef PG8_LDB
#undef PG8_MMA
#undef PG8_WAIT_V
#undef PG8_WAIT_L
#undef PG8_BAR
#undef PG8_SCHED
}
__device__ __forceinline__ float bf2f(unsigned short b) { return __uint_as_float((unsigned)b << 16); }
__device__ __forceinline__ float sigm(float x) { return __builtin_amdgcn_rcpf(1.0f + __expf(-x)); }
__device__ __forceinline__ u32x4 pack8(const f32x4 a, const f32x4 b) { u32x4 w; w.x = cvt_pk_bf16(a[0], a[1]); w.y = cvt_pk_bf16(a[2], a[3]); w.z = cvt_pk_bf16(b[0], b[1]); w.w = cvt_pk_bf16(b[2], b[3]); return w; }
__device__ __forceinline__ void unpack8(const u32x4 w, f32x4& a, f32x4& b) {
    a[0] = __uint_as_float(w.x << 16); a[1] = __uint_as_float(w.x & 0xffff0000u); a[2] = __uint_as_float(w.y << 16); a[3] = __uint_as_float(w.y & 0xffff0000u);
    b[0] = __uint_as_float(w.z << 16); b[1] = __uint_as_float(w.z & 0xffff0000u); b[2] = __uint_as_float(w.w << 16); b[3] = __uint_as_float(w.w & 0xffff0000u); }
__device__ __forceinline__ f32x4 sigm4(f32x4 v) { f32x4 r; r[0] = sigm(v[0]); r[1] = sigm(v[1]); r[2] = sigm(v[2]); r[3] = sigm(v[3]); return r; }

struct EpiIn {
    static constexpr bool PERM = true, AFTER_DRAIN = false;
    const float* rstd; bf16_t *CU, *Q, *K, *V, *GC, *GA; float* out;
    __device__ __forceinline__ void operator()(const f32x4 (&acc)[2][2][4][2], const Unit& u, int wr, int wc, int fr, int fq) const {
        const int pn = u.pn, row0 = u.pm * BM + wr * 64 + fr, cl = wc * 32 + 8 * fq;
#pragma unroll
        for (int ai = 0; ai < 2; ++ai)
#pragma unroll
            for (int m = 0; m < 4; ++m) {
                const int row = row0 + ai * HALF + m * 16; const float rs = rstd[row];
                if (pn < 4) {
                    const f32x4 a0 = acc[ai][0][m][0] * rs, a1 = acc[ai][0][m][1] * rs, g0 = acc[ai][1][m][0] * rs, g1 = acc[ai][1][m][1] * rs;
                    const f32x4 c0 = a0 * sigm4(g0), c1 = a1 * sigm4(g1); const int ch = 128 * pn + cl;
                    *(u32x4*)(CU + (size_t)row * DC + ch) = pack8(c0, c1);
                    float* hd = nullptr;
                    if (row < MP) { const int t = row & (SEQ - 1); if (t >= SEQ - 30) hd = out + OFF_CVP + ((size_t)(row >> 12) * 30 + (t - (SEQ - 30))) * DC + ch; }
                    else { const int sr = row - MP, t = sr & 31; if (t >= 2) hd = out + OFF_CVS + ((size_t)(sr >> 5) * 30 + (t - 2)) * DC + ch; }
                    if (hd) { *(f32x4*)hd = c0; *(f32x4*)(hd + 4) = c1; }
                } else if (pn < 10) {
                    const int which = (pn - 4) >> 1;
#pragma unroll
                    for (int bj = 0; bj < 2; ++bj) {
                        const int col = ((pn - 4) & 1) * 256 + bj * HALF + cl; const f32x4 v0 = acc[ai][bj][m][0] * rs, v1 = acc[ai][bj][m][1] * rs;
                        if (which == 0) { *(u32x4*)(Q + (size_t)row * DA + col) = pack8(v0 * QSCALE, v1 * QSCALE); }
                        else { bf16_t* B = which == 1 ? K : V; *(u32x4*)(B + (size_t)row * DA + col) = pack8(v0, v1);
                            float* d = (row < MP) ? out + (which == 1 ? OFF_KP : OFF_VP) + (size_t)row * DA + col : out + (which == 1 ? OFF_KS : OFF_VS) + (size_t)(row - MP) * DA + col;
                            *(f32x4*)d = v0; *(f32x4*)(d + 4) = v1; }
                    }
                } else {
                    bf16_t* B = pn < 14 ? GC : GA;
#pragma unroll
                    for (int bj = 0; bj < 2; ++bj) {
                        const int col = ((pn - 10) & 3) * 256 + bj * HALF + cl; const f32x4 v0 = acc[ai][bj][m][0] * rs, v1 = acc[ai][bj][m][1] * rs;
                        *(u32x4*)(B + (size_t)row * DM + col) = pack8(sigm4(v0), sigm4(v1)); }
                }
            }
    }
};
template <bool ADD> struct EpiMix {
    static constexpr bool PERM = true, AFTER_DRAIN = false;
    const bf16_t* G; bf16_t* MIX;
    __device__ __forceinline__ void operator()(const f32x4 (&acc)[2][2][4][2], const Unit& u, int wr, int wc, int fr, int fq) const {
        const int row0 = u.pm * BM + wr * 64 + fr, col0 = u.pn * BM + wc * 32 + 8 * fq;
#pragma unroll
        for (int ai = 0; ai < 2; ++ai)
#pragma unroll
            for (int m = 0; m < 4; ++m) {
                const size_t ro = (size_t)(row0 + ai * HALF + m * 16) * DM + col0;
#pragma unroll
                for (int bj = 0; bj < 2; ++bj) {
                    f32x4 g0, g1; unpack8(*(const u32x4*)(G + ro + bj * HALF), g0, g1);
                    f32x4 v0 = acc[ai][bj][m][0] * g0, v1 = acc[ai][bj][m][1] * g1;
                    if (ADD) { f32x4 o0, o1; unpack8(*(const u32x4*)(MIX + ro + bj * HALF), o0, o1); v0 += o0; v1 += o1; }
                    *(u32x4*)(MIX + ro + bj * HALF) = pack8(v0, v1); }
            }
    }
};
struct EpiOut {
    static constexpr bool PERM = true, AFTER_DRAIN = false;
    const float *xp, *xs; bf16_t* HB; float* SS;
    __device__ __forceinline__ void operator()(const f32x4 (&acc)[2][2][4][2], const Unit& u, int wr, int wc, int fr, int fq) const {
        const int row0 = u.pm * BM + wr * 64 + fr, col0 = u.pn * BM + wc * 32 + 8 * fq;
#pragma unroll
        for (int ai = 0; ai < 2; ++ai)
#pragma unroll
            for (int m = 0; m < 4; ++m) {
                const int row = row0 + ai * HALF + m * 16; const size_t ro = (size_t)row * DM + col0;
                const float* xr = (row < MP) ? xp + ro : xs + (ro - (size_t)MP * DM);
                float ss = 0.f;
#pragma unroll
                for (int bj = 0; bj < 2; ++bj) {
                    const f32x4 h0 = acc[ai][bj][m][0] + *(const f32x4*)(xr + bj * HALF), h1 = acc[ai][bj][m][1] + *(const f32x4*)(xr + bj * HALF + 4);
                    *(u32x4*)(HB + ro + bj * HALF) = pack8(h0, h1);
                    ss += (h0[0] * h0[0] + h0[1] * h0[1]) + (h0[2] * h0[2] + h0[3] * h0[3]) + (h1[0] * h1[0] + h1[1] * h1[1]) + (h1[2] * h1[2] + h1[3] * h1[3]); }
                ss += __shfl_xor(ss, 16); ss += __shfl_xor(ss, 32);
                if (fq == 0) SS[(size_t)row * 16 + u.pn * 4 + wc] = ss;
            }
    }
};
struct EpiGU {
    static constexpr bool PERM = true, AFTER_DRAIN = false;
    const float* SS; bf16_t* ACT;
    __device__ __forceinline__ void operator()(const f32x4 (&acc)[2][2][4][2], const Unit& u, int wr, int wc, int fr, int fq) const {
        const int row0 = u.pm * BM + wr * 64 + fr, ch = u.pn * HALF + wc * 32 + 8 * fq;
#pragma unroll
        for (int ai = 0; ai < 2; ++ai)
#pragma unroll
            for (int m = 0; m < 4; ++m) {
                const int row = row0 + ai * HALF + m * 16; const f32x4* sp = (const f32x4*)(SS + (size_t)row * 16);
                const f32x4 s0 = sp[0], s1 = sp[1], s2 = sp[2], s3 = sp[3];
                const float tot = ((s0[0] + s0[1]) + (s0[2] + s0[3])) + ((s1[0] + s1[1]) + (s1[2] + s1[3])) + ((s2[0] + s2[1]) + (s2[2] + s2[3])) + ((s3[0] + s3[1]) + (s3[2] + s3[3]));
                const float rs = 1.0f / sqrtf(tot * (1.0f / DM) + 1e-6f);
                const f32x4 g0 = acc[ai][0][m][0] * rs, g1 = acc[ai][0][m][1] * rs, u0 = acc[ai][1][m][0] * rs, u1 = acc[ai][1][m][1] * rs;
                *(u32x4*)(ACT + (size_t)row * DFF + ch) = pack8(g0 * sigm4(g0) * u0, g1 * sigm4(g1) * u1);
            }
    }
};
struct EpiDown {
    static constexpr bool PERM = true, AFTER_DRAIN = false;
    const bf16_t* HB; float* Y; float* SS;
    __device__ __forceinline__ void operator()(const f32x4 (&acc)[2][2][4][2], const Unit& u, int wr, int wc, int fr, int fq) const {
        const int row0 = u.pm * BM + wr * 64 + fr, col0 = u.pn * BM + wc * 32 + 8 * fq;
#pragma unroll
        for (int ai = 0; ai < 2; ++ai)
#pragma unroll
            for (int m = 0; m < 4; ++m) {
                const int row = row0 + ai * HALF + m * 16; const size_t ro = (size_t)row * DM + col0;
                float ss = 0.f;
#pragma unroll
                for (int bj = 0; bj < 2; ++bj) {
                    f32x4 r0, r1; unpack8(*(const u32x4*)(HB + ro + bj * HALF), r0, r1);
                    const f32x4 h0 = acc[ai][bj][m][0] + r0, h1 = acc[ai][bj][m][1] + r1;
                    *(f32x4*)(Y + ro + bj * HALF) = h0; *(f32x4*)(Y + ro + bj * HALF + 4) = h1;
                    ss += (h0[0] * h0[0] + h0[1] * h0[1]) + (h0[2] * h0[2] + h0[3] * h0[3]) + (h1[0] * h1[0] + h1[1] * h1[1]) + (h1[2] * h1[2] + h1[3] * h1[3]); }
                ss += __shfl_xor(ss, 16); ss += __shfl_xor(ss, 32);
                if (fq == 0) SS[(size_t)row * 16 + u.pn * 4 + wc] = ss;
            }
    }
};
}
#define LAS __attribute__((address_space(3)))
typedef unsigned short bf16;
typedef LAS unsigned char* ldsp;
typedef __attribute__((ext_vector_type(8))) short bf16x8;
typedef __attribute__((ext_vector_type(4))) short s16x4;
typedef __attribute__((ext_vector_type(16))) float f32x16;
typedef __attribute__((ext_vector_type(4))) float f32x4;
typedef __attribute__((ext_vector_type(4))) unsigned u32x4;
typedef __attribute__((ext_vector_type(2))) unsigned u32x2;
constexpr int NWAVES = 8, NTHREADS = 512;
constexpr int LDS_BYTES = 147456;
constexpr int LDS_QW = 147200;
constexpr int LDS_XB = 147216;
constexpr size_t CTL_BAR_BYTE = 16384, CTL_ZERO_BYTES = 65536;

__device__ __forceinline__ float wave_sum(float v) {
#pragma unroll
    for (int o = 1; o < 64; o <<= 1) v += __shfl_xor(v, o);
    return v;
}
__device__ __forceinline__ float bf2f(unsigned short b) { return __uint_as_float((unsigned)b << 16); }
__device__ __forceinline__ unsigned cvtpk(float lo, float hi) { return pg8::cvt_pk_bf16(lo, hi); }
#define BLOCK_BAR() asm volatile("s_waitcnt vmcnt(0) lgkmcnt(0)\n\ts_barrier" ::: "memory")
#define XB_TMO      128
#define XB_XCNT(j)  (256  + 64 * (j))
#define XB_XSUB(j)  (1280 + 64 * (j))
#define XB_XGEN(j)  (2304 + 64 * (j))
#define XB_TOP      3328
#define XB_TOPGEN   3392
#define XCD_BAR_WORDS 3456
#define XB_SPIN_CAP (1u << 18)

__device__ __forceinline__ unsigned xb_ld(unsigned* p)              { return __hip_atomic_load(p, __ATOMIC_RELAXED, __HIP_MEMORY_SCOPE_AGENT); }
__device__ __forceinline__ unsigned xb_add(unsigned* p, unsigned v) { return __hip_atomic_fetch_add(p, v, __ATOMIC_RELAXED, __HIP_MEMORY_SCOPE_AGENT); }
__device__ __forceinline__ unsigned xb_xcc_id() { return (unsigned)__builtin_amdgcn_s_getreg((3 << 11) | 20) & 0xFu; }
#define XB_SPIN(cond, bar) do { unsigned _sp = 0; while (cond) { __builtin_amdgcn_s_sleep(1); \
    if ((++_sp & 255u) == 0u) { if (xb_ld(&(bar)[XB_TMO])) break; if (_sp > XB_SPIN_CAP) { atomicAdd(&(bar)[XB_TMO], 1u); break; } } } } while (0)

struct XcdBarrier {
    unsigned* bar; unsigned x;
    volatile LAS unsigned* st;
};

__device__ __forceinline__ XcdBarrier xcd_barrier_post(unsigned* bar, volatile LAS unsigned* st) {
    XcdBarrier b; b.bar = bar; b.x = xb_xcc_id(); b.st = st;
    if (threadIdx.x == 0) (void)xb_add(&bar[XB_XCNT(b.x)], 1u);
    return b;
}
__device__ __forceinline__ void xcd_barrier_complete(unsigned* bar, unsigned x, unsigned& nloc, unsigned& nx) {
    const unsigned G = gridDim.x * gridDim.y * gridDim.z;
    unsigned sum, cnt, mine, sp = 0u;
    for (;;) {
        sum = 0u; cnt = 0u; mine = 0u;
#pragma unroll
        for (unsigned j = 0; j < 16; ++j) { const unsigned c = xb_ld(&bar[XB_XCNT(j)]); sum += c; cnt += (c > 0u) ? 1u : 0u; mine = (j == x) ? c : mine; }
        if (sum == G) break;
        __builtin_amdgcn_s_sleep(1);
        if ((++sp & 255u) == 0u) { if (xb_ld(&bar[XB_TMO])) break; if (sp > XB_SPIN_CAP) { atomicAdd(&bar[XB_TMO], 1u); break; } }
    }
    nloc = mine > 0u ? mine : 1u; nx = cnt > 0u ? cnt : 1u;
}

__device__ __forceinline__ void xcd_barrier(const XcdBarrier& b) {
    asm volatile("s_waitcnt vmcnt(0)" ::: "memory");
    __syncthreads();
    if (threadIdx.x == 0) {
        unsigned* bar = b.bar;
        __builtin_amdgcn_s_waitcnt(0);
        unsigned nloc = b.st[0], nx = b.st[1];
        if (nloc == 0u) { xcd_barrier_complete(bar, b.x, nloc, nx); b.st[0] = nloc; b.st[1] = nx; }
        const unsigned old = xb_add(&bar[XB_XSUB(b.x)], 1u);
        const unsigned gen = old / nloc;
        if (old + 1u == (gen + 1u) * nloc) {
            __builtin_amdgcn_fence(__ATOMIC_RELEASE, "agent");
            asm volatile("s_waitcnt vmcnt(0)" ::: "memory");
            const unsigned og = xb_add(&bar[XB_TOP], 1u);
            const unsigned tg = og / nx;
            if (og + 1u == (tg + 1u) * nx) xb_add(&bar[XB_TOPGEN], 1u);
            else XB_SPIN(xb_ld(&bar[XB_TOPGEN]) == tg, bar);
            __builtin_amdgcn_fence(__ATOMIC_ACQUIRE, "agent");
            xb_add(&bar[XB_XGEN(b.x)], 1u);
            asm volatile("s_waitcnt vmcnt(0)" ::: "memory");
        } else {
            XB_SPIN(xb_ld(&bar[XB_XGEN(b.x)]) == gen, bar);
            __builtin_amdgcn_fence(__ATOMIC_ACQUIRE, "agent");
            asm volatile("s_waitcnt vmcnt(0)" ::: "memory");
        }
    }
    __syncthreads();
}


constexpr size_t MiB = 1u << 20;
constexpr size_t WS_CTL = 0, WS_WIN = 1 * MiB, WS_WPW = 10 * MiB, WS_WAO = 11 * MiB, WS_WOUT = 12 * MiB, WS_WGU = 14 * MiB, WS_WDN = 25 * MiB, WS_RSTD = 31 * MiB,
                 WS_SS = 32 * MiB, WS_SS2 = 34 * MiB, WS_CBP = 36 * MiB, WS_CBS = 37 * MiB, WS_XB = 40 * MiB, WS_CU = 73 * MiB, WS_Q = 90 * MiB, WS_K = 107 * MiB, WS_V = 124 * MiB,
                 WS_GC = 141 * MiB, WS_GA = 174 * MiB, WS_CS = 207 * MiB, WS_AO = 224 * MiB, WS_MIX = 241 * MiB, WS_H = 274 * MiB, WS_HB = 340 * MiB, WS_ACT = 373 * MiB, WS_END = 464 * MiB;
constexpr int CBS_PITCH = 4160;

struct Args { const float* in[21]; float* out; unsigned char* ws; int ph_lo, ph_hi, qmask, pad; };

__device__ __forceinline__ void transpose_item(const float* W, int N, int K, int src_col0, int k0, bf16* WT, int dst_row0, const float* gk, LAS float* scr, int lane) {
    float tmp[32];
    const float* wp = W + (size_t)(k0 + (lane >> 5)) * N + src_col0 + (lane & 31);
#pragma unroll
    for (int i = 0; i < 32; ++i) tmp[i] = wp[(size_t)(2 * i) * N];
    const int c = lane & 7;
    f32x4 g0 = {1.f, 1.f, 1.f, 1.f}, g1 = g0;
    if (gk) { g0 = *(const f32x4*)(gk + k0 + 8 * c); g1 = *(const f32x4*)(gk + k0 + 8 * c + 4); }
#pragma unroll
    for (int i = 0; i < 32; ++i) scr[(2 * i + (lane >> 5)) * 33 + (lane & 31)] = tmp[i];
    asm volatile("s_waitcnt lgkmcnt(0)" ::: "memory");
#pragma unroll
    for (int j = 0; j < 4; ++j) { const int n = (lane >> 3) + 8 * j; const LAS float* s = scr + (8 * c) * 33 + n;
        u32x4 o; o.x = cvtpk(s[0 * 33] * g0[0], s[1 * 33] * g0[1]); o.y = cvtpk(s[2 * 33] * g0[2], s[3 * 33] * g0[3]); o.z = cvtpk(s[4 * 33] * g1[0], s[5 * 33] * g1[1]); o.w = cvtpk(s[6 * 33] * g1[2], s[7 * 33] * g1[3]);
        *(u32x4*)(WT + (size_t)(dst_row0 + n) * K + k0 + 8 * c) = o; }
    asm volatile("s_waitcnt lgkmcnt(0)" ::: "memory");
}

__device__ __forceinline__ void p0_prologue(const Args& a, ldsp lds, int wave, int lane) {
    unsigned char* ws = a.ws;
    const int gw = blockIdx.x * NWAVES + wave, NGW = gridDim.x * NWAVES;
    if (blockIdx.x == 0 && threadIdx.x == 0) __hip_atomic_store((unsigned*)(ws + WS_CTL), 0u, __ATOMIC_RELAXED, __HIP_MEMORY_SCOPE_AGENT);
    LAS float* gwf = (LAS float*)lds;
    { const float* win = a.in[7]; const float* g = a.in[6];
      for (int e = threadIdx.x; e < 8 * DM; e += NTHREADS) { const int k = e >> 3, h = e & 7; gwf[h * DM + k] = win[(size_t)k * DIN + 2560 + h] * g[k]; } }
    LAS float* scr = (LAS float*)(lds + 32768 + wave * 8448);
    constexpr int I_IN = (DM / 64) * (NIN / 32), I_PW = (DC / 64) * (DM / 32), I_AO = (DA / 64) * (DM / 32), I_OUT = (DM / 64) * (DM / 32), I_GU = (DM / 64) * (NGU / 32), I_DN = (DFF / 64) * (DM / 32);
    constexpr int NITEMS = I_IN + I_PW + I_AO + I_OUT + I_GU + I_DN;
    for (int it = gw; it < NITEMS; it += NGW) {
        int r = it;
        if (r < I_IN) { const int nblk = NIN / 32, kb = r / nblk, nb = r % nblk, n = 32 * nb; int src;
            if (n < 1024) { const int pn = n >> 8, rr = n & 255; src = rr < 128 ? 128 * pn + rr : 512 + 128 * pn + (rr - 128); } else if (n < 2560) src = n; else src = n + 8;
            transpose_item(a.in[7], DIN, DM, src, 64 * kb, (bf16*)(ws + WS_WIN), n, a.in[6], scr, lane); continue; } r -= I_IN;
        if (r < I_PW) { const int nblk = DM / 32, kb = r / nblk, nb = r % nblk; transpose_item(a.in[13], DM, DC, 32 * nb, 64 * kb, (bf16*)(ws + WS_WPW), 32 * nb, nullptr, scr, lane); continue; } r -= I_PW;
        if (r < I_AO) { const int nblk = DM / 32, kb = r / nblk, nb = r % nblk; transpose_item(a.in[14], DM, DA, 32 * nb, 64 * kb, (bf16*)(ws + WS_WAO), 32 * nb, nullptr, scr, lane); continue; } r -= I_AO;
        if (r < I_OUT) { const int nblk = DM / 32, kb = r / nblk, nb = r % nblk; transpose_item(a.in[15], DM, DM, 32 * nb, 64 * kb, (bf16*)(ws + WS_WOUT), 32 * nb, nullptr, scr, lane); continue; } r -= I_OUT;
        if (r < I_GU) { const int nblk = NGU / 32, kb = r / nblk, nb = r % nblk, n = 32 * nb, pn = n >> 8, rr = n & 255;
            const float* src = rr < 128 ? a.in[17] : a.in[18]; const int sc = rr < 128 ? 128 * pn + rr : 128 * pn + (rr - 128);
            transpose_item(src, DFF, DM, sc, 64 * kb, (bf16*)(ws + WS_WGU), n, a.in[16], scr, lane); continue; } r -= I_GU;
        { const int nblk = DM / 32, kb = r / nblk, nb = r % nblk; transpose_item(a.in[19], DM, DFF, 32 * nb, 64 * kb, (bf16*)(ws + WS_WDN), 32 * nb, nullptr, scr, lane); }
    }
    __syncthreads();
    float* rstd = (float*)(ws + WS_RSTD); bf16* XB = (bf16*)(ws + WS_XB); const float* bfv = a.in[8];
    for (int m = gw; m < MT; m += NGW) {
        const float* xrow = (m < MP) ? a.in[0] + (size_t)m * DM : a.in[1] + (size_t)(m - MP) * DM;
        const f32x4* xr = (const f32x4*)xrow + lane;
        f32x4 v[4]; float s = 0.f;
#pragma unroll
        for (int j = 0; j < 4; ++j) { v[j] = xr[64 * j]; s += (v[j].x * v[j].x + v[j].y * v[j].y) + (v[j].z * v[j].z + v[j].w * v[j].w); }
        const float rs = 1.0f / sqrtf(wave_sum(s) * (1.0f / DM) + 1e-6f);
        unsigned long long* o8 = (unsigned long long*)(XB + (size_t)m * DM) + lane;
#pragma unroll
        for (int j = 0; j < 4; ++j) o8[64 * j] = (unsigned long long)cvtpk(v[j].x, v[j].y) | ((unsigned long long)cvtpk(v[j].z, v[j].w) << 32);
        float f[8];
#pragma unroll
        for (int h = 0; h < 8; ++h) { float acc = 0.f;
#pragma unroll
            for (int j = 0; j < 4; ++j) { const f32x4 w = *(const LAS f32x4*)(gwf + h * DM + 4 * lane + 256 * j); acc += (v[j].x * w.x + v[j].y * w.y) + (v[j].z * w.z + v[j].w * w.w); }
            f[h] = wave_sum(acc); }
        float fl = f[0];
#pragma unroll
        for (int h = 1; h < 8; ++h) fl = (lane == h) ? f[h] : fl;
        if (lane == 0) rstd[m] = rs;
        if (lane < 8) { const float z = fl * rs + bfv[lane]; const float lf = fminf(z, 0.f) - log1pf(expf(-fabsf(z)));
            float* dst = (m < MP) ? a.out + OFF_LFP + (size_t)m * NH + lane : a.out + OFF_LFS + (size_t)(m - MP) * NH + lane; *dst = lf; }
    }
}

__device__ __forceinline__ void cumsum_phase(const Args& a, int wave, int lane) {
    const int gw = ((int)blockIdx.x - ((int)gridDim.x - 20)) * NWAVES + wave;
    if (gw < 0 || gw >= 160) return;
    unsigned char* ws = a.ws;
    const float* src; float* dst; const float* extra = nullptr;
    if (gw < 32) { const int b = gw >> 3, h = gw & 7; src = a.out + OFF_LFP + (size_t)b * SEQ * NH + h; dst = (float*)(ws + WS_CBP) + (size_t)gw * SEQ; }
    else { const int s = gw - 32, b = s >> 3, h = s & 7; src = a.in[4] + (size_t)b * PAST * NH + h; dst = (float*)(ws + WS_CBS) + (size_t)s * CBS_PITCH; extra = a.out + OFF_LFS + (size_t)b * DS * NH + h; }
    const float* p = src + (size_t)lane * 64 * NH;
    float v[64];
#pragma unroll
    for (int i = 0; i < 64; ++i) v[i] = p[i * NH];
    float tot = 0.f;
#pragma unroll
    for (int i = 0; i < 64; ++i) tot += v[i];
    float incl = tot;
#pragma unroll
    for (int o = 1; o < 64; o <<= 1) { const float t = __shfl_up(incl, o); if (lane >= o) incl += t; }
    float run = incl - tot;
#pragma unroll
    for (int i = 0; i < 64; ++i) { run += v[i]; dst[lane * 64 + i] = -run * LOG2E; }
    if (extra) {
        const float total = __shfl(incl, 63);
        float x = (lane < 32) ? extra[lane * NH] : 0.f; float ic = x;
#pragma unroll
        for (int o = 1; o < 64; o <<= 1) { const float t = __shfl_up(ic, o); if (lane >= o) ic += t; }
        dst[PAST + lane] = (lane < 32) ? -(total + ic) * LOG2E : 0.f;
    }
}

namespace att {
__device__ __forceinline__ int crow(int r, int hi) { return (r & 3) + 8 * (r >> 2) + 4 * hi; }
#define SBAR() __builtin_amdgcn_sched_barrier(0)
__device__ __forceinline__ void qkt(f32x16& p0, f32x16& p1, const LAS unsigned char* Kslot, const bf16x8* qr, int r32, int hi) {
    const LAS unsigned char* kb = Kslot + hi * 1024 + r32 * 16;
    f32x16 z = {};
#pragma unroll
    for (int d0 = 0; d0 < 4; ++d0) {
        const bf16x8 b0 = *(const LAS bf16x8*)(kb + d0 * 2048), b1 = *(const LAS bf16x8*)(kb + d0 * 2048 + 512);
        if (d0 == 0) { p0 = __builtin_amdgcn_mfma_f32_32x32x16_bf16(b0, qr[0], z, 0, 0, 0); p1 = __builtin_amdgcn_mfma_f32_32x32x16_bf16(b1, qr[0], z, 0, 0, 0); }
        else { p0 = __builtin_amdgcn_mfma_f32_32x32x16_bf16(b0, qr[d0], p0, 0, 0, 0); p1 = __builtin_amdgcn_mfma_f32_32x32x16_bf16(b1, qr[d0], p1, 0, 0, 0); } }
}
__device__ __forceinline__ void pv(f32x16* o, int vb, bf16x8 pa0, bf16x8 pa1, bf16x8 pa2, bf16x8 pa3) {
#pragma unroll
    for (int d0 = 0; d0 < 2; ++d0) { s16x4 lo[4], hi[4];
#pragma unroll
        for (int ks = 0; ks < 4; ++ks) {
            asm volatile("ds_read_b64_tr_b16 %0,%1 offset:%c2" : "=&v"(lo[ks]) : "v"(vb), "i"(d0 * 4096 + ks * 1024) : "memory");
            asm volatile("ds_read_b64_tr_b16 %0,%1 offset:%c2" : "=&v"(hi[ks]) : "v"(vb), "i"(d0 * 4096 + ks * 1024 + 512) : "memory"); }
        asm volatile("s_waitcnt lgkmcnt(0)" ::: "memory"); SBAR();
#define PK(k) (bf16x8){lo[k][0], lo[k][1], lo[k][2], lo[k][3], hi[k][0], hi[k][1], hi[k][2], hi[k][3]}
        o[d0] = __builtin_amdgcn_mfma_f32_32x32x16_bf16(pa0, PK(0), o[d0], 0, 0, 0);
        o[d0] = __builtin_amdgcn_mfma_f32_32x32x16_bf16(pa1, PK(1), o[d0], 0, 0, 0);
        o[d0] = __builtin_amdgcn_mfma_f32_32x32x16_bf16(pa2, PK(2), o[d0], 0, 0, 0);
        o[d0] = __builtin_amdgcn_mfma_f32_32x32x16_bf16(pa3, PK(3), o[d0], 0, 0, 0);
#undef PK
    }
}
__device__ __forceinline__ float rowmax(const f32x16& p0, const f32x16& p1) {
    float m = fmaxf(p0[0], p1[0]);
#pragma unroll
    for (int r = 1; r < 16; ++r) m = fmaxf(m, fmaxf(p0[r], p1[r]));
    auto rr = __builtin_amdgcn_permlane32_swap(__float_as_uint(m), __float_as_uint(m), false, false);
    return fmaxf(__uint_as_float(rr[0]), __uint_as_float(rr[1]));
}
__device__ __forceinline__ void tile_a(const LAS unsigned char* Kslot, const LAS float* bs, const bf16x8* qr, bool mask, int koff, int qrel, int r32, int hi,
                                          float& m_run, float& l_run, f32x16* o, LAS float* wsf, u32x4& pw0, u32x4& pw1, u32x4& pw2, u32x4& pw3) {
    f32x16 p0, p1; qkt(p0, p1, Kslot, qr, r32, hi);
#pragma unroll
    for (int i = 0; i < 4; ++i) { const f32x4 b0 = *(const LAS f32x4*)(bs + 8 * i + 4 * hi), b1 = *(const LAS f32x4*)(bs + 32 + 8 * i + 4 * hi);
#pragma unroll
        for (int j = 0; j < 4; ++j) { p0[4 * i + j] += b0[j]; p1[4 * i + j] += b1[j]; } }
    if (mask) {
#pragma unroll
        for (int r = 0; r < 16; ++r) { const int kv = koff + crow(r, hi); if (kv > qrel) p0[r] = -INFINITY; if (kv + 32 > qrel) p1[r] = -INFINITY; } }
    const float rm = rowmax(p0, p1);
    const float mn = fmaxf(m_run, rm), f = __builtin_amdgcn_exp2f(m_run - mn); m_run = mn;
    float s = 0.f;
#pragma unroll
    for (int r = 0; r < 16; ++r) { p0[r] = __builtin_amdgcn_exp2f(p0[r] - mn); p1[r] = __builtin_amdgcn_exp2f(p1[r] - mn); s += p0[r] + p1[r]; }
    l_run = l_run * f + s;
    if (hi == 0) wsf[r32] = f;
    asm volatile("s_waitcnt lgkmcnt(0)" ::: "memory");
#pragma unroll
    for (int i = 0; i < 4; ++i) { const f32x4 fv = *(const LAS f32x4*)(wsf + 8 * i + 4 * hi);
#pragma unroll
        for (int j = 0; j < 4; ++j) { o[0][4 * i + j] *= fv[j]; o[1][4 * i + j] *= fv[j]; } }
#pragma unroll
    for (int j = 0; j < 4; ++j) { pw0[j] = cvtpk(p0[2 * j], p0[2 * j + 1]); pw1[j] = cvtpk(p0[8 + 2 * j], p0[9 + 2 * j]); pw2[j] = cvtpk(p1[2 * j], p1[2 * j + 1]); pw3[j] = cvtpk(p1[8 + 2 * j], p1[9 + 2 * j]); }
}
__device__ __forceinline__ void tile_core(const LAS unsigned char* Kslot, int vb, const LAS float* bs, const bf16x8* qr, bool mask, int koff, int qrel, int r32, int hi,
                                          float& m_run, float& l_run, f32x16* o, LAS float* wsf) {
    u32x4 pw0, pw1, pw2, pw3;
    tile_a(Kslot, bs, qr, mask, koff, qrel, r32, hi, m_run, l_run, o, wsf, pw0, pw1, pw2, pw3);
    pv(o, vb, __builtin_bit_cast(bf16x8, pw0), __builtin_bit_cast(bf16x8, pw1), __builtin_bit_cast(bf16x8, pw2), __builtin_bit_cast(bf16x8, pw3));
}
__device__ __forceinline__ int vbase(int lane, int hi) { return ((lane >> 4) & 1) * 32 + (lane & 3) * 8 + (4 * hi + ((lane & 15) >> 2)) * 64; }

__device__ __forceinline__ void qkt_b(f32x16& p0, f32x16& p1, const LAS unsigned char* Kslot, const LAS float* bs, const bf16x8* qr, int r32, int hi) {
    const LAS unsigned char* kb = Kslot + hi * 1024 + r32 * 16;
    f32x16 c0, c1;
#pragma unroll
    for (int i = 0; i < 4; ++i) { const f32x4 b0 = *(const LAS f32x4*)(bs + 8 * i + 4 * hi), b1 = *(const LAS f32x4*)(bs + 32 + 8 * i + 4 * hi);
#pragma unroll
        for (int j = 0; j < 4; ++j) { c0[4 * i + j] = b0[j]; c1[4 * i + j] = b1[j]; } }
#pragma unroll
    for (int d0 = 0; d0 < 4; ++d0) {
        const bf16x8 b0 = *(const LAS bf16x8*)(kb + d0 * 2048), b1 = *(const LAS bf16x8*)(kb + d0 * 2048 + 512);
        if (d0 == 0) { p0 = __builtin_amdgcn_mfma_f32_32x32x16_bf16(b0, qr[0], c0, 0, 0, 0); p1 = __builtin_amdgcn_mfma_f32_32x32x16_bf16(b1, qr[0], c1, 0, 0, 0); }
        else { p0 = __builtin_amdgcn_mfma_f32_32x32x16_bf16(b0, qr[d0], p0, 0, 0, 0); p1 = __builtin_amdgcn_mfma_f32_32x32x16_bf16(b1, qr[d0], p1, 0, 0, 0); } }
}
__device__ __forceinline__ float max16x2(const f32x16& p0, const f32x16& p1) {
    float m0 = fmaxf(fmaxf(p0[0], p0[1]), p1[0]), m1 = fmaxf(fmaxf(p0[2], p0[3]), p1[1]);
    m0 = fmaxf(fmaxf(m0, p1[2]), p1[3]);
#pragma unroll
    for (int r = 4; r < 16; r += 4) { m0 = fmaxf(fmaxf(m0, p0[r]), p0[r + 1]); m1 = fmaxf(fmaxf(m1, p0[r + 2]), p0[r + 3]); m0 = fmaxf(fmaxf(m0, p1[r]), p1[r + 1]); m1 = fmaxf(fmaxf(m1, p1[r + 2]), p1[r + 3]); }
    return fmaxf(m0, m1);
}
__device__ __forceinline__ void step2(const LAS unsigned char* K0, int vb, const LAS float* bs, const bf16x8* qr, int r32, int hi, float& m_run, float& l_run, f32x16* o, LAS float* wsf) {
    f32x16 a0, a1, b0, b1;
    qkt_b(a0, a1, K0, bs, qr, r32, hi); qkt_b(b0, b1, K0 + 8192, bs + 64, qr, r32, hi);
    float m = fmaxf(max16x2(a0, a1), max16x2(b0, b1));
    { auto rr = __builtin_amdgcn_permlane32_swap(__float_as_uint(m), __float_as_uint(m), false, false); m = fmaxf(__uint_as_float(rr[0]), __uint_as_float(rr[1])); }
    const float mn = fmaxf(m_run, m), f = __builtin_amdgcn_exp2f(m_run - mn); m_run = mn;
    float s0 = 0.f, s1 = 0.f;
#pragma unroll
    for (int r = 0; r < 16; ++r) { a0[r] = __builtin_amdgcn_exp2f(a0[r] - mn); a1[r] = __builtin_amdgcn_exp2f(a1[r] - mn); s0 += a0[r]; s1 += a1[r]; }
#pragma unroll
    for (int r = 0; r < 16; ++r) { b0[r] = __builtin_amdgcn_exp2f(b0[r] - mn); b1[r] = __builtin_amdgcn_exp2f(b1[r] - mn); s0 += b0[r]; s1 += b1[r]; }
    l_run = l_run * f + (s0 + s1);
    if (__any(f != 1.0f)) {
        if (hi == 0) wsf[r32] = f;
        asm volatile("s_waitcnt lgkmcnt(0)" ::: "memory");
#pragma unroll
        for (int i = 0; i < 4; ++i) { const f32x4 fv = *(const LAS f32x4*)(wsf + 8 * i + 4 * hi);
#pragma unroll
            for (int j = 0; j < 4; ++j) { o[0][4 * i + j] *= fv[j]; o[1][4 * i + j] *= fv[j]; } }
    }
    u32x4 pw0, pw1, pw2, pw3;
#pragma unroll
    for (int j = 0; j < 4; ++j) { pw0[j] = cvtpk(a0[2 * j], a0[2 * j + 1]); pw1[j] = cvtpk(a0[8 + 2 * j], a0[9 + 2 * j]); pw2[j] = cvtpk(a1[2 * j], a1[2 * j + 1]); pw3[j] = cvtpk(a1[8 + 2 * j], a1[9 + 2 * j]); }
    pv(o, vb, __builtin_bit_cast(bf16x8, pw0), __builtin_bit_cast(bf16x8, pw1), __builtin_bit_cast(bf16x8, pw2), __builtin_bit_cast(bf16x8, pw3));
#pragma unroll
    for (int j = 0; j < 4; ++j) { pw0[j] = cvtpk(b0[2 * j], b0[2 * j + 1]); pw1[j] = cvtpk(b0[8 + 2 * j], b0[9 + 2 * j]); pw2[j] = cvtpk(b1[2 * j], b1[2 * j + 1]); pw3[j] = cvtpk(b1[8 + 2 * j], b1[9 + 2 * j]); }
    pv(o, vb + 8192, __builtin_bit_cast(bf16x8, pw0), __builtin_bit_cast(bf16x8, pw1), __builtin_bit_cast(bf16x8, pw2), __builtin_bit_cast(bf16x8, pw3));
}

constexpr int PL_K = 0, PL_V = 32768, PL_B = 65536, PL_WS = 66560, PL_OST = 69632;
__device__ __forceinline__ void prompt_unit(int b, int h, int qb, const bf16* Q, const bf16* K, const bf16* V, const float* CB, bf16* O, ldsp lds) {
    int tid_ = threadIdx.x; asm volatile("" : "+v"(tid_));
    const int tid = tid_, lane = tid & 63, r32 = lane & 31, hi = lane >> 5; const int wid = __builtin_amdgcn_readfirstlane(tid >> 6);
    const size_t rowbase = (size_t)b * SEQ; const int q0 = qb * 256;
    const bf16* Qw = Q + (rowbase + q0 + wid * 32) * DA + h * HD;
    const bf16* Kh = K + rowbase * DA + h * HD; const bf16* Vh = V + rowbase * DA + h * HD;
    const float* cb = CB + (size_t)(b * NH + h) * SEQ;
    const bf16* ksrc = Kh + (size_t)lane * DA + wid * 8;
    const bf16* vsrc = Vh + (size_t)(16 * (wid & 3) + (lane >> 2)) * DA + (wid >> 2) * 32 + (lane & 3) * 8;
    const int NT2 = (q0 + 256) / 128;
#define DMA_STEP(t, slot) do { _Pragma("unroll") for (int sub_ = 0; sub_ < 2; ++sub_) { \
        __builtin_amdgcn_global_load_lds((const unsigned*)(ksrc + (size_t)(2 * (t) + sub_) * 64 * DA), (LAS unsigned*)(lds + PL_K + (slot) * 16384 + sub_ * 8192 + wid * 1024), 16, 0, 0); \
        __builtin_amdgcn_global_load_lds((const unsigned*)(vsrc + (size_t)(2 * (t) + sub_) * 64 * DA), (LAS unsigned*)(lds + PL_V + (slot) * 16384 + sub_ * 8192 + wid * 1024), 16, 0, 0); } \
        if (wid < 2) __builtin_amdgcn_global_load_lds((const unsigned*)(cb + (2 * (t) + wid) * 64 + lane), (LAS unsigned*)(lds + PL_B + (slot) * 512 + wid * 256), 4, 0, 0); } while (0)
    DMA_STEP(0, 0);
    bf16x8 qr[4];
#pragma unroll
    for (int d0 = 0; d0 < 4; ++d0) qr[d0] = *(const bf16x8*)(Qw + (size_t)r32 * DA + d0 * 16 + hi * 8);
    float m_run = -1e30f, l_run = 0.f; f32x16 o[2]; o[0] = f32x16{}; o[1] = f32x16{};
    LAS float* wsf = (LAS float*)(lds + PL_WS + wid * 256);
    const int lds0 = (int)(unsigned)(uintptr_t)lds;
    const int vb0 = lds0 + PL_V + vbase(lane, hi);
    const int qrel = wid * 32 + r32;
    for (int t = 0; t < NT2; ++t) {
        BLOCK_BAR();
        const int slot = t & 1;
        if (t + 1 < NT2) DMA_STEP(t + 1, slot ^ 1);
        const int jb2 = t - (NT2 - 2);
        if (jb2 < 0) step2(lds + PL_K + slot * 16384, vb0 + slot * 16384, (const LAS float*)(lds + PL_B + slot * 512), qr, r32, hi, m_run, l_run, o, wsf);
        else {
#pragma unroll
            for (int sub = 0; sub < 2; ++sub) { const int js = 2 * jb2 + sub;
                if (64 * js <= wid * 32 + 31)
                    tile_core(lds + PL_K + slot * 16384 + sub * 8192, vb0 + slot * 16384 + sub * 8192, (const LAS float*)(lds + PL_B + slot * 512 + sub * 256), qr, true, 64 * js, qrel, r32, hi, m_run, l_run, o, wsf); }
        }
    }
#undef DMA_STEP
    { auto rr = __builtin_amdgcn_permlane32_swap(__float_as_uint(l_run), __float_as_uint(l_run), false, false); l_run = __uint_as_float(rr[0]) + __uint_as_float(rr[1]); }
    if (hi == 0) wsf[32 + r32] = l_run;
    asm volatile("s_waitcnt lgkmcnt(0)" ::: "memory");
    float rli[16];
#pragma unroll
    for (int r = 0; r < 16; ++r) rli[r] = 1.0f / wsf[32 + crow(r, hi)];
    bf16* Ow = O + (rowbase + q0 + wid * 32) * DA + h * HD;
    { LAS bf16* stg = (LAS bf16*)(lds + PL_OST + wid * 4096);
#pragma unroll
      for (int r = 0; r < 16; ++r) { const int orow = crow(r, hi);
#pragma unroll
          for (int d0 = 0; d0 < 2; ++d0) { const float v = o[d0][r] * rli[r]; stg[orow * 64 + d0 * 32 + r32] = (bf16)(cvtpk(v, v) & 0xffffu); } }
      asm volatile("s_waitcnt lgkmcnt(0)" ::: "memory");
#pragma unroll
      for (int i = 0; i < 4; ++i) { const int row = i * 8 + (lane >> 3), ch = lane & 7; const u32x4 v = *(const LAS u32x4*)(stg + row * 64 + ch * 8); *(u32x4*)(Ow + (size_t)row * DA + ch * 8) = v; } }
    BLOCK_BAR();
}

constexpr int SL_B = 131072, SL_WS = 133120, SL_M = 135168, SL_L = 136192;
__device__ __forceinline__ void sample_unit(int b, int h, const Args& a, ldsp lds) {
    int tid_ = threadIdx.x; asm volatile("" : "+v"(tid_));
    const int tid = tid_, lane = tid & 63, r32 = lane & 31, hi = lane >> 5; const int wid = __builtin_amdgcn_readfirstlane(tid >> 6);
    unsigned char* ws = a.ws;
    const bf16* Q = (const bf16*)(ws + WS_Q); const bf16* Kn = (const bf16*)(ws + WS_K); const bf16* Vn = (const bf16*)(ws + WS_V); bf16* O = (bf16*)(ws + WS_AO);
    const float* cbs = (const float*)(ws + WS_CBS) + (size_t)(b * NH + h) * CBS_PITCH;
    const size_t srow = (size_t)MP + (size_t)b * DS;
    const float* ck = a.in[2] + ((size_t)b * PAST * NH + h) * HD; const float* cv = a.in[3] + ((size_t)b * PAST * NH + h) * HD;
    ldsp Kw = lds + wid * 16384; ldsp Vw = Kw + 8192;
    LAS float* bsw = (LAS float*)(lds + SL_B + wid * 256); LAS float* wsf = (LAS float*)(lds + SL_WS + wid * 256);
    bf16x8 qr[4];
#pragma unroll
    for (int d0 = 0; d0 < 4; ++d0) qr[d0] = *(const bf16x8*)(Q + (srow + r32) * DA + h * HD + d0 * 16 + hi * 8);
    float m_run = -1e30f, l_run = 0.f; f32x16 o[2]; o[0] = f32x16{}; o[1] = f32x16{};
    const int vb0 = (int)(unsigned)(uintptr_t)Vw + vbase(lane, hi);
    const int f4 = lane & 15, kq = lane >> 4; const int voff = (kq * DA + 4 * f4) * 4;
    const __amdgpu_buffer_rsrc_t rk = __builtin_amdgcn_make_buffer_rsrc((void*)ck, 0, PAST * 2048, 0x00027000), rv = __builtin_amdgcn_make_buffer_rsrc((void*)cv, 0, PAST * 2048, 0x00027000);
    const int koffK = (f4 >> 1) * 1024 + (f4 & 1) * 8;
    const int koffV = (f4 >> 3) * 4096 + ((f4 & 7) >> 1) * 16 + (f4 & 1) * 8;
    f32x4 kreg[8];
#pragma unroll
    for (int i = 0; i < 8; ++i) kreg[i] = __builtin_bit_cast(f32x4, __builtin_amdgcn_raw_buffer_load_b128(rk, voff, (512 * wid + 4 * i) * 2048, 0));
    for (int tt = 0; tt < 8; ++tt) {
        const int key0 = 512 * wid + 64 * tt;
        { f32x4 kreg2[8];
#pragma unroll
          for (int i = 0; i < 8; ++i) kreg2[i] = __builtin_bit_cast(f32x4, __builtin_amdgcn_raw_buffer_load_b128(rk, voff, (key0 + 32 + 4 * i) * 2048, 0));
#pragma unroll
          for (int i = 0; i < 8; ++i) { const int key = 4 * i + kq; u32x2 w; w.x = cvtpk(kreg[i].x, kreg[i].y); w.y = cvtpk(kreg[i].z, kreg[i].w); *(LAS u32x2*)(Kw + koffK + key * 16) = w; }
#pragma unroll
          for (int i = 0; i < 8; ++i) { const int key = 32 + 4 * i + kq; u32x2 w; w.x = cvtpk(kreg2[i].x, kreg2[i].y); w.y = cvtpk(kreg2[i].z, kreg2[i].w); *(LAS u32x2*)(Kw + koffK + key * 16) = w; } }
        asm volatile("" ::: "memory");
        f32x4 vreg[16];
#pragma unroll
        for (int i = 0; i < 16; ++i) vreg[i] = __builtin_bit_cast(f32x4, __builtin_amdgcn_raw_buffer_load_b128(rv, voff, (key0 + 4 * i) * 2048, 0));
        bsw[lane] = cbs[key0 + lane];
        asm volatile("s_waitcnt lgkmcnt(0)" ::: "memory");
        u32x4 pw0, pw1, pw2, pw3;
        tile_a(Kw, bsw, qr, false, 0, 0, r32, hi, m_run, l_run, o, wsf, pw0, pw1, pw2, pw3);
        asm volatile("" ::: "memory");
#pragma unroll
        for (int i = 0; i < 16; ++i) { const int key = 4 * i + kq; u32x2 w; w.x = cvtpk(vreg[i].x, vreg[i].y); w.y = cvtpk(vreg[i].z, vreg[i].w); *(LAS u32x2*)(Vw + koffV + (key >> 4) * 1024 + (key & 15) * 64) = w; }
        asm volatile("" ::: "memory");
        if (tt < 7) {
#pragma unroll
            for (int i = 0; i < 8; ++i) kreg[i] = __builtin_bit_cast(f32x4, __builtin_amdgcn_raw_buffer_load_b128(rk, voff, (key0 + 64 + 4 * i) * 2048, 0)); }
        asm volatile("s_waitcnt lgkmcnt(0)" ::: "memory");
        pv(o, vb0, __builtin_bit_cast(bf16x8, pw0), __builtin_bit_cast(bf16x8, pw1), __builtin_bit_cast(bf16x8, pw2), __builtin_bit_cast(bf16x8, pw3));
    }
    if (wid == 7) {
        const int key = lane >> 1, half = lane & 1;
        const u32x4* kp = (const u32x4*)(Kn + (srow + key) * DA + h * HD + half * 32); const u32x4* vp = (const u32x4*)(Vn + (srow + key) * DA + h * HD + half * 32);
#pragma unroll
        for (int c = 0; c < 4; ++c) { *(LAS u32x4*)(Kw + (4 * half + c) * 1024 + key * 16) = kp[c]; *(LAS u32x4*)(Kw + (4 * half + c) * 1024 + (key + 32) * 16) = (u32x4){0u, 0u, 0u, 0u}; }
#pragma unroll
        for (int c = 0; c < 4; ++c) { *(LAS u32x4*)(Vw + (half * 4 + (key >> 4)) * 1024 + ((key & 15) * 4 + c) * 16) = vp[c]; *(LAS u32x4*)(Vw + (half * 4 + 2 + (key >> 4)) * 1024 + ((key & 15) * 4 + c) * 16) = (u32x4){0u, 0u, 0u, 0u}; }
        bsw[lane] = cbs[PAST + lane];
        asm volatile("s_waitcnt lgkmcnt(0)" ::: "memory");
        tile_core(Kw, vb0, bsw, qr, true, 0, r32, r32, hi, m_run, l_run, o, wsf);
    }
    { auto rr = __builtin_amdgcn_permlane32_swap(__float_as_uint(l_run), __float_as_uint(l_run), false, false); l_run = __uint_as_float(rr[0]) + __uint_as_float(rr[1]); }
    LAS float* Mw = (LAS float*)(lds + SL_M); LAS float* Lw = (LAS float*)(lds + SL_L);
    if (hi == 0) { Mw[wid * 32 + r32] = m_run; Lw[wid * 32 + r32] = l_run; }
    BLOCK_BAR();
    float M = -1e30f;
#pragma unroll
    for (int w = 0; w < 8; ++w) M = fmaxf(M, Mw[w * 32 + r32]);
    float L = 0.f;
#pragma unroll
    for (int w = 0; w < 8; ++w) L += Lw[w * 32 + r32] * __builtin_amdgcn_exp2f(Mw[w * 32 + r32] - M);
    const float g = __builtin_amdgcn_exp2f(m_run - M) / L;
    if (hi == 0) wsf[r32] = g;
    asm volatile("s_waitcnt lgkmcnt(0)" ::: "memory");
    LAS float* OW = (LAS float*)Kw;
#pragma unroll
    for (int r = 0; r < 16; ++r) { const int q = crow(r, hi); const float gg = wsf[q];
#pragma unroll
        for (int d0 = 0; d0 < 2; ++d0) OW[q * 64 + d0 * 32 + r32] = o[d0][r] * gg; }
    BLOCK_BAR();
    { const int q = tid >> 4, d = (tid & 15) * 4; f32x4 acc = {0.f, 0.f, 0.f, 0.f};
#pragma unroll
      for (int w = 0; w < 8; ++w) acc += *(const LAS f32x4*)(lds + w * 16384 + (q * 64 + d) * 4);
      u32x2 wv; wv.x = cvtpk(acc.x, acc.y); wv.y = cvtpk(acc.z, acc.w); *(u32x2*)(O + (srow + q) * DA + h * HD + d) = wv; }
    BLOCK_BAR();
}
#undef SBAR
}

__device__ __forceinline__ void conv_unit(int u, const Args& a, ldsp lds) {
    int tid_ = threadIdx.x; asm volatile("" : "+v"(tid_));
    const int tid = tid_, lane = tid & 63; const int wid = __builtin_amdgcn_readfirstlane(tid >> 6);
    unsigned char* ws = a.ws; const bf16* CU = (const bf16*)(ws + WS_CU); bf16* CS = (bf16*)(ws + WS_CS);
    const float* wdw = a.in[9]; const float* bdw = a.in[10]; const float* lng = a.in[11]; const float* lnb = a.in[12];
    asm volatile("" : "+s"(wdw), "+s"(bdw), "+s"(lng), "+s"(lnb));
    const int row0 = 32 * u, rw = row0 + 4 * wid, cA = 4 * lane, cB = 256 + 4 * lane;
    LAS f32x4* W4 = (LAS f32x4*)lds;
    for (int e = tid; e < (CW + 6) * (DC / 4); e += NTHREADS) { const int j = (e >> 7) - 3; f32x4 v = {0.f, 0.f, 0.f, 0.f}; if (j >= 0 && j < CW) v = ((const f32x4*)wdw)[e - 3 * (DC / 4)]; W4[e] = v; }
    constexpr int XOFF = (CW + 6) * DC * 4;
    LAS u32x4* X4 = (LAS u32x4*)(lds + XOFF);
    if (row0 < MP) { const int t0 = (row0 & (SEQ - 1)) - 30;
        for (int e = tid; e < 62 * 64; e += NTHREADS) { const int r = e >> 6; u32x4 v = {0u, 0u, 0u, 0u};
            if (t0 + r >= 0) v = *(const u32x4*)(CU + (size_t)(row0 - 30 + r) * DC + (e & 63) * 8);
            X4[e] = v; } }
    else { const int b = (row0 - MP) >> 5; const float* st = a.in[5] + (size_t)b * 30 * DC;
        for (int e = tid; e < 62 * 64; e += NTHREADS) { const int r = e >> 6; u32x4 v;
            if (r >= 30) v = *(const u32x4*)(CU + (size_t)(row0 - 30 + r) * DC + (e & 63) * 8);
            else { const float* p = st + (size_t)r * DC + (e & 63) * 8; v = pg8::pack8(*(const f32x4*)p, *(const f32x4*)(p + 4)); }
            X4[e] = v; } }
    const f32x4 biasA = *(const f32x4*)(bdw + cA), biasB = *(const f32x4*)(bdw + cB);
    f32x4 accA[4], accB[4], wA[4], wB[4];
#pragma unroll
    for (int r = 0; r < 4; ++r) { accA[r] = biasA; accB[r] = biasB; wA[r] = (f32x4){0.f, 0.f, 0.f, 0.f}; wB[r] = wA[r]; }
    BLOCK_BAR();
    const LAS unsigned char* xrow = lds + XOFF + (4 * wid) * 1024;
#pragma unroll 4
    for (int i = 0; i < 34; ++i) {
        wA[0] = W4[(i + 3) * (DC / 4) + lane]; wB[0] = W4[(i + 3) * (DC / 4) + 64 + lane];
        const u32x2 xa = *(const LAS u32x2*)(xrow + i * 1024 + cA * 2), xb = *(const LAS u32x2*)(xrow + i * 1024 + cB * 2);
        f32x4 fa, fb;
        fa[0] = __uint_as_float(xa.x << 16); fa[1] = __uint_as_float(xa.x & 0xffff0000u); fa[2] = __uint_as_float(xa.y << 16); fa[3] = __uint_as_float(xa.y & 0xffff0000u);
        fb[0] = __uint_as_float(xb.x << 16); fb[1] = __uint_as_float(xb.x & 0xffff0000u); fb[2] = __uint_as_float(xb.y << 16); fb[3] = __uint_as_float(xb.y & 0xffff0000u);
#pragma unroll
        for (int r = 0; r < 4; ++r) { accA[r] += wA[r] * fa; accB[r] += wB[r] * fb; }
        wA[3] = wA[2]; wA[2] = wA[1]; wA[1] = wA[0]; wB[3] = wB[2]; wB[2] = wB[1]; wB[1] = wB[0];
    }
    const f32x4 gA = *(const f32x4*)(lng + cA), gB = *(const f32x4*)(lng + cB), bA = *(const f32x4*)(lnb + cA), bB = *(const f32x4*)(lnb + cB);
#pragma unroll
    for (int r = 0; r < 4; ++r) {
        f32x4 v0 = accA[r], v1 = accB[r];
        const float mean = wave_sum((v0.x + v0.y) + (v0.z + v0.w) + (v1.x + v1.y) + (v1.z + v1.w)) * (1.0f / DC);
        v0 = v0 - mean; v1 = v1 - mean;
        const float var = wave_sum((v0.x * v0.x + v0.y * v0.y) + (v0.z * v0.z + v0.w * v0.w) + (v1.x * v1.x + v1.y * v1.y) + (v1.z * v1.z + v1.w * v1.w)) * (1.0f / DC);
        const float rs = 1.0f / sqrtf(var + 1e-5f);
        f32x4 y0 = v0 * rs * gA + bA, y1 = v1 * rs * gB + bB;
        y0 = y0 * pg8::sigm4(y0); y1 = y1 * pg8::sigm4(y1);
        bf16* o = CS + (size_t)(rw + r) * DC;
        *(u32x2*)(o + cA) = (u32x2){cvtpk(y0[0], y0[1]), cvtpk(y0[2], y0[3])}; *(u32x2*)(o + cB) = (u32x2){cvtpk(y1[0], y1[1]), cvtpk(y1[2], y1[3])}; }
    BLOCK_BAR();
}

constexpr int NU_SAMPLE = DB * NH, NU_PROMPT = 4 * NH * 16, NU_CONV = MT / 32, NU_TOTAL = NU_SAMPLE + NU_PROMPT + NU_CONV;
__device__ __forceinline__ void queue_phase(const Args& a, ldsp lds) {
    unsigned char* ws = a.ws; unsigned* ctr = (unsigned*)(ws + WS_CTL);
    volatile LAS unsigned* qw = (volatile LAS unsigned*)(lds + LDS_QW);
    for (;;) {
        if (threadIdx.x == 0) qw[0] = __hip_atomic_fetch_add(ctr, 1u, __ATOMIC_RELAXED, __HIP_MEMORY_SCOPE_AGENT);
        __syncthreads();
        const int id = (int)qw[0];
        __syncthreads();
        if (id >= NU_TOTAL) break;
        if (id < NU_SAMPLE) { if (a.qmask & 1) att::sample_unit(id >> 3, id & 7, a, lds); }
        else if (id < NU_SAMPLE + NU_PROMPT) { if (a.qmask & 2) { const int j = id - NU_SAMPLE, qb = 15 - (j >> 5), bh = j & 31;
            att::prompt_unit(bh >> 3, bh & 7, qb, (const bf16*)(ws + WS_Q), (const bf16*)(ws + WS_K), (const bf16*)(ws + WS_V), (const float*)(ws + WS_CBP), (bf16*)(ws + WS_AO), lds); } }
        else if (a.qmask & 4) conv_unit(id - NU_SAMPLE - NU_PROMPT, a, lds);
    }
}

constexpr int SG_PITCH = 68;
template <int K> __device__ __forceinline__ void sg_accum(const bf16* A, const bf16* Bt, int row0, int col0, int wave, int lane, f32x4 (&acc)[2][4]) {
    const int fr = lane & 15, fq = lane >> 4;
    const bf16* ap = A + (size_t)(row0 + fr) * K + 8 * fq; const bf16* bp = Bt + (size_t)(col0 + fr) * K + 8 * fq;
#pragma unroll 2
    for (int ks = wave; ks < K / 32; ks += 8) {
        bf16x8 av[2], bv[4];
#pragma unroll
        for (int mi = 0; mi < 2; ++mi) av[mi] = *(const bf16x8*)(ap + (size_t)mi * 16 * K + ks * 32);
#pragma unroll
        for (int ni = 0; ni < 4; ++ni) bv[ni] = *(const bf16x8*)(bp + (size_t)ni * 16 * K + ks * 32);
#pragma unroll
        for (int mi = 0; mi < 2; ++mi)
#pragma unroll
            for (int ni = 0; ni < 4; ++ni) acc[mi][ni] = __builtin_amdgcn_mfma_f32_16x16x32_bf16(bv[ni], av[mi], acc[mi][ni], 0, 0, 0);
    }
}
__device__ __forceinline__ f32x4 sg_reduce(ldsp lds, const f32x4 (&acc)[2][4], int wave, int lane, int tid) {
    const int fr = lane & 15, fq = lane >> 4;
    LAS float* R = (LAS float*)lds + wave * (32 * SG_PITCH);
#pragma unroll
    for (int mi = 0; mi < 2; ++mi)
#pragma unroll
        for (int ni = 0; ni < 4; ++ni) *(LAS f32x4*)(R + (16 * mi + fr) * SG_PITCH + 16 * ni + 4 * fq) = acc[mi][ni];
    BLOCK_BAR();
    f32x4 sum = {0.f, 0.f, 0.f, 0.f};
#pragma unroll
    for (int w = 0; w < 8; ++w) sum += *(const LAS f32x4*)((LAS float*)lds + w * (32 * SG_PITCH) + (tid >> 4) * SG_PITCH + 4 * (tid & 15));
    BLOCK_BAR();
    return sum;
}
__device__ __forceinline__ f32x4 bf4(const bf16* p) { const u32x2 w = *(const u32x2*)p; f32x4 r; r[0] = __uint_as_float(w.x << 16); r[1] = __uint_as_float(w.x & 0xffff0000u); r[2] = __uint_as_float(w.y << 16); r[3] = __uint_as_float(w.y & 0xffff0000u); return r; }
__device__ __forceinline__ void st_bf4(bf16* p, const f32x4 v) { u32x2 w; w.x = cvtpk(v[0], v[1]); w.y = cvtpk(v[2], v[3]); *(u32x2*)p = w; }
__device__ __forceinline__ float row16_sum(float v) { v += __shfl_xor(v, 1); v += __shfl_xor(v, 2); v += __shfl_xor(v, 4); v += __shfl_xor(v, 8); return v; }
#define SG_ZERO(acc) do { _Pragma("unroll") for (int mi_ = 0; mi_ < 2; ++mi_) _Pragma("unroll") for (int ni_ = 0; ni_ < 4; ++ni_) acc[mi_][ni_] = (f32x4){0.f, 0.f, 0.f, 0.f}; } while (0)
__device__ __forceinline__ void small_mix(const Args& a, ldsp lds, int wave, int lane) {
    unsigned char* ws = a.ws; int tid_ = threadIdx.x; asm volatile("" : "+v"(tid_)); const int tid = tid_;
    for (int u = blockIdx.x; u < 256; u += gridDim.x) {
        const int row0 = MP + 32 * (u >> 4), col0 = 64 * (u & 15);
        f32x4 acc[2][4]; SG_ZERO(acc);
        sg_accum<DC>((const bf16*)(ws + WS_CS), (const bf16*)(ws + WS_WPW), row0, col0, wave, lane, acc);
        const f32x4 r1 = sg_reduce(lds, acc, wave, lane, tid);
        SG_ZERO(acc);
        sg_accum<DA>((const bf16*)(ws + WS_AO), (const bf16*)(ws + WS_WAO), row0, col0, wave, lane, acc);
        const f32x4 r2 = sg_reduce(lds, acc, wave, lane, tid);
        const size_t o = (size_t)(row0 + (tid >> 4)) * DM + col0 + 4 * (tid & 15);
        st_bf4((bf16*)(ws + WS_MIX) + o, bf4((const bf16*)(ws + WS_GC) + o) * r1 + bf4((const bf16*)(ws + WS_GA) + o) * r2);
    }
}
__device__ __forceinline__ void small_out(const Args& a, ldsp lds, int wave, int lane) {
    unsigned char* ws = a.ws; int tid_ = threadIdx.x; asm volatile("" : "+v"(tid_)); const int tid = tid_;
    for (int u = blockIdx.x; u < 256; u += gridDim.x) {
        const int row0 = MP + 32 * (u >> 4), col0 = 64 * (u & 15);
        f32x4 acc[2][4]; SG_ZERO(acc);
        sg_accum<DM>((const bf16*)(ws + WS_MIX), (const bf16*)(ws + WS_WOUT), row0, col0, wave, lane, acc);
        const f32x4 r = sg_reduce(lds, acc, wave, lane, tid);
        const int row = row0 + (tid >> 4); const size_t o = (size_t)row * DM + col0 + 4 * (tid & 15);
        const f32x4 h = r + *(const f32x4*)(a.in[1] + (o - (size_t)MP * DM));
        st_bf4((bf16*)(ws + WS_HB) + o, h);
        const float ss = row16_sum((h[0] * h[0] + h[1] * h[1]) + (h[2] * h[2] + h[3] * h[3]));
        if ((tid & 15) == 0) ((float*)(ws + WS_SS))[(size_t)row * 16 + (u & 15)] = ss;
    }
}
__device__ __forceinline__ void small_down(const Args& a, ldsp lds, int wave, int lane) {
    unsigned char* ws = a.ws; int tid_ = threadIdx.x; asm volatile("" : "+v"(tid_)); const int tid = tid_;
    for (int u = blockIdx.x; u < 256; u += gridDim.x) {
        const int row0 = MP + 32 * (u >> 4), col0 = 64 * (u & 15);
        f32x4 acc[2][4]; SG_ZERO(acc);
        sg_accum<DFF>((const bf16*)(ws + WS_ACT), (const bf16*)(ws + WS_WDN), row0, col0, wave, lane, acc);
        const f32x4 r = sg_reduce(lds, acc, wave, lane, tid);
        const int row = row0 + (tid >> 4); const size_t o = (size_t)row * DM + col0 + 4 * (tid & 15);
        const f32x4 h = r + bf4((const bf16*)(ws + WS_HB) + o);
        *(f32x4*)(a.out + o) = h;
        const float ss = row16_sum((h[0] * h[0] + h[1] * h[1]) + (h[2] * h[2] + h[3] * h[3]));
        if ((tid & 15) == 0) ((float*)(ws + WS_SS2))[(size_t)row * 16 + (u & 15)] = ss;
    }
}

__device__ __forceinline__ void final_norm(const Args& a, int wave, int lane) {
    const int gw = blockIdx.x * NWAVES + wave, NGW = gridDim.x * NWAVES;
    const float* SS2 = (const float*)(a.ws + WS_SS2); const float* g = a.in[20];
    f32x4 gv[4];
#pragma unroll
    for (int j = 0; j < 4; ++j) gv[j] = ((const f32x4*)g)[lane + 64 * j];
    for (int m = gw; m < MT; m += NGW) {
        const float part = (lane < 16) ? SS2[(size_t)m * 16 + lane] : 0.f;
        const float rs = 1.0f / sqrtf(wave_sum(part) * (1.0f / DM) + 1e-6f);
        f32x4* yr = (f32x4*)(a.out + (size_t)m * DM) + lane;
#pragma unroll
        for (int j = 0; j < 4; ++j) { const f32x4 v = yr[64 * j]; yr[64 * j] = v * rs * gv[j]; }
    }
}

constexpr int NPHASE = 8;
__global__ void __launch_bounds__(NTHREADS, 2) fwd_kernel(Args a) {
    extern __shared__ __attribute__((aligned(16))) unsigned char lds_raw[];
    ldsp lds = (ldsp)lds_raw;
    const int tid = threadIdx.x, lane = tid & 63; const int wave = __builtin_amdgcn_readfirstlane(tid >> 6);
    unsigned char* ws = a.ws;
    const int lo = a.ph_lo, hi = a.ph_hi; const int G = gridDim.x, c = blockIdx.x;
#ifdef PHASE_ONLY
#define IN(k) ((k) == PHASE_ONLY && lo <= (k) && (k) < hi)
#else
#define IN(k) (lo <= (k) && (k) < hi)
#endif
    if (tid < 4) ((LAS unsigned*)(lds + LDS_XB))[tid] = 0u;
    __syncthreads();
    XcdBarrier bar; bar.bar = (unsigned*)(ws + WS_CTL + CTL_BAR_BYTE); bar.x = 0; bar.st = nullptr;
    if (hi - lo > 1) bar = xcd_barrier_post((unsigned*)(ws + WS_CTL + CTL_BAR_BYTE), (volatile LAS unsigned*)(lds + LDS_XB));
    if (lo < 0) cg::this_grid().sync();
#define SEAM(k) do { if (IN(k) && IN((k) + 1)) { xcd_barrier(bar); } } while (0)
#ifndef REP0
#define REP0 1
#endif
    if (IN(0)) for (int rep_ = 0; rep_ < REP0; ++rep_) { p0_prologue(a, lds, wave, lane); __syncthreads(); }
    SEAM(0);
#ifndef REP1
#define REP1 1
#endif
    if (IN(1)) for (int rep_ = 0; rep_ < REP1; ++rep_) {
        if (rep_) xcd_barrier(bar);
        cumsum_phase(a, wave, lane);
        pg8::Gemm g{(const bf16*)(ws + WS_XB), (const bf16*)(ws + WS_WIN), MT, NIN, DM}; pg8::StaticOrder S; S.init(MT, NIN, G, c);
        pg8::EpiIn E{(const float*)(ws + WS_RSTD), (bf16*)(ws + WS_CU), (bf16*)(ws + WS_Q), (bf16*)(ws + WS_K), (bf16*)(ws + WS_V), (bf16*)(ws + WS_GC), (bf16*)(ws + WS_GA), a.out};
        pg8::gemm_phase<pg8::EpiIn, pg8::StaticOrder, true, true>(lds, g, S, E);
    }
    SEAM(1);
    if (IN(2)) queue_phase(a, lds);
#ifdef PROBE_Q2
    xcd_barrier(bar); if (blockIdx.x == 0 && threadIdx.x == 0) __hip_atomic_store((unsigned*)(ws + WS_CTL), 0u, __ATOMIC_RELAXED, __HIP_MEMORY_SCOPE_AGENT); xcd_barrier(bar);
    if (IN(2)) queue_phase(a, lds);
#endif
    SEAM(2);
#ifndef REP3
#define REP3 1
#endif
    if (IN(3)) for (int rep_ = 0; rep_ < REP3; ++rep_) {
        if (rep_) xcd_barrier(bar);
        { pg8::Gemm g{(const bf16*)(ws + WS_CS), (const bf16*)(ws + WS_WPW), MP, DM, DC}; pg8::StaticOrder S; S.init(MP, DM, G, c);
          pg8::EpiMix<false> E{(const bf16*)(ws + WS_GC), (bf16*)(ws + WS_MIX)};
          pg8::gemm_phase<pg8::EpiMix<false>, pg8::StaticOrder, true, true>(lds, g, S, E); }
        asm volatile("s_waitcnt vmcnt(0)" ::: "memory"); __syncthreads();
        { pg8::Gemm g{(const bf16*)(ws + WS_AO), (const bf16*)(ws + WS_WAO), MP, DM, DA}; pg8::StaticOrder S; S.init(MP, DM, G, c);
          pg8::EpiMix<true> E{(const bf16*)(ws + WS_GA), (bf16*)(ws + WS_MIX)};
          pg8::gemm_phase<pg8::EpiMix<true>, pg8::StaticOrder, true, true>(lds, g, S, E); }
        small_mix(a, lds, wave, lane);
    }
    SEAM(3);
#ifndef REP4
#define REP4 1
#endif
    if (IN(4)) for (int rep_ = 0; rep_ < REP4; ++rep_) {
        if (rep_) xcd_barrier(bar);
        pg8::Gemm g{(const bf16*)(ws + WS_MIX), (const bf16*)(ws + WS_WOUT), MP, DM, DM}; pg8::StaticOrder S; S.init(MP, DM, G, c);
        pg8::EpiOut E{a.in[0], a.in[1], (bf16*)(ws + WS_HB), (float*)(ws + WS_SS)};
        pg8::gemm_phase<pg8::EpiOut, pg8::StaticOrder, true, true>(lds, g, S, E);
        small_out(a, lds, wave, lane);
    }
    SEAM(4);
#ifndef REP5
#define REP5 1
#endif
    if (IN(5)) for (int rep_ = 0; rep_ < REP5; ++rep_) {
        if (rep_) xcd_barrier(bar);
        pg8::Gemm g{(const bf16*)(ws + WS_HB), (const bf16*)(ws + WS_WGU), MT, NGU, DM}; pg8::StaticOrder S; S.init(MT, NGU, G, c);
        pg8::EpiGU E{(const float*)(ws + WS_SS), (bf16*)(ws + WS_ACT)};
        pg8::gemm_phase<pg8::EpiGU, pg8::StaticOrder, true, true>(lds, g, S, E);
    }
    SEAM(5);
#ifndef REP6
#define REP6 1
#endif
    if (IN(6)) for (int rep_ = 0; rep_ < REP6; ++rep_) {
        if (rep_) xcd_barrier(bar);
        pg8::Gemm g{(const bf16*)(ws + WS_ACT), (const bf16*)(ws + WS_WDN), MP, DM, DFF}; pg8::StaticOrder S; S.init(MP, DM, G, c);
        pg8::EpiDown E{(const bf16*)(ws + WS_HB), a.out, (float*)(ws + WS_SS2)};
        pg8::gemm_phase<pg8::EpiDown, pg8::StaticOrder, true, true>(lds, g, S, E);
        small_down(a, lds, wave, lane);
    }
    SEAM(6);
    if (IN(7)) final_norm(a, wave, lane);
#ifdef PROBE_SYNCS
    for (int i_ = 0; i_ < PROBE_SYNCS; ++i_) xcd_barrier(bar);
#endif
#undef IN
#undef SEAM
}

#ifndef N_LAUNCHES
#define N_LAUNCHES 1
#endif
extern "C" void kernel_launch(void* const* d_in, const int* in_sizes, int n_in, void* d_out, int out_size, void* d_ws, size_t ws_size, hipStream_t stream) {
    static int grid = 0;
    if (grid == 0) {
        if (n_in != 21 || (size_t)out_size != OUT_TOTAL || ws_size < WS_END) { fprintf(stderr, "kernel_launch: unexpected shapes (n_in %d out %d ws %zu)\n", n_in, out_size, ws_size); grid = -1; return; }
        int dev = 0, cus = 0, per_cu = 0;
        hipGetDevice(&dev); hipDeviceGetAttribute(&cus, hipDeviceAttributeMultiprocessorCount, dev);
        hipFuncSetAttribute((const void*)fwd_kernel, hipFuncAttributeMaxDynamicSharedMemorySize, LDS_BYTES);
        hipOccupancyMaxActiveBlocksPerMultiprocessor(&per_cu, (const void*)fwd_kernel, NTHREADS, LDS_BYTES);
        (void)hipGetLastError();
        if (per_cu < 1) fprintf(stderr, "kernel_launch: occupancy query says %d blocks per CU\n", per_cu);
        grid = cus > 0 ? cus : 256;
    }
    if (grid < 0) return;
    if (hipMemsetAsync((char*)d_ws + WS_CTL, 0, CTL_ZERO_BYTES, stream) != hipSuccess) { fprintf(stderr, "kernel_launch: memset failed\n"); return; }
    Args a{};
    for (int i = 0; i < 21; ++i) a.in[i] = (const float*)d_in[i];
    a.out = (float*)d_out; a.ws = (unsigned char*)d_ws; a.qmask = 7;
#if N_LAUNCHES == 1
    a.ph_lo = 0; a.ph_hi = NPHASE;
    void* args[] = {&a};
    hipError_t e = hipLaunchCooperativeKernel((const void*)fwd_kernel, dim3(grid), dim3(NTHREADS), args, LDS_BYTES, stream);
    if (e != hipSuccess) fprintf(stderr, "cooperative launch failed: %s (grid %d)\n", hipGetErrorString(e), grid);
#else
    for (int p = 0; p < NPHASE; ++p) { a.ph_lo = p; a.ph_hi = p + 1; a.qmask = 7; hipLaunchKernelGGL(fwd_kernel, dim3(grid), dim3(NTHREADS), LDS_BYTES, stream, a);
#ifdef PROBE_REPEAT
        if (p == PROBE_REPEAT) { (void)hipMemsetAsync((char*)d_ws + WS_CTL, 0, CTL_ZERO_BYTES, stream);
#ifdef PROBE_QMASK
            a.qmask = PROBE_QMASK;
#endif
            hipLaunchKernelGGL(fwd_kernel, dim3(grid), dim3(NTHREADS), LDS_BYTES, stream, a); }
#endif
    }
#endif
}
```

```cpp
#include <hip/hip_runtime.h>
#include <hip/hip_cooperative_groups.h>
#include <cstdio>
#include <cstdint>
#include <cmath>
namespace cg = cooperative_groups;
constexpr int DM = 1024, MP = 16384, MS = 512, MT = MP + MS, SEQ = 4096, NH = 8, HD = 64, DA = 512, DC = 512, CW = 31, DFF = 2816, DIN = 4616, PAST = 4096, DB = 16, DS = 32;
constexpr int NIN = 4608, NGU = 2 * DFF;
constexpr size_t OFF_Y = 0, OFF_KP = (size_t)MT * DM, OFF_VP = OFF_KP + (size_t)MP * DA, OFF_LFP = OFF_VP + (size_t)MP * DA, OFF_CVP = OFF_LFP + (size_t)MP * NH,
                 OFF_KS = OFF_CVP + (size_t)4 * 30 * DC, OFF_VS = OFF_KS + (size_t)MS * DA, OFF_LFS = OFF_VS + (size_t)MS * DA, OFF_CVS = OFF_LFS + (size_t)MS * NH, OUT_TOTAL = OFF_CVS + (size_t)DB * 30 * DC;
static_assert(OUT_TOTAL == 35045376, "output size");
constexpr float LOG2E = 1.4426950408889634f;
constexpr float QSCALE = 0.125f * LOG2E;
#define N_LAUNCHES 1
namespace pg8 {
#define PG8_LAS __attribute__((address_space(3)))
typedef unsigned short bf16_t;
typedef short bf16x8 __attribute__((ext_vector_type(8)));
typedef float f32x4 __attribute__((ext_vector_type(4)));
typedef unsigned u32x4 __attribute__((ext_vector_type(4)));
constexpr int BM = 256, BK = 64, HALF = 128, HTB = HALF * BK * 2  , STAGE_BYTES = 8 * HTB, NXCD = 8, WGM = 8;

__host__ __device__ __forceinline__ int lds_byte(int r, int c) { const int st = (r >> 4) * 2 + (c >> 5), rr = r & 15, cc = c & 31, ob = rr * 64 + cc * 2; return st * 1024 + (ob ^ (((ob >> 9) & 1) << 5)); }
__host__ __device__ __forceinline__ void stage_rc(int b, int& R, int& C) { const int st = b / 1024, sb = b % 1024, swz = sb ^ (((sb >> 9) & 1) << 5); R = (st >> 1) * 16 + swz / 64; C = (st & 1) * 32 + (swz % 64) / 2; }
__host__ __device__ __forceinline__ int perm32(int rho) { const int n = rho >> 4, i = rho & 15; return 8 * (i >> 2) + 4 * n + (i & 3); }

struct Unit { int pm, pn; };
struct Gemm { const bf16_t* A; const bf16_t* Bt; int M, N, K; };

struct StaticOrder {
    int nM, nN, nwg, G, c;
    __host__ __device__ void init(int M, int N, int G_, int c_) { nM = M / BM; nN = N / BM; nwg = nM * nN; G = G_; c = c_; }
    __host__ __device__ bool next(int i, Unit& u) const {
        const long L = (long)i * G + c; if (L >= nwg) return false;
        int wgid = (int)L; { const int q = nwg / NXCD, r = nwg % NXCD, xcd = wgid % NXCD, off = wgid / NXCD; wgid = (xcd < r ? xcd * (q + 1) : r * (q + 1) + (xcd - r) * q) + off; }
        const int nig = WGM * nN, gid = wgid / nig, fm = gid * WGM, gsz = (nM - fm) < WGM ? (nM - fm) : WGM;
        u.pm = fm + ((wgid % nig) % gsz); u.pn = (wgid % nig) / gsz; return true;
    }
    __device__ __forceinline__ void a_ready(const Unit&) const {}
    __device__ __forceinline__ void done(const Unit&) const {}
};

__device__ __forceinline__ unsigned cvt_pk_bf16(float lo, float hi) { unsigned r; asm volatile("v_cvt_pk_bf16_f32 %0, %1, %2" : "=v"(r) : "v"(lo), "v"(hi)); return r; }
typedef float f32x2 __attribute__((ext_vector_type(2)));
template <class Epi, class Sched, bool ALIGN_EPI = false, bool SP2 = false, bool MIDHOOK = false>
__device__ __forceinline__ void gemm_phase(PG8_LAS unsigned char* lds, const Gemm g, const Sched& S, const Epi& E) {
    const int tid = threadIdx.x, wid = __builtin_amdgcn_readfirstlane(tid >> 6), lane = tid & 63, wr = wid >> 2, wc = wid & 3, fr = lane & 15, fq = lane >> 4;
    const int K = g.K, nt = K / BK;
    unsigned voffA[2], voffB[2];
#pragma unroll
    for (int i = 0; i < 2; ++i) { int R, C; stage_rc(tid * 16 + i * 8192, R, C); const int Rb = Epi::PERM ? ((R & ~31) + perm32(R & 31)) : R;
        voffA[i] = (unsigned)(R * K + C) * 2u; voffB[i] = (unsigned)(Rb * K + C) * 2u; }
    const size_t kstep = (size_t)(BK * 2);
    const size_t hstep = (size_t)HALF * K * 2;
    const size_t tstep = 2 * hstep;
    const unsigned ldsw = (unsigned)wid * 1024u;
    const int aoff = lds_byte(wr * 64 + fr, fq * 8), boff = lds_byte(wc * 32 + fr, fq * 8);
#define PG8_SA(b, h) (((b) * 2 + (h)) * HTB)
#define PG8_SB(b, h) ((4 + (b) * 2 + (h)) * HTB)
#define PG8_STAGE(bufoff, gbase, voff) do { _Pragma("unroll") for (int _i = 0; _i < 2; ++_i) \
        __builtin_amdgcn_global_load_lds((const unsigned*)((const char*)(gbase) + (voff)[_i]), (PG8_LAS unsigned*)(lds + (bufoff) + ldsw + _i * 8192), 16, 0, 0); } while (0)
#define PG8_LDA(dst, b, h) do { _Pragma("unroll") for (int m = 0; m < 4; ++m) _Pragma("unroll") for (int k = 0; k < 2; ++k) dst[m][k] = *(const PG8_LAS bf16x8*)(lds + PG8_SA(b, h) + aoff + m * 2048 + k * 1024); } while (0)
#define PG8_LDB(dst, b, h) do { _Pragma("unroll") for (int n = 0; n < 2; ++n) _Pragma("unroll") for (int k = 0; k < 2; ++k) dst[n][k] = *(const PG8_LAS bf16x8*)(lds + PG8_SB(b, h) + boff + n * 2048 + k * 1024); } while (0)
#define PG8_MMA(ai, bj, At, Bt) do { __builtin_amdgcn_s_setprio(1); _Pragma("unroll") for (int m = 0; m < 4; ++m) _Pragma("unroll") for (int n = 0; n < 2; ++n) _Pragma("unroll") for (int k = 0; k < 2; ++k) \
        acc[ai][bj][m][n] = __builtin_amdgcn_mfma_f32_16x16x32_bf16(Bt[n][k], At[m][k], acc[ai][bj][m][n], 0, 0, 0); __builtin_amdgcn_s_setprio(0); } while (0)
#define PG8_WAIT_V(n) asm volatile("s_waitcnt vmcnt(" #n ")" ::: "memory")
#define PG8_WAIT_L(n) asm volatile("s_waitcnt lgkmcnt(" #n ")" ::: "memory")
#define PG8_BAR __builtin_amdgcn_s_barrier()
#define PG8_SCHED __builtin_amdgcn_sched_barrier(0)
    Unit cur, nxt; int ui = 0;
    if (!S.next(0, cur)) return;
    f32x4 acc[2][2][4][2];
#pragma unroll
    for (int a = 0; a < 2; ++a)
#pragma unroll
        for (int b = 0; b < 2; ++b)
#pragma unroll
            for (int m = 0; m < 4; ++m)
#pragma unroll
                for (int n = 0; n < 2; ++n) acc[a][b][m][n] = (f32x4){0.f, 0.f, 0.f, 0.f};
    bf16x8 At[4][2], B0[2][2], B1[2][2];
    const char* cA = (const char*)g.A + (size_t)cur.pm * tstep; const char* cB = (const char*)g.Bt + (size_t)cur.pn * tstep;
    S.a_ready(cur);
    if constexpr (SP2) {
        PG8_STAGE(PG8_SB(0, 0), cB, voffB); PG8_STAGE(PG8_SB(0, 1), cB + hstep, voffB); PG8_STAGE(PG8_SA(0, 0), cA, voffA); PG8_STAGE(PG8_SA(0, 1), cA + hstep, voffA);
        if (wr == 1) PG8_BAR;
        PG8_WAIT_V(2); PG8_BAR;
        PG8_STAGE(PG8_SB(1, 0), cB + kstep, voffB); PG8_STAGE(PG8_SA(1, 0), cA + kstep, voffA); PG8_STAGE(PG8_SB(1, 1), cB + hstep + kstep, voffB);
        PG8_WAIT_V(6); PG8_BAR;
    } else {
        PG8_STAGE(PG8_SB(0, 0), cB, voffB); PG8_STAGE(PG8_SA(0, 0), cA, voffA); PG8_STAGE(PG8_SB(0, 1), cB + hstep, voffB); PG8_STAGE(PG8_SA(0, 1), cA + hstep, voffA);
        if (wr == 1) PG8_BAR;
        PG8_WAIT_V(4); PG8_BAR;
        PG8_STAGE(PG8_SB(1, 0), cB + kstep, voffB); PG8_STAGE(PG8_SA(1, 0), cA + kstep, voffA); PG8_STAGE(PG8_SB(1, 1), cB + hstep + kstep, voffB);
        PG8_WAIT_V(6); PG8_BAR;
    }
    for (;;) {
        const bool has_next = S.next(ui + 1, nxt);
        const char* nA = has_next ? (const char*)g.A + (size_t)nxt.pm * tstep : cA; const char* nB = has_next ? (const char*)g.Bt + (size_t)nxt.pn * tstep : cB;
        for (int t = 0; t < nt; t += 2) {
            if constexpr (MIDHOOK) { if (t == nt / 2) E.mid(acc, cur, wr, wc, fr, fq); }
            const bool last = (t == nt - 2);
            const char* a1 = cA + (size_t)(t + 1) * kstep;
            const char* a2 = last ? nA : cA + (size_t)(t + 2) * kstep; const char* b2 = last ? nB : cB + (size_t)(t + 2) * kstep;
            const char* a3 = a2 + kstep; const char* b3 = b2 + kstep;
            if (last && has_next) S.a_ready(nxt);
            if constexpr (SP2) {
            PG8_LDB(B0, 0, 0); PG8_LDB(B1, 0, 1); PG8_SCHED; PG8_LDA(At, 0, 0); PG8_STAGE(PG8_SA(1, 1), a1 + hstep, voffA);
            PG8_WAIT_V(8); PG8_WAIT_L(0); PG8_BAR; PG8_MMA(0, 0, At, B0); PG8_MMA(0, 1, At, B1); PG8_BAR; PG8_SCHED;
            PG8_LDA(At, 0, 1); PG8_STAGE(PG8_SB(0, 0), b2, voffB); PG8_STAGE(PG8_SB(0, 1), b2 + hstep, voffB); PG8_STAGE(PG8_SA(0, 0), a2, voffA);
            PG8_WAIT_V(8); PG8_WAIT_L(0); PG8_BAR; PG8_MMA(1, 0, At, B0); PG8_MMA(1, 1, At, B1); PG8_BAR; PG8_SCHED;
            PG8_LDB(B0, 1, 0); PG8_LDB(B1, 1, 1); PG8_SCHED; PG8_LDA(At, 1, 0); PG8_STAGE(PG8_SA(0, 1), a2 + hstep, voffA);
            PG8_WAIT_V(8); PG8_WAIT_L(0); PG8_BAR; PG8_MMA(0, 0, At, B0); PG8_MMA(0, 1, At, B1); PG8_BAR; PG8_SCHED;
            PG8_LDA(At, 1, 1); PG8_STAGE(PG8_SB(1, 0), b3, voffB); PG8_STAGE(PG8_SB(1, 1), b3 + hstep, voffB); PG8_STAGE(PG8_SA(1, 0), a3, voffA);
            PG8_WAIT_V(8); PG8_WAIT_L(0); PG8_BAR; PG8_MMA(1, 0, At, B0); PG8_MMA(1, 1, At, B1); PG8_BAR; PG8_SCHED;
            } else {
            PG8_LDB(B0, 0, 0); PG8_SCHED; PG8_LDA(At, 0, 0); PG8_STAGE(PG8_SA(1, 1), a1 + hstep, voffA);
            PG8_WAIT_L(8); PG8_BAR; PG8_WAIT_L(0); PG8_MMA(0, 0, At, B0); PG8_BAR; PG8_SCHED;
            PG8_LDB(B1, 0, 1); PG8_STAGE(PG8_SB(0, 0), b2, voffB);
            PG8_BAR; PG8_WAIT_L(0); PG8_MMA(0, 1, At, B1); PG8_BAR;
            PG8_LDA(At, 0, 1); PG8_STAGE(PG8_SA(0, 0), a2, voffA);
            PG8_BAR; PG8_WAIT_L(0); PG8_MMA(1, 0, At, B0); PG8_BAR; PG8_SCHED;
            PG8_STAGE(PG8_SB(0, 1), b2 + hstep, voffB);
            PG8_WAIT_V(6); PG8_BAR; PG8_MMA(1, 1, At, B1); PG8_BAR;
            PG8_LDB(B0, 1, 0); PG8_SCHED; PG8_LDA(At, 1, 0); PG8_STAGE(PG8_SA(0, 1), a2 + hstep, voffA);
            PG8_WAIT_L(8); PG8_BAR; PG8_WAIT_L(0); PG8_MMA(0, 0, At, B0); PG8_BAR; PG8_SCHED;
            PG8_LDB(B1, 1, 1); PG8_STAGE(PG8_SB(1, 0), b3, voffB);
            PG8_BAR; PG8_WAIT_L(0); PG8_MMA(0, 1, At, B1); PG8_BAR;
            PG8_LDA(At, 1, 1); PG8_STAGE(PG8_SA(1, 0), a3, voffA);
            PG8_BAR; PG8_WAIT_L(0); PG8_MMA(1, 0, At, B0); PG8_BAR; PG8_SCHED;
            PG8_STAGE(PG8_SB(1, 1), b3 + hstep, voffB);
            PG8_WAIT_V(6); PG8_BAR; PG8_MMA(1, 1, At, B1); PG8_BAR;
            }
        }
        if constexpr (ALIGN_EPI) { if (wr == 0) PG8_BAR; }
        if constexpr (!Epi::AFTER_DRAIN) { E(acc, cur, wr, wc, fr, fq); S.done(cur); }
        if (!has_next) break;
#pragma unroll
        for (int a = 0; a < 2; ++a)
#pragma unroll
            for (int b = 0; b < 2; ++b)
#pragma unroll
                for (int m = 0; m < 4; ++m)
#pragma unroll
                    for (int n = 0; n < 2; ++n) acc[a][b][m][n] = (f32x4){0.f, 0.f, 0.f, 0.f};
        cur = nxt; cA = nA; cB = nB; ++ui;
        if constexpr (ALIGN_EPI) { if (wr == 1) PG8_BAR; }
    }
    PG8_WAIT_V(0);
    if constexpr (!ALIGN_EPI) { if (wr == 0) PG8_BAR; }
    PG8_BAR;
    if constexpr (Epi::AFTER_DRAIN) { E.fused(acc, cur, wr, wc, fr, fq, lds, wid, lane); S.done(cur); }
#undef PG8_SA
#undef PG8_SB
#undef PG8_STAGE
#undef PG8_LDA
#undef PG8_LDB
#undef PG8_MMA
#undef PG8_WAIT_V
#undef PG8_WAIT_L
#undef PG8_BAR
#undef PG8_SCHED
}
__device__ __forceinline__ float bf2f(unsigned short b) { return __uint_as_float((unsigned)b << 16); }
__device__ __forceinline__ float sigm(float x) { return __builtin_amdgcn_rcpf(1.0f + __expf(-x)); }
__device__ __forceinline__ u32x4 pack8(const f32x4 a, const f32x4 b) { u32x4 w; w.x = cvt_pk_bf16(a[0], a[1]); w.y = cvt_pk_bf16(a[2], a[3]); w.z = cvt_pk_bf16(b[0], b[1]); w.w = cvt_pk_bf16(b[2], b[3]); return w; }
__device__ __forceinline__ void unpack8(const u32x4 w, f32x4& a, f32x4& b) {
    a[0] = __uint_as_float(w.x << 16); a[1] = __uint_as_float(w.x & 0xffff0000u); a[2] = __uint_as_float(w.y << 16); a[3] = __uint_as_float(w.y & 0xffff0000u);
    b[0] = __uint_as_float(w.z << 16); b[1] = __uint_as_float(w.z & 0xffff0000u); b[2] = __uint_as_float(w.w << 16); b[3] = __uint_as_float(w.w & 0xffff0000u); }
__device__ __forceinline__ f32x4 sigm4(f32x4 v) { f32x4 r; r[0] = sigm(v[0]); r[1] = sigm(v[1]); r[2] = sigm(v[2]); r[3] = sigm(v[3]); return r; }

struct EpiIn {
    static constexpr bool PERM = true, AFTER_DRAIN = false;
    const float* rstd; bf16_t *CU, *Q, *K, *V, *GC, *GA; float* out;
    __device__ __forceinline__ void operator()(const f32x4 (&acc)[2][2][4][2], const Unit& u, int wr, int wc, int fr, int fq) const {
        const int pn = u.pn, row0 = u.pm * BM + wr * 64 + fr, cl = wc * 32 + 8 * fq;
#pragma unroll
        for (int ai = 0; ai < 2; ++ai)
#pragma unroll
            for (int m = 0; m < 4; ++m) {
                const int row = row0 + ai * HALF + m * 16; const float rs = rstd[row];
                if (pn < 4) {
                    const f32x4 a0 = acc[ai][0][m][0] * rs, a1 = acc[ai][0][m][1] * rs, g0 = acc[ai][1][m][0] * rs, g1 = acc[ai][1][m][1] * rs;
                    const f32x4 c0 = a0 * sigm4(g0), c1 = a1 * sigm4(g1); const int ch = 128 * pn + cl;
                    *(u32x4*)(CU + (size_t)row * DC + ch) = pack8(c0, c1);
                    float* hd = nullptr;
                    if (row < MP) { const int t = row & (SEQ - 1); if (t >= SEQ - 30) hd = out + OFF_CVP + ((size_t)(row >> 12) * 30 + (t - (SEQ - 30))) * DC + ch; }
                    else { const int sr = row - MP, t = sr & 31; if (t >= 2) hd = out + OFF_CVS + ((size_t)(sr >> 5) * 30 + (t - 2)) * DC + ch; }
                    if (hd) { *(f32x4*)hd = c0; *(f32x4*)(hd + 4) = c1; }
                } else if (pn < 10) {
                    const int which = (pn - 4) >> 1;
#pragma unroll
                    for (int bj = 0; bj < 2; ++bj) {
                        const int col = ((pn - 4) & 1) * 256 + bj * HALF + cl; const f32x4 v0 = acc[ai][bj][m][0] * rs, v1 = acc[ai][bj][m][1] * rs;
                        if (which == 0) { *(u32x4*)(Q + (size_t)row * DA + col) = pack8(v0 * QSCALE, v1 * QSCALE); }
                        else { bf16_t* B = which == 1 ? K : V; *(u32x4*)(B + (size_t)row * DA + col) = pack8(v0, v1);
                            float* d = (row < MP) ? out + (which == 1 ? OFF_KP : OFF_VP) + (size_t)row * DA + col : out + (which == 1 ? OFF_KS : OFF_VS) + (size_t)(row - MP) * DA + col;
                            *(f32x4*)d = v0; *(f32x4*)(d + 4) = v1; }
                    }
                } else {
                    const f32x4 c0 = acc[ai][0][m][0] * rs, c1 = acc[ai][0][m][1] * rs, t0 = acc[ai][1][m][0] * rs, t1 = acc[ai][1][m][1] * rs;
                    f32x4 e0, e1;
#pragma unroll
                    for (int j = 0; j < 4; ++j) { e0[j] = fminf(__expf(-t0[j]), 1e30f); e1[j] = fminf(__expf(-t1[j]), 1e30f); }
                    f32x4 s0, s1;
#pragma unroll
                    for (int j = 0; j < 4; ++j) { s0[j] = __builtin_amdgcn_rcpf(1.0f + e0[j]); s1[j] = __builtin_amdgcn_rcpf(1.0f + e1[j]); }
                    const size_t o = (size_t)row * DM + 128 * (pn - 10) + cl;
                    *(u32x4*)(GC + o) = pack8(sigm4(c0) * (e0 + 1.0f), sigm4(c1) * (e1 + 1.0f));
                    *(u32x4*)(GA + o) = pack8(s0, s1);
                }
            }
    }
};
struct EpiMixF {
    static constexpr bool PERM = true, AFTER_DRAIN = false;
    const bf16_t *GC, *GA; bf16_t* MIX;
    __device__ __forceinline__ void mid(f32x4 (&acc)[2][2][4][2], const Unit& u, int wr, int wc, int fr, int fq) const {
        asm volatile("" : "+v"(fr));
        const int row0 = u.pm * BM + wr * 64 + fr, col0 = u.pn * BM + wc * 32 + 8 * fq;
#pragma unroll
        for (int ai = 0; ai < 2; ++ai)
#pragma unroll
            for (int m = 0; m < 4; ++m) {
                const size_t ro = (size_t)(row0 + ai * HALF + m * 16) * DM + col0;
#pragma unroll
                for (int bj = 0; bj < 2; ++bj) {
                    f32x4 c0, c1; unpack8(*(const u32x4*)(GC + ro + bj * HALF), c0, c1);
                    acc[ai][bj][m][0] *= c0; acc[ai][bj][m][1] *= c1; }
                asm volatile("" ::: "memory");
            }
    }
    __device__ __forceinline__ void operator()(const f32x4 (&acc)[2][2][4][2], const Unit& u, int wr, int wc, int fr, int fq) const {
        const int row0 = u.pm * BM + wr * 64 + fr, col0 = u.pn * BM + wc * 32 + 8 * fq;
#pragma unroll
        for (int ai = 0; ai < 2; ++ai)
#pragma unroll
            for (int m = 0; m < 4; ++m) {
                const size_t ro = (size_t)(row0 + ai * HALF + m * 16) * DM + col0;
#pragma unroll
                for (int bj = 0; bj < 2; ++bj) {
                    f32x4 g0, g1; unpack8(*(const u32x4*)(GA + ro + bj * HALF), g0, g1);
                    *(u32x4*)(MIX + ro + bj * HALF) = pack8(acc[ai][bj][m][0] * g0, acc[ai][bj][m][1] * g1); }
            }
    }
};
struct EpiOut {
    static constexpr bool PERM = true, AFTER_DRAIN = false;
    const float *xp, *xs; bf16_t* HB; float* SS;
    __device__ __forceinline__ void operator()(const f32x4 (&acc)[2][2][4][2], const Unit& u, int wr, int wc, int fr, int fq) const {
        const int row0 = u.pm * BM + wr * 64 + fr, col0 = u.pn * BM + wc * 32 + 8 * fq;
#pragma unroll
        for (int ai = 0; ai < 2; ++ai)
#pragma unroll
            for (int m = 0; m < 4; ++m) {
                const int row = row0 + ai * HALF + m * 16; const size_t ro = (size_t)row * DM + col0;
                const float* xr = (row < MP) ? xp + ro : xs + (ro - (size_t)MP * DM);
                float ss = 0.f;
#pragma unroll
                for (int bj = 0; bj < 2; ++bj) {
                    const f32x4 h0 = acc[ai][bj][m][0] + *(const f32x4*)(xr + bj * HALF), h1 = acc[ai][bj][m][1] + *(const f32x4*)(xr + bj * HALF + 4);
                    *(u32x4*)(HB + ro + bj * HALF) = pack8(h0, h1);
                    ss += (h0[0] * h0[0] + h0[1] * h0[1]) + (h0[2] * h0[2] + h0[3] * h0[3]) + (h1[0] * h1[0] + h1[1] * h1[1]) + (h1[2] * h1[2] + h1[3] * h1[3]); }
                ss += __shfl_xor(ss, 16); ss += __shfl_xor(ss, 32);
                if (fq == 0) SS[(size_t)row * 16 + u.pn * 4 + wc] = ss;
            }
    }
};
struct EpiGU {
    static constexpr bool PERM = true, AFTER_DRAIN = false;
    const float* SS; bf16_t* ACT;
    __device__ __forceinline__ void operator()(const f32x4 (&acc)[2][2][4][2], const Unit& u, int wr, int wc, int fr, int fq) const {
        const int row0 = u.pm * BM + wr * 64 + fr, ch = u.pn * HALF + wc * 32 + 8 * fq;
#pragma unroll
        for (int ai = 0; ai < 2; ++ai)
#pragma unroll
            for (int m = 0; m < 4; ++m) {
                const int row = row0 + ai * HALF + m * 16; const f32x4* sp = (const f32x4*)(SS + (size_t)row * 16);
                const f32x4 s0 = sp[0], s1 = sp[1], s2 = sp[2], s3 = sp[3];
                const float tot = ((s0[0] + s0[1]) + (s0[2] + s0[3])) + ((s1[0] + s1[1]) + (s1[2] + s1[3])) + ((s2[0] + s2[1]) + (s2[2] + s2[3])) + ((s3[0] + s3[1]) + (s3[2] + s3[3]));
                const float rs = 1.0f / sqrtf(tot * (1.0f / DM) + 1e-6f);
                const f32x4 g0 = acc[ai][0][m][0] * rs, g1 = acc[ai][0][m][1] * rs, u0 = acc[ai][1][m][0] * rs, u1 = acc[ai][1][m][1] * rs;
                *(u32x4*)(ACT + (size_t)row * DFF + ch) = pack8(g0 * sigm4(g0) * u0, g1 * sigm4(g1) * u1);
            }
    }
};
struct EpiDown {
    static constexpr bool PERM = true, AFTER_DRAIN = false;
    const bf16_t* HB; float* Y; float* SS;
    __device__ __forceinline__ void operator()(const f32x4 (&acc)[2][2][4][2], const Unit& u, int wr, int wc, int fr, int fq) const {
        const int row0 = u.pm * BM + wr * 64 + fr, col0 = u.pn * BM + wc * 32 + 8 * fq;
#pragma unroll
        for (int ai = 0; ai < 2; ++ai)
#pragma unroll
            for (int m = 0; m < 4; ++m) {
                const int row = row0 + ai * HALF + m * 16; const size_t ro = (size_t)row * DM + col0;
                float ss = 0.f;
#pragma unroll
                for (int bj = 0; bj < 2; ++bj) {
                    f32x4 r0, r1; unpack8(*(const u32x4*)(HB + ro + bj * HALF), r0, r1);
                    const f32x4 h0 = acc[ai][bj][m][0] + r0, h1 = acc[ai][bj][m][1] + r1;
                    *(f32x4*)(Y + ro + bj * HALF) = h0; *(f32x4*)(Y + ro + bj * HALF + 4) = h1;
                    ss += (h0[0] * h0[0] + h0[1] * h0[1]) + (h0[2] * h0[2] + h0[3] * h0[3]) + (h1[0] * h1[0] + h1[1] * h1[1]) + (h1[2] * h1[2] + h1[3] * h1[3]); }
                ss += __shfl_xor(ss, 16); ss += __shfl_xor(ss, 32);
                if (fq == 0) SS[(size_t)row * 16 + u.pn * 4 + wc] = ss;
            }
    }
};
}
#define LAS __attribute__((address_space(3)))
typedef unsigned short bf16;
typedef LAS unsigned char* ldsp;
typedef __attribute__((ext_vector_type(8))) short bf16x8;
typedef __attribute__((ext_vector_type(4))) short s16x4;
typedef __attribute__((ext_vector_type(16))) float f32x16;
typedef __attribute__((ext_vector_type(4))) float f32x4;
typedef __attribute__((ext_vector_type(4))) unsigned u32x4;
typedef __attribute__((ext_vector_type(2))) unsigned u32x2;
constexpr int NWAVES = 8, NTHREADS = 512;
constexpr int LDS_BYTES = 147456;
constexpr int LDS_QW = 147200;
constexpr int LDS_XB = 147216;
constexpr size_t CTL_BAR_BYTE = 16384, CTL_ZERO_BYTES = 65536;

__device__ __forceinline__ float wave_sum(float v) {
#pragma unroll
    for (int o = 1; o < 64; o <<= 1) v += __shfl_xor(v, o);
    return v;
}
__device__ __forceinline__ float bf2f(unsigned short b) { return __uint_as_float((unsigned)b << 16); }
__device__ __forceinline__ unsigned cvtpk(float lo, float hi) { return pg8::cvt_pk_bf16(lo, hi); }
#define BLOCK_BAR() asm volatile("s_waitcnt vmcnt(0) lgkmcnt(0)\n\ts_barrier" ::: "memory")
#define XB_TMO      128
#define XB_XCNT(j)  (256  + 64 * (j))
#define XB_XSUB(j)  (1280 + 64 * (j))
#define XB_XGEN(j)  (2304 + 64 * (j))
#define XB_TOP      3328
#define XB_TOPGEN   3392
#define XCD_BAR_WORDS 3456
#define XB_SPIN_CAP (1u << 18)

__device__ __forceinline__ unsigned xb_ld(unsigned* p)              { return __hip_atomic_load(p, __ATOMIC_RELAXED, __HIP_MEMORY_SCOPE_AGENT); }
__device__ __forceinline__ unsigned xb_add(unsigned* p, unsigned v) { return __hip_atomic_fetch_add(p, v, __ATOMIC_RELAXED, __HIP_MEMORY_SCOPE_AGENT); }
__device__ __forceinline__ unsigned xb_xcc_id() { return (unsigned)__builtin_amdgcn_s_getreg((3 << 11) | 20) & 0xFu; }
#define XB_SPIN(cond, bar) do { unsigned _sp = 0; while (cond) { __builtin_amdgcn_s_sleep(1); \
    if ((++_sp & 255u) == 0u) { if (xb_ld(&(bar)[XB_TMO])) break; if (_sp > XB_SPIN_CAP) { atomicAdd(&(bar)[XB_TMO], 1u); break; } } } } while (0)

struct XcdBarrier {
    unsigned* bar; unsigned x;
    volatile LAS unsigned* st;
};

__device__ __forceinline__ XcdBarrier xcd_barrier_post(unsigned* bar, volatile LAS unsigned* st) {
    XcdBarrier b; b.bar = bar; b.x = xb_xcc_id(); b.st = st;
    if (threadIdx.x == 0) (void)xb_add(&bar[XB_XCNT(b.x)], 1u);
    return b;
}
__device__ __forceinline__ void xcd_barrier_complete(unsigned* bar, unsigned x, unsigned& nloc, unsigned& nx) {
    const unsigned G = gridDim.x * gridDim.y * gridDim.z;
    unsigned sum, cnt, mine, sp = 0u;
    for (;;) {
        sum = 0u; cnt = 0u; mine = 0u;
#pragma unroll
        for (unsigned j = 0; j < 16; ++j) { const unsigned c = xb_ld(&bar[XB_XCNT(j)]); sum += c; cnt += (c > 0u) ? 1u : 0u; mine = (j == x) ? c : mine; }
        if (sum == G) break;
        __builtin_amdgcn_s_sleep(1);
        if ((++sp & 255u) == 0u) { if (xb_ld(&bar[XB_TMO])) break; if (sp > XB_SPIN_CAP) { atomicAdd(&bar[XB_TMO], 1u); break; } }
    }
    nloc = mine > 0u ? mine : 1u; nx = cnt > 0u ? cnt : 1u;
}

__device__ __forceinline__ void xcd_barrier(const XcdBarrier& b) {
    asm volatile("s_waitcnt vmcnt(0)" ::: "memory");
    __syncthreads();
    if (threadIdx.x == 0) {
        unsigned* bar = b.bar;
        __builtin_amdgcn_s_waitcnt(0);
        unsigned nloc = b.st[0], nx = b.st[1];
        if (nloc == 0u) { xcd_barrier_complete(bar, b.x, nloc, nx); b.st[0] = nloc; b.st[1] = nx; }
        const unsigned old = xb_add(&bar[XB_XSUB(b.x)], 1u);
        const unsigned gen = old / nloc;
        if (old + 1u == (gen + 1u) * nloc) {
            __builtin_amdgcn_fence(__ATOMIC_RELEASE, "agent");
            asm volatile("s_waitcnt vmcnt(0)" ::: "memory");
            const unsigned og = xb_add(&bar[XB_TOP], 1u);
            const unsigned tg = og / nx;
            if (og + 1u == (tg + 1u) * nx) xb_add(&bar[XB_TOPGEN], 1u);
            else XB_SPIN(xb_ld(&bar[XB_TOPGEN]) == tg, bar);
            __builtin_amdgcn_fence(__ATOMIC_ACQUIRE, "agent");
            xb_add(&bar[XB_XGEN(b.x)], 1u);
            asm volatile("s_waitcnt vmcnt(0)" ::: "memory");
        } else {
            XB_SPIN(xb_ld(&bar[XB_XGEN(b.x)]) == gen, bar);
            __builtin_amdgcn_fence(__ATOMIC_ACQUIRE, "agent");
            asm volatile("s_waitcnt vmcnt(0)" ::: "memory");
        }
    }
    __syncthreads();
}


constexpr size_t MiB = 1u << 20;
constexpr size_t WS_CTL = 0, WS_WIN = 1 * MiB, WS_WMIX = 10 * MiB  , WS_WOUT = 12 * MiB, WS_WGU = 14 * MiB, WS_WDN = 25 * MiB, WS_RSTD = 31 * MiB,
                 WS_SS = 32 * MiB, WS_SS2 = 34 * MiB, WS_CBP = 36 * MiB, WS_CBS = 37 * MiB, WS_XB = 40 * MiB, WS_CU = 73 * MiB, WS_Q = 90 * MiB, WS_K = 107 * MiB, WS_V = 124 * MiB,
                 WS_GC = 141 * MiB, WS_GA = 174 * MiB, WS_CSAO = 207 * MiB  , WS_MIX = 241 * MiB, WS_H = 274 * MiB, WS_HB = 340 * MiB, WS_ACT = 373 * MiB, WS_END = 464 * MiB;
constexpr int CBS_PITCH = 4160;

struct Args { const float* in[21]; float* out; unsigned char* ws; int ph_lo, ph_hi, qmask, pad; };

__device__ __forceinline__ void transpose_item(const float* W, int N, int K, int src_col0, int k0, bf16* WT, int dst_row0, const float* gk, LAS float* scr, int lane, int dko = 0) {
    float tmp[32];
    const float* wp = W + (size_t)(k0 + (lane >> 5)) * N + src_col0 + (lane & 31);
#pragma unroll
    for (int i = 0; i < 32; ++i) tmp[i] = wp[(size_t)(2 * i) * N];
    const int c = lane & 7;
    f32x4 g0 = {1.f, 1.f, 1.f, 1.f}, g1 = g0;
    if (gk) { g0 = *(const f32x4*)(gk + k0 + 8 * c); g1 = *(const f32x4*)(gk + k0 + 8 * c + 4); }
#pragma unroll
    for (int i = 0; i < 32; ++i) scr[(2 * i + (lane >> 5)) * 33 + (lane & 31)] = tmp[i];
    asm volatile("s_waitcnt lgkmcnt(0)" ::: "memory");
#pragma unroll
    for (int j = 0; j < 4; ++j) { const int n = (lane >> 3) + 8 * j; const LAS float* s = scr + (8 * c) * 33 + n;
        u32x4 o; o.x = cvtpk(s[0 * 33] * g0[0], s[1 * 33] * g0[1]); o.y = cvtpk(s[2 * 33] * g0[2], s[3 * 33] * g0[3]); o.z = cvtpk(s[4 * 33] * g1[0], s[5 * 33] * g1[1]); o.w = cvtpk(s[6 * 33] * g1[2], s[7 * 33] * g1[3]);
        *(u32x4*)(WT + (size_t)(dst_row0 + n) * K + dko + k0 + 8 * c) = o; }
    asm volatile("s_waitcnt lgkmcnt(0)" ::: "memory");
}

__device__ __forceinline__ void p0_prologue(const Args& a, ldsp lds, int wave, int lane) {
    unsigned char* ws = a.ws;
    const int gw = blockIdx.x * NWAVES + wave, NGW = gridDim.x * NWAVES;
    if (blockIdx.x == 0 && threadIdx.x == 0) __hip_atomic_store((unsigned*)(ws + WS_CTL), 0u, __ATOMIC_RELAXED, __HIP_MEMORY_SCOPE_AGENT);
    LAS float* gwf = (LAS float*)lds;
    { const float* win = a.in[7]; const float* g = a.in[6];
      float tv[16], gv[16];
#pragma unroll
      for (int i = 0; i < 16; ++i) { const int e = threadIdx.x + NTHREADS * i, k = e >> 3, h = e & 7; tv[i] = win[(size_t)k * DIN + 2560 + h]; gv[i] = g[k]; }
#pragma unroll
      for (int i = 0; i < 16; ++i) { const int e = threadIdx.x + NTHREADS * i, k = e >> 3, h = e & 7; gwf[h * DM + k] = tv[i] * gv[i]; } }
    LAS float* scr = (LAS float*)(lds + 32768 + wave * 8448);
    constexpr int I_IN = (DM / 64) * (NIN / 32), I_PW = (DC / 64) * (DM / 32), I_AO = (DA / 64) * (DM / 32), I_OUT = (DM / 64) * (DM / 32), I_GU = (DM / 64) * (NGU / 32), I_DN = (DFF / 64) * (DM / 32);
    constexpr int NITEMS = I_IN + I_PW + I_AO + I_OUT + I_GU + I_DN;
    for (int it = gw; it < NITEMS; it += NGW) {
        int r = it;
        if (r < I_IN) { const int nblk = NIN / 32, kb = r / nblk, nb = r % nblk, n = 32 * nb; int src;
            if (n < 1024) { const int pn = n >> 8, rr = n & 255; src = rr < 128 ? 128 * pn + rr : 512 + 128 * pn + (rr - 128); } else if (n < 2560) src = n; else { const int pn = n >> 8, rr = n & 255, ch0 = 128 * (pn - 10); src = rr < 128 ? 2568 + ch0 + rr : 3592 + ch0 + (rr - 128); }
            transpose_item(a.in[7], DIN, DM, src, 64 * kb, (bf16*)(ws + WS_WIN), n, a.in[6], scr, lane); continue; } r -= I_IN;
        if (r < I_PW) { const int nblk = DM / 32, kb = r / nblk, nb = r % nblk; transpose_item(a.in[13], DM, DM, 32 * nb, 64 * kb, (bf16*)(ws + WS_WMIX), 32 * nb, nullptr, scr, lane, 0); continue; } r -= I_PW;
        if (r < I_AO) { const int nblk = DM / 32, kb = r / nblk, nb = r % nblk; transpose_item(a.in[14], DM, DM, 32 * nb, 64 * kb, (bf16*)(ws + WS_WMIX), 32 * nb, nullptr, scr, lane, DC); continue; } r -= I_AO;
        if (r < I_OUT) { const int nblk = DM / 32, kb = r / nblk, nb = r % nblk; transpose_item(a.in[15], DM, DM, 32 * nb, 64 * kb, (bf16*)(ws + WS_WOUT), 32 * nb, nullptr, scr, lane); continue; } r -= I_OUT;
        if (r < I_GU) { const int nblk = NGU / 32, kb = r / nblk, nb = r % nblk, n = 32 * nb, pn = n >> 8, rr = n & 255;
            const float* src = rr < 128 ? a.in[17] : a.in[18]; const int sc = rr < 128 ? 128 * pn + rr : 128 * pn + (rr - 128);
            transpose_item(src, DFF, DM, sc, 64 * kb, (bf16*)(ws + WS_WGU), n, a.in[16], scr, lane); continue; } r -= I_GU;
        { const int nblk = DM / 32, kb = r / nblk, nb = r % nblk; transpose_item(a.in[19], DM, DFF, 32 * nb, 64 * kb, (bf16*)(ws + WS_WDN), 32 * nb, nullptr, scr, lane); }
    }
    __syncthreads();
    float* rstd = (float*)(ws + WS_RSTD); bf16* XB = (bf16*)(ws + WS_XB); const float* bfv = a.in[8];
    for (int m0 = gw; m0 < MT; m0 += 2 * NGW) {
        f32x4 vv[2][4];
#pragma unroll
        for (int q = 0; q < 2; ++q) { const int m = m0 + q * NGW;
            if (m < MT) { const float* xrow = (m < MP) ? a.in[0] + (size_t)m * DM : a.in[1] + (size_t)(m - MP) * DM; const f32x4* xr = (const f32x4*)xrow + lane;
#pragma unroll
                for (int j = 0; j < 4; ++j) vv[q][j] = xr[64 * j]; } else {
#pragma unroll
                for (int j = 0; j < 4; ++j) vv[q][j] = (f32x4){0.f, 0.f, 0.f, 0.f}; } }
#pragma unroll
        for (int q = 0; q < 2; ++q) { const int m = m0 + q * NGW;
            if (m < MT) {
                f32x4 v[4]; float s = 0.f;
#pragma unroll
                for (int j = 0; j < 4; ++j) { v[j] = vv[q][j]; s += (v[j].x * v[j].x + v[j].y * v[j].y) + (v[j].z * v[j].z + v[j].w * v[j].w); }
                const float rs = 1.0f / sqrtf(wave_sum(s) * (1.0f / DM) + 1e-6f);
                unsigned long long* o8 = (unsigned long long*)(XB + (size_t)m * DM) + lane;
#pragma unroll
                for (int j = 0; j < 4; ++j) o8[64 * j] = (unsigned long long)cvtpk(v[j].x, v[j].y) | ((unsigned long long)cvtpk(v[j].z, v[j].w) << 32);
                float f[8];
#pragma unroll
                for (int h = 0; h < 8; ++h) { float acc = 0.f;
#pragma unroll
                    for (int j = 0; j < 4; ++j) { const f32x4 w = *(const LAS f32x4*)(gwf + h * DM + 4 * lane + 256 * j); acc += (v[j].x * w.x + v[j].y * w.y) + (v[j].z * w.z + v[j].w * w.w); }
                    f[h] = wave_sum(acc); }
                float fl = f[0];
#pragma unroll
                for (int h = 1; h < 8; ++h) fl = (lane == h) ? f[h] : fl;
                if (lane == 0) rstd[m] = rs;
                if (lane < 8) { const float z = fl * rs + bfv[lane]; const float lf = fminf(z, 0.f) - log1pf(expf(-fabsf(z)));
                    float* dst = (m < MP) ? a.out + OFF_LFP + (size_t)m * NH + lane : a.out + OFF_LFS + (size_t)(m - MP) * NH + lane; *dst = lf; }
            } }
    }
}

__device__ __forceinline__ void cumsum_phase(const Args& a, int wave, int lane) {
    const int gw = ((int)blockIdx.x - ((int)gridDim.x - 20)) * NWAVES + wave;
    if (gw < 0 || gw >= 160) return;
    unsigned char* ws = a.ws;
    const float* src; float* dst; const float* extra = nullptr;
    if (gw < 32) { const int b = gw >> 3, h = gw & 7; src = a.out + OFF_LFP + (size_t)b * SEQ * NH + h; dst = (float*)(ws + WS_CBP) + (size_t)gw * SEQ; }
    else { const int s = gw - 32, b = s >> 3, h = s & 7; src = a.in[4] + (size_t)b * PAST * NH + h; dst = (float*)(ws + WS_CBS) + (size_t)s * CBS_PITCH; extra = a.out + OFF_LFS + (size_t)b * DS * NH + h; }
    const float* p = src + (size_t)lane * 64 * NH;
    float v[64];
#pragma unroll
    for (int i = 0; i < 64; ++i) v[i] = p[i * NH];
    float tot = 0.f;
#pragma unroll
    for (int i = 0; i < 64; ++i) tot += v[i];
    float incl = tot;
#pragma unroll
    for (int o = 1; o < 64; o <<= 1) { const float t = __shfl_up(incl, o); if (lane >= o) incl += t; }
    float run = incl - tot;
#pragma unroll
    for (int i = 0; i < 64; ++i) { run += v[i]; dst[lane * 64 + i] = -run * LOG2E; }
    if (extra) {
        const float total = __shfl(incl, 63);
        float x = (lane < 32) ? extra[lane * NH] : 0.f; float ic = x;
#pragma unroll
        for (int o = 1; o < 64; o <<= 1) { const float t = __shfl_up(ic, o); if (lane >= o) ic += t; }
        dst[PAST + lane] = (lane < 32) ? -(total + ic) * LOG2E : 0.f;
    }
}

namespace att {
__device__ __forceinline__ int crow(int r, int hi) { return (r & 3) + 8 * (r >> 2) + 4 * hi; }
#define SBAR() __builtin_amdgcn_sched_barrier(0)
__device__ __forceinline__ void glds16(const void* gsrc, unsigned lds_dst) { unsigned keep;
    asm volatile("s_mov_b32 %0, m0\n\ts_mov_b32 m0, %2\n\ts_nop 0\n\tglobal_load_lds_dwordx4 %1, off\n\ts_mov_b32 m0, %0" : "=&s"(keep) : "v"(gsrc), "s"(lds_dst) : "memory"); }
__device__ __forceinline__ void glds4(const void* gsrc, unsigned lds_dst) { unsigned keep;
    asm volatile("s_mov_b32 %0, m0\n\ts_mov_b32 m0, %2\n\ts_nop 0\n\tglobal_load_lds_dword %1, off\n\ts_mov_b32 m0, %0" : "=&s"(keep) : "v"(gsrc), "s"(lds_dst) : "memory"); }
__device__ __forceinline__ void qkt(f32x16& p0, f32x16& p1, const LAS unsigned char* Kslot, const bf16x8* qr, int r32, int hi) {
    const LAS unsigned char* kb = Kslot + hi * 1024 + r32 * 16;
    f32x16 z = {};
#pragma unroll
    for (int d0 = 0; d0 < 4; ++d0) {
        const bf16x8 b0 = *(const LAS bf16x8*)(kb + d0 * 2048), b1 = *(const LAS bf16x8*)(kb + d0 * 2048 + 512);
        if (d0 == 0) { p0 = __builtin_amdgcn_mfma_f32_32x32x16_bf16(b0, qr[0], z, 0, 0, 0); p1 = __builtin_amdgcn_mfma_f32_32x32x16_bf16(b1, qr[0], z, 0, 0, 0); }
        else { p0 = __builtin_amdgcn_mfma_f32_32x32x16_bf16(b0, qr[d0], p0, 0, 0, 0); p1 = __builtin_amdgcn_mfma_f32_32x32x16_bf16(b1, qr[d0], p1, 0, 0, 0); } }
}
__device__ __forceinline__ void pv(f32x16* o, int vb, bf16x8 pa0, bf16x8 pa1, bf16x8 pa2, bf16x8 pa3) {
#pragma unroll
    for (int d0 = 0; d0 < 2; ++d0) { s16x4 lo[4], hi[4];
#pragma unroll
        for (int ks = 0; ks < 4; ++ks) {
            asm volatile("ds_read_b64_tr_b16 %0,%1 offset:%c2" : "=&v"(lo[ks]) : "v"(vb), "i"(d0 * 4096 + ks * 1024) : "memory");
            asm volatile("ds_read_b64_tr_b16 %0,%1 offset:%c2" : "=&v"(hi[ks]) : "v"(vb), "i"(d0 * 4096 + ks * 1024 + 512) : "memory"); }
        asm volatile("s_waitcnt lgkmcnt(0)" ::: "memory"); SBAR();
#define PK(k) (bf16x8){lo[k][0], lo[k][1], lo[k][2], lo[k][3], hi[k][0], hi[k][1], hi[k][2], hi[k][3]}
        o[d0] = __builtin_amdgcn_mfma_f32_32x32x16_bf16(pa0, PK(0), o[d0], 0, 0, 0);
        o[d0] = __builtin_amdgcn_mfma_f32_32x32x16_bf16(pa1, PK(1), o[d0], 0, 0, 0);
        o[d0] = __builtin_amdgcn_mfma_f32_32x32x16_bf16(pa2, PK(2), o[d0], 0, 0, 0);
        o[d0] = __builtin_amdgcn_mfma_f32_32x32x16_bf16(pa3, PK(3), o[d0], 0, 0, 0);
#undef PK
    }
}
__device__ __forceinline__ float rowmax(const f32x16& p0, const f32x16& p1) {
    float m = fmaxf(p0[0], p1[0]);
#pragma unroll
    for (int r = 1; r < 16; ++r) m = fmaxf(m, fmaxf(p0[r], p1[r]));
    auto rr = __builtin_amdgcn_permlane32_swap(__float_as_uint(m), __float_as_uint(m), false, false);
    return fmaxf(__uint_as_float(rr[0]), __uint_as_float(rr[1]));
}
__device__ __forceinline__ void tile_a(const LAS unsigned char* Kslot, const LAS float* bs, const bf16x8* qr, bool mask, int koff, int qrel, int r32, int hi,
                                          float& m_run, float& l_run, f32x16* o, LAS float* wsf, u32x4& pw0, u32x4& pw1, u32x4& pw2, u32x4& pw3) {
    f32x16 p0, p1; qkt(p0, p1, Kslot, qr, r32, hi);
#pragma unroll
    for (int i = 0; i < 4; ++i) { const f32x4 b0 = *(const LAS f32x4*)(bs + 8 * i + 4 * hi), b1 = *(const LAS f32x4*)(bs + 32 + 8 * i + 4 * hi);
#pragma unroll
        for (int j = 0; j < 4; ++j) { p0[4 * i + j] += b0[j]; p1[4 * i + j] += b1[j]; } }
    if (mask) {
#pragma unroll
        for (int r = 0; r < 16; ++r) { const int kv = koff + crow(r, hi); if (kv > qrel) p0[r] = -INFINITY; if (kv + 32 > qrel) p1[r] = -INFINITY; } }
    const float rm = rowmax(p0, p1);
    const float mn = fmaxf(m_run, rm), f = __builtin_amdgcn_exp2f(m_run - mn); m_run = mn;
    float s = 0.f;
#pragma unroll
    for (int r = 0; r < 16; ++r) { p0[r] = __builtin_amdgcn_exp2f(p0[r] - mn); p1[r] = __builtin_amdgcn_exp2f(p1[r] - mn); s += p0[r] + p1[r]; }
    l_run = l_run * f + s;
    if (hi == 0) wsf[r32] = f;
    asm volatile("s_waitcnt lgkmcnt(0)" ::: "memory");
#pragma unroll
    for (int i = 0; i < 4; ++i) { const f32x4 fv = *(const LAS f32x4*)(wsf + 8 * i + 4 * hi);
#pragma unroll
        for (int j = 0; j < 4; ++j) { o[0][4 * i + j] *= fv[j]; o[1][4 * i + j] *= fv[j]; } }
#pragma unroll
    for (int j = 0; j < 4; ++j) { pw0[j] = cvtpk(p0[2 * j], p0[2 * j + 1]); pw1[j] = cvtpk(p0[8 + 2 * j], p0[9 + 2 * j]); pw2[j] = cvtpk(p1[2 * j], p1[2 * j + 1]); pw3[j] = cvtpk(p1[8 + 2 * j], p1[9 + 2 * j]); }
}
__device__ __forceinline__ void tile_core(const LAS unsigned char* Kslot, int vb, const LAS float* bs, const bf16x8* qr, bool mask, int koff, int qrel, int r32, int hi,
                                          float& m_run, float& l_run, f32x16* o, LAS float* wsf) {
    u32x4 pw0, pw1, pw2, pw3;
    tile_a(Kslot, bs, qr, mask, koff, qrel, r32, hi, m_run, l_run, o, wsf, pw0, pw1, pw2, pw3);
    pv(o, vb, __builtin_bit_cast(bf16x8, pw0), __builtin_bit_cast(bf16x8, pw1), __builtin_bit_cast(bf16x8, pw2), __builtin_bit_cast(bf16x8, pw3));
}
__device__ __forceinline__ int vbase(int lane, int hi) { return ((lane >> 4) & 1) * 32 + (lane & 3) * 8 + (4 * hi + ((lane & 15) >> 2)) * 64; }

__device__ __forceinline__ void qkt_b(f32x16& p0, f32x16& p1, const LAS unsigned char* Kslot, const LAS float* bs, const bf16x8* qr, int r32, int hi) {
    const LAS unsigned char* kb = Kslot + hi * 1024 + r32 * 16;
    f32x16 c0, c1;
#pragma unroll
    for (int i = 0; i < 4; ++i) { const f32x4 b0 = *(const LAS f32x4*)(bs + 8 * i + 4 * hi), b1 = *(const LAS f32x4*)(bs + 32 + 8 * i + 4 * hi);
#pragma unroll
        for (int j = 0; j < 4; ++j) { c0[4 * i + j] = b0[j]; c1[4 * i + j] = b1[j]; } }
#pragma unroll
    for (int d0 = 0; d0 < 4; ++d0) {
        const bf16x8 b0 = *(const LAS bf16x8*)(kb + d0 * 2048), b1 = *(const LAS bf16x8*)(kb + d0 * 2048 + 512);
        if (d0 == 0) { p0 = __builtin_amdgcn_mfma_f32_32x32x16_bf16(b0, qr[0], c0, 0, 0, 0); p1 = __builtin_amdgcn_mfma_f32_32x32x16_bf16(b1, qr[0], c1, 0, 0, 0); }
        else { p0 = __builtin_amdgcn_mfma_f32_32x32x16_bf16(b0, qr[d0], p0, 0, 0, 0); p1 = __builtin_amdgcn_mfma_f32_32x32x16_bf16(b1, qr[d0], p1, 0, 0, 0); } }
}
__device__ __forceinline__ float max16x2(const f32x16& p0, const f32x16& p1) {
    float m0 = fmaxf(fmaxf(p0[0], p0[1]), p1[0]), m1 = fmaxf(fmaxf(p0[2], p0[3]), p1[1]);
    m0 = fmaxf(fmaxf(m0, p1[2]), p1[3]);
#pragma unroll
    for (int r = 4; r < 16; r += 4) { m0 = fmaxf(fmaxf(m0, p0[r]), p0[r + 1]); m1 = fmaxf(fmaxf(m1, p0[r + 2]), p0[r + 3]); m0 = fmaxf(fmaxf(m0, p1[r]), p1[r + 1]); m1 = fmaxf(fmaxf(m1, p1[r + 2]), p1[r + 3]); }
    return fmaxf(m0, m1);
}
__device__ __forceinline__ void step2(const LAS unsigned char* K0, int vb, const LAS float* bs, const bf16x8* qr, int r32, int hi, float& m_run, float& l_run, f32x16* o, LAS float* wsf) {
    f32x16 a0, a1, b0, b1;
    qkt_b(a0, a1, K0, bs, qr, r32, hi); qkt_b(b0, b1, K0 + 8192, bs + 64, qr, r32, hi);
    float m = fmaxf(max16x2(a0, a1), max16x2(b0, b1));
    { auto rr = __builtin_amdgcn_permlane32_swap(__float_as_uint(m), __float_as_uint(m), false, false); m = fmaxf(__uint_as_float(rr[0]), __uint_as_float(rr[1])); }
    const float mn = fmaxf(m_run, m), f = __builtin_amdgcn_exp2f(m_run - mn); m_run = mn;
    float s0 = 0.f, s1 = 0.f;
#pragma unroll
    for (int r = 0; r < 16; ++r) { a0[r] = __builtin_amdgcn_exp2f(a0[r] - mn); a1[r] = __builtin_amdgcn_exp2f(a1[r] - mn); s0 += a0[r]; s1 += a1[r]; }
#pragma unroll
    for (int r = 0; r < 16; ++r) { b0[r] = __builtin_amdgcn_exp2f(b0[r] - mn); b1[r] = __builtin_amdgcn_exp2f(b1[r] - mn); s0 += b0[r]; s1 += b1[r]; }
    l_run = l_run * f + (s0 + s1);
    if (__any(f != 1.0f)) {
        if (hi == 0) wsf[r32] = f;
        asm volatile("s_waitcnt lgkmcnt(0)" ::: "memory");
#pragma unroll
        for (int i = 0; i < 4; ++i) { const f32x4 fv = *(const LAS f32x4*)(wsf + 8 * i + 4 * hi);
#pragma unroll
            for (int j = 0; j < 4; ++j) { o[0][4 * i + j] *= fv[j]; o[1][4 * i + j] *= fv[j]; } }
    }
    u32x4 pw0, pw1, pw2, pw3;
#pragma unroll
    for (int j = 0; j < 4; ++j) { pw0[j] = cvtpk(a0[2 * j], a0[2 * j + 1]); pw1[j] = cvtpk(a0[8 + 2 * j], a0[9 + 2 * j]); pw2[j] = cvtpk(a1[2 * j], a1[2 * j + 1]); pw3[j] = cvtpk(a1[8 + 2 * j], a1[9 + 2 * j]); }
    pv(o, vb, __builtin_bit_cast(bf16x8, pw0), __builtin_bit_cast(bf16x8, pw1), __builtin_bit_cast(bf16x8, pw2), __builtin_bit_cast(bf16x8, pw3));
#pragma unroll
    for (int j = 0; j < 4; ++j) { pw0[j] = cvtpk(b0[2 * j], b0[2 * j + 1]); pw1[j] = cvtpk(b0[8 + 2 * j], b0[9 + 2 * j]); pw2[j] = cvtpk(b1[2 * j], b1[2 * j + 1]); pw3[j] = cvtpk(b1[8 + 2 * j], b1[9 + 2 * j]); }
    pv(o, vb + 8192, __builtin_bit_cast(bf16x8, pw0), __builtin_bit_cast(bf16x8, pw1), __builtin_bit_cast(bf16x8, pw2), __builtin_bit_cast(bf16x8, pw3));
}

typedef short v4i16_t __attribute__((ext_vector_type(4)));
typedef float f32x2 __attribute__((ext_vector_type(2)));
__device__ __forceinline__ s16x4 vtr(const LAS unsigned char* p) { return __builtin_bit_cast(s16x4, __builtin_amdgcn_ds_read_tr16_b64_v4i16((LAS v4i16_t*)p)); }
#define VFRAG(lo, hi) ((bf16x8){lo[0], lo[1], lo[2], lo[3], hi[0], hi[1], hi[2], hi[3]})
#define SM_MAX1(x0, x1) do { mA_ = fmaxf(fmaxf(x0[0], x0[1]), x1[0]); mB_ = fmaxf(fmaxf(x0[2], x0[3]), x1[1]); mA_ = fmaxf(fmaxf(mA_, x1[2]), x1[3]); \
        _Pragma("unroll") for (int r = 4; r < 8; r += 4) { mA_ = fmaxf(fmaxf(mA_, x0[r]), x0[r + 1]); mB_ = fmaxf(fmaxf(mB_, x0[r + 2]), x0[r + 3]); mA_ = fmaxf(fmaxf(mA_, x1[r]), x1[r + 1]); mB_ = fmaxf(fmaxf(mB_, x1[r + 2]), x1[r + 3]); } } while (0)
#define SM_MAX2(x0, x1) do { _Pragma("unroll") for (int r = 8; r < 16; r += 4) { mA_ = fmaxf(fmaxf(mA_, x0[r]), x0[r + 1]); mB_ = fmaxf(fmaxf(mB_, x0[r + 2]), x0[r + 3]); mA_ = fmaxf(fmaxf(mA_, x1[r]), x1[r + 1]); mB_ = fmaxf(fmaxf(mB_, x1[r + 2]), x1[r + 3]); } \
        float m_ = fmaxf(mA_, mB_); { auto rr = __builtin_amdgcn_permlane32_swap(__float_as_uint(m_), __float_as_uint(m_), false, false); m_ = fmaxf(__uint_as_float(rr[0]), __uint_as_float(rr[1])); } \
        mn_ = fmaxf(m_run, m_); f_ = __builtin_amdgcn_exp2f(m_run - mn_); m_run = mn_; l_run *= f_; if (hi == 0) wsf[r32] = f_; mn2_ = (f32x2){mn_, mn_}; s2_ = (f32x2){0.f, 0.f}; } while (0)
#define SM_EXP8(XX, base) do { _Pragma("unroll") for (int r = (base); r < (base) + 8; r += 2) { f32x2 t_ = (f32x2){XX[r], XX[r + 1]} - mn2_; t_[0] = __builtin_amdgcn_exp2f(t_[0]); t_[1] = __builtin_amdgcn_exp2f(t_[1]); XX[r] = t_[0]; XX[r + 1] = t_[1]; s2_ += t_; } } while (0)
#define SM_PACK(x0, x1, w0, w1, w2, w3) do { l_run += s2_[0] + s2_[1]; _Pragma("unroll") for (int j = 0; j < 4; ++j) { w0[j] = cvtpk(x0[2 * j], x0[2 * j + 1]); w1[j] = cvtpk(x0[8 + 2 * j], x0[9 + 2 * j]); w2[j] = cvtpk(x1[2 * j], x1[2 * j + 1]); w3[j] = cvtpk(x1[8 + 2 * j], x1[9 + 2 * j]); } \
        _Pragma("unroll") for (int i = 0; i < 4; ++i) fv_[i] = *(const LAS f32x4*)(wsf + 8 * i + 4 * hi); } while (0)
#define SM_RESC() do { _Pragma("unroll") for (int i = 0; i < 4; ++i) _Pragma("unroll") for (int j = 0; j < 4; ++j) { o[0][4 * i + j] *= fv_[i][j]; o[1][4 * i + j] *= fv_[i][j]; } } while (0)
#define MF(acc, A, B) acc = __builtin_amdgcn_mfma_f32_32x32x16_bf16(A, B, acc, 0, 0, 0)
__device__ __forceinline__ void step2p(const LAS unsigned char* K0, const LAS unsigned char* V0, const LAS float* bs, const bf16x8* qr, int lane, int r32, int hi, float& m_run, float& l_run, f32x16* o, LAS float* wsf) {
    f32x16 a0, a1, b0, b1;
    qkt_b(a0, a1, K0, bs, qr, r32, hi);
    bf16x8 kf[8];
    { const LAS unsigned char* kb = K0 + 8192 + hi * 1024 + r32 * 16;
#pragma unroll
      for (int d0 = 0; d0 < 4; ++d0) { kf[2 * d0] = *(const LAS bf16x8*)(kb + d0 * 2048); kf[2 * d0 + 1] = *(const LAS bf16x8*)(kb + d0 * 2048 + 512); }
#pragma unroll
      for (int i = 0; i < 4; ++i) { const f32x4 c0 = *(const LAS f32x4*)(bs + 64 + 8 * i + 4 * hi), c1 = *(const LAS f32x4*)(bs + 96 + 8 * i + 4 * hi);
#pragma unroll
          for (int j = 0; j < 4; ++j) { b0[4 * i + j] = c0[j]; b1[4 * i + j] = c1[j]; } } }
    float mA_, mB_, mn_, f_; f32x2 mn2_, s2_; f32x4 fv_[4]; u32x4 pw0, pw1, pw2, pw3;
    SBAR();
    MF(b0, kf[0], qr[0]); SM_MAX1(a0, a1); SBAR();
    MF(b1, kf[1], qr[0]); SM_MAX2(a0, a1); SBAR();
    MF(b0, kf[2], qr[1]); SM_EXP8(a0, 0); SBAR();
    MF(b1, kf[3], qr[1]); SM_EXP8(a0, 8); SBAR();
    MF(b0, kf[4], qr[2]); SM_EXP8(a1, 0); SBAR();
    MF(b1, kf[5], qr[2]); SM_EXP8(a1, 8); SBAR();
    MF(b0, kf[6], qr[3]); SM_PACK(a0, a1, pw0, pw1, pw2, pw3); SBAR();
    MF(b1, kf[7], qr[3]); SM_RESC(); SBAR();
    const LAS unsigned char* vp = V0 + vbase(lane, hi);
    s16x4 vlo[8], vhi[8];
#pragma unroll
    for (int i = 0; i < 8; ++i) { vlo[i] = vtr(vp + (i >> 2) * 4096 + (i & 3) * 1024); vhi[i] = vtr(vp + (i >> 2) * 4096 + (i & 3) * 1024 + 512); }
    const bf16x8 pa0 = __builtin_bit_cast(bf16x8, pw0), pa1 = __builtin_bit_cast(bf16x8, pw1), pa2 = __builtin_bit_cast(bf16x8, pw2), pa3 = __builtin_bit_cast(bf16x8, pw3);
    SBAR();
    MF(o[0], pa0, VFRAG(vlo[0], vhi[0])); SM_MAX1(b0, b1); SBAR();
    MF(o[1], pa0, VFRAG(vlo[4], vhi[4])); SM_MAX2(b0, b1); SBAR();
    MF(o[0], pa1, VFRAG(vlo[1], vhi[1])); SM_EXP8(b0, 0); SBAR();
    MF(o[1], pa1, VFRAG(vlo[5], vhi[5])); SM_EXP8(b0, 8); SBAR();
    MF(o[0], pa2, VFRAG(vlo[2], vhi[2])); SM_EXP8(b1, 0); SBAR();
    MF(o[1], pa2, VFRAG(vlo[6], vhi[6])); SM_EXP8(b1, 8); SBAR();
    MF(o[0], pa3, VFRAG(vlo[3], vhi[3])); SM_PACK(b0, b1, pw0, pw1, pw2, pw3); SBAR();
    MF(o[1], pa3, VFRAG(vlo[7], vhi[7])); SBAR();
    SM_RESC();
    const LAS unsigned char* vq = vp + 8192;
#pragma unroll
    for (int i = 0; i < 8; ++i) { vlo[i] = vtr(vq + (i >> 2) * 4096 + (i & 3) * 1024); vhi[i] = vtr(vq + (i >> 2) * 4096 + (i & 3) * 1024 + 512); }
    const bf16x8 pb0 = __builtin_bit_cast(bf16x8, pw0), pb1 = __builtin_bit_cast(bf16x8, pw1), pb2 = __builtin_bit_cast(bf16x8, pw2), pb3 = __builtin_bit_cast(bf16x8, pw3);
    MF(o[0], pb0, VFRAG(vlo[0], vhi[0])); MF(o[1], pb0, VFRAG(vlo[4], vhi[4])); MF(o[0], pb1, VFRAG(vlo[1], vhi[1])); MF(o[1], pb1, VFRAG(vlo[5], vhi[5]));
    MF(o[0], pb2, VFRAG(vlo[2], vhi[2])); MF(o[1], pb2, VFRAG(vlo[6], vhi[6])); MF(o[0], pb3, VFRAG(vlo[3], vhi[3])); MF(o[1], pb3, VFRAG(vlo[7], vhi[7]));
}

constexpr int PL_K = 0, PL_V = 49152, PL_B = 98304, PL_WS = 99840, PL_OST = 102400;
__device__ __forceinline__ void prompt_unit(int b, int h, int qb, const bf16* Q, const bf16* K, const bf16* V, const float* CB, bf16* O, ldsp lds, int variant) {
    int tid_ = threadIdx.x; asm volatile("" : "+v"(tid_));
    const int tid = tid_, lane = tid & 63, r32 = lane & 31, hi = lane >> 5; const int wid = __builtin_amdgcn_readfirstlane(tid >> 6);
    const size_t rowbase = (size_t)b * SEQ; const int q0 = qb * 256;
    const bf16* Qw = Q + (rowbase + q0 + wid * 32) * DA + h * HD;
    const bf16* Kh = K + rowbase * DA + h * HD; const bf16* Vh = V + rowbase * DA + h * HD;
    const float* cb = CB + (size_t)(b * NH + h) * SEQ;
    const bf16* ksrc = Kh + (size_t)lane * DA + wid * 8;
    const bf16* vsrc = Vh + (size_t)(16 * (wid & 3) + (lane >> 2)) * DA + (wid >> 2) * 32 + (lane & 3) * 8;
    const int NT2 = (q0 + 256) / 128;
    const unsigned ldsu = (unsigned)(uintptr_t)lds;
#define DMA_STEP(t, slot) do { _Pragma("unroll") for (int sub_ = 0; sub_ < 2; ++sub_) { \
        glds16(ksrc + (size_t)(2 * (t) + sub_) * 64 * DA, (unsigned)__builtin_amdgcn_readfirstlane(ldsu + PL_K + (slot) * 16384 + sub_ * 8192 + wid * 1024)); \
        glds16(vsrc + (size_t)(2 * (t) + sub_) * 64 * DA, (unsigned)__builtin_amdgcn_readfirstlane(ldsu + PL_V + (slot) * 16384 + sub_ * 8192 + wid * 1024)); } \
        if (wid < 2) glds4(cb + (2 * (t) + wid) * 64 + lane, (unsigned)__builtin_amdgcn_readfirstlane(ldsu + PL_B + (slot) * 512 + wid * 256)); } while (0)
    bf16x8 qr[4];
#pragma unroll
    for (int d0 = 0; d0 < 4; ++d0) qr[d0] = *(const bf16x8*)(Qw + (size_t)r32 * DA + d0 * 16 + hi * 8);
    __builtin_amdgcn_s_waitcnt(0x0F70);
    asm volatile("" ::: "memory");
    DMA_STEP(0, 0);
    if (NT2 > 1) DMA_STEP(1, 1);
    float m_run = -1e30f, l_run = 0.f; f32x16 o[2]; o[0] = f32x16{}; o[1] = f32x16{};
    LAS float* wsf = (LAS float*)(lds + PL_WS + wid * 256);
    const int lds0 = (int)(unsigned)(uintptr_t)lds;
    const int vb0 = lds0 + PL_V + vbase(lane, hi);
    const int qrel = wid * 32 + r32;
    int slot = 0;
    for (int t = 0; t < NT2; ++t) {
        if (t + 1 < NT2) { if (wid < 2) asm volatile("s_waitcnt vmcnt(5) lgkmcnt(0)\n\ts_barrier" ::: "memory"); else asm volatile("s_waitcnt vmcnt(4) lgkmcnt(0)\n\ts_barrier" ::: "memory"); }
        else BLOCK_BAR();
        if (t + 2 < NT2 && variant != 3) { const int s2 = slot == 0 ? 2 : slot - 1; DMA_STEP(t + 2, s2); }
        const int jb2 = t - (NT2 - 2);
        if (variant == 2) { } else if (jb2 < 0) step2p(lds + PL_K + slot * 16384, lds + PL_V + slot * 16384, (const LAS float*)(lds + PL_B + slot * 512), qr, lane, r32, hi, m_run, l_run, o, wsf);
        else {
#pragma unroll
            for (int sub = 0; sub < 2; ++sub) { const int js = 2 * jb2 + sub;
                if (64 * js <= wid * 32 + 31)
                    tile_core(lds + PL_K + slot * 16384 + sub * 8192, vb0 + slot * 16384 + sub * 8192, (const LAS float*)(lds + PL_B + slot * 512 + sub * 256), qr, true, 64 * js, qrel, r32, hi, m_run, l_run, o, wsf); }
        }
        slot = slot == 2 ? 0 : slot + 1;
    }
#undef DMA_STEP
    { auto rr = __builtin_amdgcn_permlane32_swap(__float_as_uint(l_run), __float_as_uint(l_run), false, false); l_run = __uint_as_float(rr[0]) + __uint_as_float(rr[1]); }
    if (hi == 0) wsf[32 + r32] = l_run;
    asm volatile("s_waitcnt lgkmcnt(0)" ::: "memory");
    float rli[16];
#pragma unroll
    for (int r = 0; r < 16; ++r) rli[r] = 1.0f / wsf[32 + crow(r, hi)];
    bf16* Ow = O + (rowbase + q0 + wid * 32) * DM + h * HD;
    { LAS bf16* stg = (LAS bf16*)(lds + PL_OST + wid * 4096);
#pragma unroll
      for (int r = 0; r < 16; ++r) { const int orow = crow(r, hi);
#pragma unroll
          for (int d0 = 0; d0 < 2; ++d0) { const float v = o[d0][r] * rli[r]; stg[orow * 64 + d0 * 32 + r32] = (bf16)(cvtpk(v, v) & 0xffffu); } }
      asm volatile("s_waitcnt lgkmcnt(0)" ::: "memory");
#pragma unroll
      for (int i = 0; i < 4; ++i) { const int row = i * 8 + (lane >> 3), ch = lane & 7; const u32x4 v = *(const LAS u32x4*)(stg + row * 64 + ch * 8); *(u32x4*)(Ow + (size_t)row * DM + ch * 8) = v; } }
    BLOCK_BAR();
}

constexpr int SL_B = 131072, SL_WS = 133120, SL_M = 135168, SL_L = 136192;
__device__ __forceinline__ void sample_unit(int b, int h, const Args& a, ldsp lds) {
    int tid_ = threadIdx.x; asm volatile("" : "+v"(tid_));
    const int tid = tid_, lane = tid & 63, r32 = lane & 31, hi = lane >> 5; const int wid = __builtin_amdgcn_readfirstlane(tid >> 6);
    unsigned char* ws = a.ws;
    const bf16* Q = (const bf16*)(ws + WS_Q); const bf16* Kn = (const bf16*)(ws + WS_K); const bf16* Vn = (const bf16*)(ws + WS_V); bf16* O = (bf16*)(ws + WS_CSAO) + DC;
    const float* cbs = (const float*)(ws + WS_CBS) + (size_t)(b * NH + h) * CBS_PITCH;
    const size_t srow = (size_t)MP + (size_t)b * DS;
    const float* ck = a.in[2] + ((size_t)b * PAST * NH + h) * HD; const float* cv = a.in[3] + ((size_t)b * PAST * NH + h) * HD;
    ldsp Kw = lds + wid * 16384; ldsp Vw = Kw + 8192;
    LAS float* bsw = (LAS float*)(lds + SL_B + wid * 256); LAS float* wsf = (LAS float*)(lds + SL_WS + wid * 256);
    bf16x8 qr[4];
#pragma unroll
    for (int d0 = 0; d0 < 4; ++d0) qr[d0] = *(const bf16x8*)(Q + (srow + r32) * DA + h * HD + d0 * 16 + hi * 8);
    float m_run = -1e30f, l_run = 0.f; f32x16 o[2]; o[0] = f32x16{}; o[1] = f32x16{};
    const int vb0 = (int)(unsigned)(uintptr_t)Vw + vbase(lane, hi);
    const int f4 = lane & 15, kq = lane >> 4; const int voff = (kq * DA + 4 * f4) * 4;
    const __amdgpu_buffer_rsrc_t rk = __builtin_amdgcn_make_buffer_rsrc((void*)ck, 0, PAST * 2048, 0x00027000), rv = __builtin_amdgcn_make_buffer_rsrc((void*)cv, 0, PAST * 2048, 0x00027000);
    const int koffK = (f4 >> 1) * 1024 + (f4 & 1) * 8;
    const int koffV = (f4 >> 3) * 4096 + ((f4 & 7) >> 1) * 16 + (f4 & 1) * 8;
    f32x4 kreg[8];
#pragma unroll
    for (int i = 0; i < 8; ++i) kreg[i] = __builtin_bit_cast(f32x4, __builtin_amdgcn_raw_buffer_load_b128(rk, voff, (512 * wid + 4 * i) * 2048, 0));
    for (int tt = 0; tt < 8; ++tt) {
        const int key0 = 512 * wid + 64 * tt;
        { f32x4 kreg2[8];
#pragma unroll
          for (int i = 0; i < 8; ++i) kreg2[i] = __builtin_bit_cast(f32x4, __builtin_amdgcn_raw_buffer_load_b128(rk, voff, (key0 + 32 + 4 * i) * 2048, 0));
#pragma unroll
          for (int i = 0; i < 8; ++i) { const int key = 4 * i + kq; u32x2 w; w.x = cvtpk(kreg[i].x, kreg[i].y); w.y = cvtpk(kreg[i].z, kreg[i].w); *(LAS u32x2*)(Kw + koffK + key * 16) = w; }
#pragma unroll
          for (int i = 0; i < 8; ++i) { const int key = 32 + 4 * i + kq; u32x2 w; w.x = cvtpk(kreg2[i].x, kreg2[i].y); w.y = cvtpk(kreg2[i].z, kreg2[i].w); *(LAS u32x2*)(Kw + koffK + key * 16) = w; } }
        asm volatile("" ::: "memory");
        f32x4 vreg[16];
#pragma unroll
        for (int i = 0; i < 16; ++i) vreg[i] = __builtin_bit_cast(f32x4, __builtin_amdgcn_raw_buffer_load_b128(rv, voff, (key0 + 4 * i) * 2048, 0));
        bsw[lane] = cbs[key0 + lane];
        asm volatile("s_waitcnt lgkmcnt(0)" ::: "memory");
        u32x4 pw0, pw1, pw2, pw3;
        tile_a(Kw, bsw, qr, false, 0, 0, r32, hi, m_run, l_run, o, wsf, pw0, pw1, pw2, pw3);
        asm volatile("" ::: "memory");
#pragma unroll
        for (int i = 0; i < 16; ++i) { const int key = 4 * i + kq; u32x2 w; w.x = cvtpk(vreg[i].x, vreg[i].y); w.y = cvtpk(vreg[i].z, vreg[i].w); *(LAS u32x2*)(Vw + koffV + (key >> 4) * 1024 + (key & 15) * 64) = w; }
        asm volatile("" ::: "memory");
        if (tt < 7) {
#pragma unroll
            for (int i = 0; i < 8; ++i) kreg[i] = __builtin_bit_cast(f32x4, __builtin_amdgcn_raw_buffer_load_b128(rk, voff, (key0 + 64 + 4 * i) * 2048, 0)); }
        asm volatile("s_waitcnt lgkmcnt(0)" ::: "memory");
        pv(o, vb0, __builtin_bit_cast(bf16x8, pw0), __builtin_bit_cast(bf16x8, pw1), __builtin_bit_cast(bf16x8, pw2), __builtin_bit_cast(bf16x8, pw3));
    }
    if (wid == 7) {
        const int key = lane >> 1, half = lane & 1;
        const u32x4* kp = (const u32x4*)(Kn + (srow + key) * DA + h * HD + half * 32); const u32x4* vp = (const u32x4*)(Vn + (srow + key) * DA + h * HD + half * 32);
#pragma unroll
        for (int c = 0; c < 4; ++c) { *(LAS u32x4*)(Kw + (4 * half + c) * 1024 + key * 16) = kp[c]; *(LAS u32x4*)(Kw + (4 * half + c) * 1024 + (key + 32) * 16) = (u32x4){0u, 0u, 0u, 0u}; }
#pragma unroll
        for (int c = 0; c < 4; ++c) { *(LAS u32x4*)(Vw + (half * 4 + (key >> 4)) * 1024 + ((key & 15) * 4 + c) * 16) = vp[c]; *(LAS u32x4*)(Vw + (half * 4 + 2 + (key >> 4)) * 1024 + ((key & 15) * 4 + c) * 16) = (u32x4){0u, 0u, 0u, 0u}; }
        bsw[lane] = cbs[PAST + lane];
        asm volatile("s_waitcnt lgkmcnt(0)" ::: "memory");
        tile_core(Kw, vb0, bsw, qr, true, 0, r32, r32, hi, m_run, l_run, o, wsf);
    }
    { auto rr = __builtin_amdgcn_permlane32_swap(__float_as_uint(l_run), __float_as_uint(l_run), false, false); l_run = __uint_as_float(rr[0]) + __uint_as_float(rr[1]); }
    LAS float* Mw = (LAS float*)(lds + SL_M); LAS float* Lw = (LAS float*)(lds + SL_L);
    if (hi == 0) { Mw[wid * 32 + r32] = m_run; Lw[wid * 32 + r32] = l_run; }
    BLOCK_BAR();
    float M = -1e30f;
#pragma unroll
    for (int w = 0; w < 8; ++w) M = fmaxf(M, Mw[w * 32 + r32]);
    float L = 0.f;
#pragma unroll
    for (int w = 0; w < 8; ++w) L += Lw[w * 32 + r32] * __builtin_amdgcn_exp2f(Mw[w * 32 + r32] - M);
    const float g = __builtin_amdgcn_exp2f(m_run - M) / L;
    if (hi == 0) wsf[r32] = g;
    asm volatile("s_waitcnt lgkmcnt(0)" ::: "memory");
    LAS float* OW = (LAS float*)Kw;
#pragma unroll
    for (int r = 0; r < 16; ++r) { const int q = crow(r, hi); const float gg = wsf[q];
#pragma unroll
        for (int d0 = 0; d0 < 2; ++d0) OW[q * 64 + d0 * 32 + r32] = o[d0][r] * gg; }
    BLOCK_BAR();
    { const int q = tid >> 4, d = (tid & 15) * 4; f32x4 acc = {0.f, 0.f, 0.f, 0.f};
#pragma unroll
      for (int w = 0; w < 8; ++w) acc += *(const LAS f32x4*)(lds + w * 16384 + (q * 64 + d) * 4);
      u32x2 wv; wv.x = cvtpk(acc.x, acc.y); wv.y = cvtpk(acc.z, acc.w); *(u32x2*)(O + (srow + q) * DM + h * HD + d) = wv; }
    BLOCK_BAR();
}
#undef SBAR
}

__device__ __forceinline__ void conv_unit(int u, const Args& a, ldsp lds, bool w_staged) {
    int tid_ = threadIdx.x; asm volatile("" : "+v"(tid_));
    const int tid = tid_, lane = tid & 63; const int wid = __builtin_amdgcn_readfirstlane(tid >> 6);
    unsigned char* ws = a.ws; const bf16* CU = (const bf16*)(ws + WS_CU); bf16* CS = (bf16*)(ws + WS_CSAO);
    const float* wdw = a.in[9]; const float* bdw = a.in[10]; const float* lng = a.in[11]; const float* lnb = a.in[12];
    asm volatile("" : "+s"(wdw), "+s"(bdw), "+s"(lng), "+s"(lnb));
    const int row0 = 32 * u, rw = row0 + 4 * wid, cA = 4 * lane, cB = 256 + 4 * lane;
    LAS f32x4* W4 = (LAS f32x4*)lds;
    constexpr int XOFF = (CW + 6) * DC * 4;
    LAS u32x4* X4 = (LAS u32x4*)(lds + XOFF);
    {
        f32x4 wreg[8]; u32x4 xreg[8];
#pragma unroll
        for (int k = 0; k < 8; ++k) { const int e = tid + NTHREADS * k; wreg[k] = (f32x4){0.f, 0.f, 0.f, 0.f}; if (!w_staged && e < CW * (DC / 4)) wreg[k] = ((const f32x4*)wdw)[e]; }
        if (row0 < MP) { const int t0 = (row0 & (SEQ - 1)) - 30;
#pragma unroll
            for (int k = 0; k < 8; ++k) { const int e = tid + NTHREADS * k, r = e >> 6; xreg[k] = (u32x4){0u, 0u, 0u, 0u};
                if (e < 62 * 64 && t0 + r >= 0) xreg[k] = *(const u32x4*)(CU + (size_t)(row0 - 30 + r) * DC + (e & 63) * 8); } }
        else { const int b = (row0 - MP) >> 5; const float* st = a.in[5] + (size_t)b * 30 * DC;
#pragma unroll
            for (int k = 0; k < 8; ++k) { const int e = tid + NTHREADS * k, r = e >> 6; xreg[k] = (u32x4){0u, 0u, 0u, 0u};
                if (e < 62 * 64) { if (r >= 30) xreg[k] = *(const u32x4*)(CU + (size_t)(row0 - 30 + r) * DC + (e & 63) * 8);
                    else { const float* p = st + (size_t)r * DC + (e & 63) * 8; xreg[k] = pg8::pack8(*(const f32x4*)p, *(const f32x4*)(p + 4)); } } } }
#pragma unroll
        for (int k = 0; k < 8; ++k) { const int e = tid + NTHREADS * k; if (!w_staged && e < CW * (DC / 4)) W4[e + 3 * (DC / 4)] = wreg[k]; }
#pragma unroll
        for (int k = 0; k < 2; ++k) { const int e = tid + NTHREADS * k; if (!w_staged && e < 768) W4[e < 384 ? e : (CW + 3) * (DC / 4) + (e - 384)] = (f32x4){0.f, 0.f, 0.f, 0.f}; }
#pragma unroll
        for (int k = 0; k < 8; ++k) { const int e = tid + NTHREADS * k; if (e < 62 * 64) X4[e] = xreg[k]; }
    }
    const f32x4 biasA = *(const f32x4*)(bdw + cA), biasB = *(const f32x4*)(bdw + cB);
    f32x4 accA[4], accB[4], wA[4], wB[4];
#pragma unroll
    for (int r = 0; r < 4; ++r) { accA[r] = biasA; accB[r] = biasB; wA[r] = (f32x4){0.f, 0.f, 0.f, 0.f}; wB[r] = wA[r]; }
    BLOCK_BAR();
    const LAS unsigned char* xrow = lds + XOFF + (4 * wid) * 1024;
#pragma unroll 4
    for (int i = 0; i < 34; ++i) {
        wA[0] = W4[(i + 3) * (DC / 4) + lane]; wB[0] = W4[(i + 3) * (DC / 4) + 64 + lane];
        const u32x2 xa = *(const LAS u32x2*)(xrow + i * 1024 + cA * 2), xb = *(const LAS u32x2*)(xrow + i * 1024 + cB * 2);
        f32x4 fa, fb;
        fa[0] = __uint_as_float(xa.x << 16); fa[1] = __uint_as_float(xa.x & 0xffff0000u); fa[2] = __uint_as_float(xa.y << 16); fa[3] = __uint_as_float(xa.y & 0xffff0000u);
        fb[0] = __uint_as_float(xb.x << 16); fb[1] = __uint_as_float(xb.x & 0xffff0000u); fb[2] = __uint_as_float(xb.y << 16); fb[3] = __uint_as_float(xb.y & 0xffff0000u);
#pragma unroll
        for (int r = 0; r < 4; ++r) { accA[r] += wA[r] * fa; accB[r] += wB[r] * fb; }
        wA[3] = wA[2]; wA[2] = wA[1]; wA[1] = wA[0]; wB[3] = wB[2]; wB[2] = wB[1]; wB[1] = wB[0];
    }
    const f32x4 gA = *(const f32x4*)(lng + cA), gB = *(const f32x4*)(lng + cB), bA = *(const f32x4*)(lnb + cA), bB = *(const f32x4*)(lnb + cB);
#pragma unroll
    for (int r = 0; r < 4; ++r) {
        f32x4 v0 = accA[r], v1 = accB[r];
        const float mean = wave_sum((v0.x + v0.y) + (v0.z + v0.w) + (v1.x + v1.y) + (v1.z + v1.w)) * (1.0f / DC);
        v0 = v0 - mean; v1 = v1 - mean;
        const float var = wave_sum((v0.x * v0.x + v0.y * v0.y) + (v0.z * v0.z + v0.w * v0.w) + (v1.x * v1.x + v1.y * v1.y) + (v1.z * v1.z + v1.w * v1.w)) * (1.0f / DC);
        const float rs = 1.0f / sqrtf(var + 1e-5f);
        f32x4 y0 = v0 * rs * gA + bA, y1 = v1 * rs * gB + bB;
        y0 = y0 * pg8::sigm4(y0); y1 = y1 * pg8::sigm4(y1);
        bf16* o = CS + (size_t)(rw + r) * DM;
        *(u32x2*)(o + cA) = (u32x2){cvtpk(y0[0], y0[1]), cvtpk(y0[2], y0[3])}; *(u32x2*)(o + cB) = (u32x2){cvtpk(y1[0], y1[1]), cvtpk(y1[2], y1[3])}; }
    BLOCK_BAR();
}

constexpr int NU_SAMPLE = DB * NH, NU_PROMPT = 4 * NH * 16, NU_CONV = MT / 32, NU_TOTAL = NU_SAMPLE + NU_PROMPT + NU_CONV;
__device__ __forceinline__ void queue_phase(const Args& a, ldsp lds) {
    unsigned char* ws = a.ws; unsigned* ctr = (unsigned*)(ws + WS_CTL);
    volatile LAS unsigned* qw = (volatile LAS unsigned*)(lds + LDS_QW);
    bool w_staged = false;
    for (;;) {
        if (threadIdx.x == 0) qw[0] = __hip_atomic_fetch_add(ctr, 1u, __ATOMIC_RELAXED, __HIP_MEMORY_SCOPE_AGENT);
        __syncthreads();
        const int id = (int)qw[0];
        __syncthreads();
        if (id >= NU_TOTAL) break;
        if (id < NU_SAMPLE) { if (a.qmask & 1) { att::sample_unit(id >> 3, id & 7, a, lds); w_staged = false; } }
        else if (id < NU_SAMPLE + NU_PROMPT) { if (a.qmask & 2) { const int j = id - NU_SAMPLE, qb = 15 - (j >> 5), bh = j & 31;
            att::prompt_unit(bh >> 3, bh & 7, qb, (const bf16*)(ws + WS_Q), (const bf16*)(ws + WS_K), (const bf16*)(ws + WS_V), (const float*)(ws + WS_CBP), a.pad ? (bf16*)(ws + 470 * MiB) : (bf16*)(ws + WS_CSAO) + DC, lds, a.pad); w_staged = false; } }
        else if (a.qmask & 4) { conv_unit(id - NU_SAMPLE - NU_PROMPT, a, lds, w_staged); w_staged = true; }
    }
}

constexpr int SG_PITCH = 68;
template <int K, int LDA = K, int LDB = K> __device__ __forceinline__ void sg_accum(const bf16* A, const bf16* Bt, int row0, int col0, int wave, int lane, f32x4 (&acc)[2][4]) {
    const int fr = lane & 15, fq = lane >> 4;
    const bf16* ap = A + (size_t)(row0 + fr) * LDA + 8 * fq; const bf16* bp = Bt + (size_t)(col0 + fr) * LDB + 8 * fq;
#pragma unroll 2
    for (int ks = wave; ks < K / 32; ks += 8) {
        bf16x8 av[2], bv[4];
#pragma unroll
        for (int mi = 0; mi < 2; ++mi) av[mi] = *(const bf16x8*)(ap + (size_t)mi * 16 * LDA + ks * 32);
#pragma unroll
        for (int ni = 0; ni < 4; ++ni) bv[ni] = *(const bf16x8*)(bp + (size_t)ni * 16 * LDB + ks * 32);
#pragma unroll
        for (int mi = 0; mi < 2; ++mi)
#pragma unroll
            for (int ni = 0; ni < 4; ++ni) acc[mi][ni] = __builtin_amdgcn_mfma_f32_16x16x32_bf16(bv[ni], av[mi], acc[mi][ni], 0, 0, 0);
    }
}
__device__ __forceinline__ f32x4 sg_reduce(ldsp lds, const f32x4 (&acc)[2][4], int wave, int lane, int tid) {
    const int fr = lane & 15, fq = lane >> 4;
    LAS float* R = (LAS float*)lds + wave * (32 * SG_PITCH);
#pragma unroll
    for (int mi = 0; mi < 2; ++mi)
#pragma unroll
        for (int ni = 0; ni < 4; ++ni) *(LAS f32x4*)(R + (16 * mi + fr) * SG_PITCH + 16 * ni + 4 * fq) = acc[mi][ni];
    BLOCK_BAR();
    f32x4 sum = {0.f, 0.f, 0.f, 0.f};
#pragma unroll
    for (int w = 0; w < 8; ++w) sum += *(const LAS f32x4*)((LAS float*)lds + w * (32 * SG_PITCH) + (tid >> 4) * SG_PITCH + 4 * (tid & 15));
    BLOCK_BAR();
    return sum;
}
__device__ __forceinline__ f32x4 bf4(const bf16* p) { const u32x2 w = *(const u32x2*)p; f32x4 r; r[0] = __uint_as_float(w.x << 16); r[1] = __uint_as_float(w.x & 0xffff0000u); r[2] = __uint_as_float(w.y << 16); r[3] = __uint_as_float(w.y & 0xffff0000u); return r; }
__device__ __forceinline__ void st_bf4(bf16* p, const f32x4 v) { u32x2 w; w.x = cvtpk(v[0], v[1]); w.y = cvtpk(v[2], v[3]); *(u32x2*)p = w; }
__device__ __forceinline__ float row16_sum(float v) { v += __shfl_xor(v, 1); v += __shfl_xor(v, 2); v += __shfl_xor(v, 4); v += __shfl_xor(v, 8); return v; }
#define SG_ZERO(acc) do { _Pragma("unroll") for (int mi_ = 0; mi_ < 2; ++mi_) _Pragma("unroll") for (int ni_ = 0; ni_ < 4; ++ni_) acc[mi_][ni_] = (f32x4){0.f, 0.f, 0.f, 0.f}; } while (0)
__device__ __forceinline__ void small_mix(const Args& a, ldsp lds, int wave, int lane) {
    unsigned char* ws = a.ws; int tid_ = threadIdx.x; asm volatile("" : "+v"(tid_)); const int tid = tid_;
    for (int u = blockIdx.x; u < 256; u += gridDim.x) {
        const int row0 = MP + 32 * (u >> 4), col0 = 64 * (u & 15);
        f32x4 acc[2][4]; SG_ZERO(acc);
        sg_accum<DC, DM, DM>((const bf16*)(ws + WS_CSAO), (const bf16*)(ws + WS_WMIX), row0, col0, wave, lane, acc);
        const f32x4 r1 = sg_reduce(lds, acc, wave, lane, tid);
        SG_ZERO(acc);
        sg_accum<DA, DM, DM>((const bf16*)(ws + WS_CSAO) + DC, (const bf16*)(ws + WS_WMIX) + DC, row0, col0, wave, lane, acc);
        const f32x4 r2 = sg_reduce(lds, acc, wave, lane, tid);
        const size_t o = (size_t)(row0 + (tid >> 4)) * DM + col0 + 4 * (tid & 15);
        st_bf4((bf16*)(ws + WS_MIX) + o, (bf4((const bf16*)(ws + WS_GC) + o) * r1 + r2) * bf4((const bf16*)(ws + WS_GA) + o));
    }
}
__device__ __forceinline__ void small_out(const Args& a, ldsp lds, int wave, int lane) {
    unsigned char* ws = a.ws; int tid_ = threadIdx.x; asm volatile("" : "+v"(tid_)); const int tid = tid_;
    for (int u = blockIdx.x; u < 256; u += gridDim.x) {
        const int row0 = MP + 32 * (u >> 4), col0 = 64 * (u & 15);
        f32x4 acc[2][4]; SG_ZERO(acc);
        sg_accum<DM>((const bf16*)(ws + WS_MIX), (const bf16*)(ws + WS_WOUT), row0, col0, wave, lane, acc);
        const f32x4 r = sg_reduce(lds, acc, wave, lane, tid);
        const int row = row0 + (tid >> 4); const size_t o = (size_t)row * DM + col0 + 4 * (tid & 15);
        const f32x4 h = r + *(const f32x4*)(a.in[1] + (o - (size_t)MP * DM));
        st_bf4((bf16*)(ws + WS_HB) + o, h);
        const float ss = row16_sum((h[0] * h[0] + h[1] * h[1]) + (h[2] * h[2] + h[3] * h[3]));
        if ((tid & 15) == 0) ((float*)(ws + WS_SS))[(size_t)row * 16 + (u & 15)] = ss;
    }
}
__device__ __forceinline__ void small_down(const Args& a, ldsp lds, int wave, int lane) {
    unsigned char* ws = a.ws; int tid_ = threadIdx.x; asm volatile("" : "+v"(tid_)); const int tid = tid_;
    for (int u = blockIdx.x; u < 256; u += gridDim.x) {
        const int row0 = MP + 32 * (u >> 4), col0 = 64 * (u & 15);
        f32x4 acc[2][4]; SG_ZERO(acc);
        sg_accum<DFF>((const bf16*)(ws + WS_ACT), (const bf16*)(ws + WS_WDN), row0, col0, wave, lane, acc);
        const f32x4 r = sg_reduce(lds, acc, wave, lane, tid);
        const int row = row0 + (tid >> 4); const size_t o = (size_t)row * DM + col0 + 4 * (tid & 15);
        const f32x4 h = r + bf4((const bf16*)(ws + WS_HB) + o);
        *(f32x4*)(a.out + o) = h;
        const float ss = row16_sum((h[0] * h[0] + h[1] * h[1]) + (h[2] * h[2] + h[3] * h[3]));
        if ((tid & 15) == 0) ((float*)(ws + WS_SS2))[(size_t)row * 16 + (u & 15)] = ss;
    }
}

__device__ __forceinline__ void final_norm(const Args& a, int wave, int lane) {
    const int gw = blockIdx.x * NWAVES + wave, NGW = gridDim.x * NWAVES;
    const float* SS2 = (const float*)(a.ws + WS_SS2); const float* g = a.in[20];
    f32x4 gv[4];
#pragma unroll
    for (int j = 0; j < 4; ++j) gv[j] = ((const f32x4*)g)[lane + 64 * j];
    for (int m0 = gw; m0 < MT; m0 += 4 * NGW) {
        f32x4 v[4][4]; float part[4];
#pragma unroll
        for (int q = 0; q < 4; ++q) { const int m = m0 + q * NGW;
            if (m < MT) { part[q] = (lane < 16) ? SS2[(size_t)m * 16 + lane] : 0.f; const f32x4* yr = (const f32x4*)(a.out + (size_t)m * DM) + lane;
#pragma unroll
                for (int j = 0; j < 4; ++j) v[q][j] = yr[64 * j]; } else { part[q] = 0.f;
#pragma unroll
                for (int j = 0; j < 4; ++j) v[q][j] = (f32x4){0.f, 0.f, 0.f, 0.f}; } }
#pragma unroll
        for (int q = 0; q < 4; ++q) { const int m = m0 + q * NGW;
            const float rs = 1.0f / sqrtf(wave_sum(part[q]) * (1.0f / DM) + 1e-6f);
            if (m < MT) { f32x4* yr = (f32x4*)(a.out + (size_t)m * DM) + lane;
#pragma unroll
                for (int j = 0; j < 4; ++j) yr[64 * j] = v[q][j] * rs * gv[j]; } }
    }
}

constexpr int NPHASE = 8;
__global__ void __launch_bounds__(NTHREADS, 2) fwd_kernel(Args a) {
    extern __shared__ __attribute__((aligned(16))) unsigned char lds_raw[];
    ldsp lds = (ldsp)lds_raw;
    const int tid = threadIdx.x, lane = tid & 63; const int wave = __builtin_amdgcn_readfirstlane(tid >> 6);
    unsigned char* ws = a.ws;
    const int lo = a.ph_lo, hi = a.ph_hi; const int G = gridDim.x, c = blockIdx.x;
#ifdef PHASE_ONLY
#define IN(k) ((k) == PHASE_ONLY && lo <= (k) && (k) < hi)
#else
#define IN(k) (lo <= (k) && (k) < hi)
#endif
    if (tid < 4) ((LAS unsigned*)(lds + LDS_XB))[tid] = 0u;
    __syncthreads();
    XcdBarrier bar; bar.bar = (unsigned*)(ws + WS_CTL + CTL_BAR_BYTE); bar.x = 0; bar.st = nullptr;
    if (hi - lo > 1) bar = xcd_barrier_post((unsigned*)(ws + WS_CTL + CTL_BAR_BYTE), (volatile LAS unsigned*)(lds + LDS_XB));
    if (lo < 0) cg::this_grid().sync();
#define SEAM(k) do { if (IN(k) && IN((k) + 1)) { xcd_barrier(bar); } } while (0)
#ifndef REP0
#define REP0 1
#endif
    if (IN(0)) for (int rep_ = 0; rep_ < REP0; ++rep_) { p0_prologue(a, lds, wave, lane); __syncthreads(); }
    SEAM(0);
#ifndef REP1
#define REP1 1
#endif
    if (IN(1)) for (int rep_ = 0; rep_ < REP1; ++rep_) {
        if (rep_) xcd_barrier(bar);
        cumsum_phase(a, wave, lane);
        pg8::Gemm g{(const bf16*)(ws + WS_XB), (const bf16*)(ws + WS_WIN), MT, NIN, DM}; pg8::StaticOrder S; S.init(MT, NIN, G, c);
        pg8::EpiIn E{(const float*)(ws + WS_RSTD), (bf16*)(ws + WS_CU), (bf16*)(ws + WS_Q), (bf16*)(ws + WS_K), (bf16*)(ws + WS_V), (bf16*)(ws + WS_GC), (bf16*)(ws + WS_GA), a.out};
        pg8::gemm_phase<pg8::EpiIn, pg8::StaticOrder, true, true>(lds, g, S, E);
    }
    SEAM(1);
    if (IN(2)) queue_phase(a, lds);
#ifdef PROBE_Q2
    xcd_barrier(bar); if (blockIdx.x == 0 && threadIdx.x == 0) __hip_atomic_store((unsigned*)(ws + WS_CTL), 0u, __ATOMIC_RELAXED, __HIP_MEMORY_SCOPE_AGENT); xcd_barrier(bar);
    if (IN(2)) queue_phase(a, lds);
#endif
    SEAM(2);
#ifndef REP3
#define REP3 1
#endif
    if (IN(3)) for (int rep_ = 0; rep_ < REP3; ++rep_) {
        if (rep_) xcd_barrier(bar);
        { pg8::Gemm g{(const bf16*)(ws + WS_CSAO), (const bf16*)(ws + WS_WMIX), MP, DM, DM}; pg8::StaticOrder S; S.init(MP, DM, G, c);
          pg8::EpiMixF E{(const bf16*)(ws + WS_GC), (const bf16*)(ws + WS_GA), (bf16*)(ws + WS_MIX)};
          pg8::gemm_phase<pg8::EpiMixF, pg8::StaticOrder, true, true, true>(lds, g, S, E); }
        small_mix(a, lds, wave, lane);
    }
    SEAM(3);
#ifndef REP4
#define REP4 1
#endif
    if (IN(4)) for (int rep_ = 0; rep_ < REP4; ++rep_) {
        if (rep_) xcd_barrier(bar);
        pg8::Gemm g{(const bf16*)(ws + WS_MIX), (const bf16*)(ws + WS_WOUT), MP, DM, DM}; pg8::StaticOrder S; S.init(MP, DM, G, c);
        pg8::EpiOut E{a.in[0], a.in[1], (bf16*)(ws + WS_HB), (float*)(ws + WS_SS)};
        pg8::gemm_phase<pg8::EpiOut, pg8::StaticOrder, true, true>(lds, g, S, E);
        small_out(a, lds, wave, lane);
    }
    SEAM(4);
#ifndef REP5
#define REP5 1
#endif
    if (IN(5)) for (int rep_ = 0; rep_ < REP5; ++rep_) {
        if (rep_) xcd_barrier(bar);
        pg8::Gemm g{(const bf16*)(ws + WS_HB), (const bf16*)(ws + WS_WGU), MT, NGU, DM}; pg8::StaticOrder S; S.init(MT, NGU, G, c);
        pg8::EpiGU E{(const float*)(ws + WS_SS), (bf16*)(ws + WS_ACT)};
        pg8::gemm_phase<pg8::EpiGU, pg8::StaticOrder, true, true>(lds, g, S, E);
    }
    SEAM(5);
#ifndef REP6
#define REP6 1
#endif
    if (IN(6)) for (int rep_ = 0; rep_ < REP6; ++rep_) {
        if (rep_) xcd_barrier(bar);
        pg8::Gemm g{(const bf16*)(ws + WS_ACT), (const bf16*)(ws + WS_WDN), MP, DM, DFF}; pg8::StaticOrder S; S.init(MP, DM, G, c);
        pg8::EpiDown E{(const bf16*)(ws + WS_HB), a.out, (float*)(ws + WS_SS2)};
        pg8::gemm_phase<pg8::EpiDown, pg8::StaticOrder, true, true>(lds, g, S, E);
        small_down(a, lds, wave, lane);
    }
    SEAM(6);
    if (IN(7)) final_norm(a, wave, lane);
#ifdef PROBE_SYNCS
    for (int i_ = 0; i_ < PROBE_SYNCS; ++i_) xcd_barrier(bar);
#endif
#undef IN
#undef SEAM
}

#ifndef N_LAUNCHES
#define N_LAUNCHES 1
#endif
extern "C" void kernel_launch(void* const* d_in, const int* in_sizes, int n_in, void* d_out, int out_size, void* d_ws, size_t ws_size, hipStream_t stream) {
    static int grid = 0;
    if (grid == 0) {
        if (n_in != 21 || (size_t)out_size != OUT_TOTAL || ws_size < WS_END) { fprintf(stderr, "kernel_launch: unexpected shapes (n_in %d out %d ws %zu)\n", n_in, out_size, ws_size); grid = -1; return; }
        int dev = 0, cus = 0, per_cu = 0;
        hipGetDevice(&dev); hipDeviceGetAttribute(&cus, hipDeviceAttributeMultiprocessorCount, dev);
        hipFuncSetAttribute((const void*)fwd_kernel, hipFuncAttributeMaxDynamicSharedMemorySize, LDS_BYTES);
        hipOccupancyMaxActiveBlocksPerMultiprocessor(&per_cu, (const void*)fwd_kernel, NTHREADS, LDS_BYTES);
        (void)hipGetLastError();
        if (per_cu < 1) fprintf(stderr, "kernel_launch: occupancy query says %d blocks per CU\n", per_cu);
        grid = cus > 0 ? cus : 256;
    }
    if (grid < 0) return;
    if (hipMemsetAsync((char*)d_ws + WS_CTL, 0, CTL_ZERO_BYTES, stream) != hipSuccess) { fprintf(stderr, "kernel_launch: memset failed\n"); return; }
    Args a{};
    for (int i = 0; i < 21; ++i) a.in[i] = (const float*)d_in[i];
    a.out = (float*)d_out; a.ws = (unsigned char*)d_ws; a.qmask = 7;
#if N_LAUNCHES == 1
    a.ph_lo = 0; a.ph_hi = NPHASE;
    void* args[] = {&a};
    hipError_t e = hipLaunchCooperativeKernel((const void*)fwd_kernel, dim3(grid), dim3(NTHREADS), args, LDS_BYTES, stream);
    if (e != hipSuccess) fprintf(stderr, "cooperative launch failed: %s (grid %d)\n", hipGetErrorString(e), grid);
#else
    for (int p = 0; p < NPHASE; ++p) { a.ph_lo = p; a.ph_hi = p + 1; a.qmask = 7; a.pad = 0; hipLaunchKernelGGL(fwd_kernel, dim3(grid), dim3(NTHREADS), LDS_BYTES, stream, a);
#ifdef PROBE_REPEAT
        if (p == PROBE_REPEAT) { (void)hipMemsetAsync((char*)d_ws + WS_CTL, 0, CTL_ZERO_BYTES, stream);
#ifdef PROBE_QMASK
            a.qmask = PROBE_QMASK;
#endif
#ifdef PROBE_VARIANT
            a.pad = PROBE_VARIANT;
#endif
            hipLaunchKernelGGL(fwd_kernel, dim3(grid), dim3(NTHREADS), LDS_BYTES, stream, a); }
#endif
    }
#endif
}
```
